# Optimizing an MI355X kernel written in HIP

```python
import math
import jax, jax.numpy as jnp
from jax import lax
import numpy as np

D_MODEL = 2048
BATCH = 4
SEQ = 2048
DEPTH = 2
DEC_BATCH = 128
DEC_SEQ = 4
PAST_LEN = 2048
PAGE_SIZE = 128

DH = 128
H_A = D_MODEL // (2 * DH)
HKV = 2
GRP = H_A // HKV
L_CMP = 32
D_CMP = 16
CMP_R = L_CMP // D_CMP
CMP_HID = 2 * DH
L_SEL = 64
N_TOP = 16
WINDOW = 512
Q_BLOCK = 64
N_KV_SLOTS = 4
H_B = 4
DK_B = D_MODEL // (4 * H_B)
DV_B = D_MODEL // (2 * H_B)
GLA_LR = 16
GLA_GATE_NORM = 16.0
DK_C = 128
H_C = D_MODEL // DK_C
DV_C = D_MODEL // H_C
REC_CHUNK = 16
N_A_LAYERS = (DEPTH + 1) // 2
N_C_LAYERS = DEPTH // 2
EPS = 1e-6
FORCE_SCORE = 1e9
A_SIZES = (H_A * DH, 6 * HKV * DH, 3 * H_A, H_A * DH, H_B * DK_B, H_B * DK_B, H_B * DV_B, GLA_LR, H_B * DV_B)
C_SIZES = (H_C * DK_C, H_C * DK_C, H_C * DV_C, H_C * DV_C)

kernel_name = 'nsa_gla_hgrn2_hybrid_step'


def split_cols(a, sizes):
    return jnp.split(a, np.cumsum(sizes)[:-1].tolist(), axis=-1)


def rmsnorm(x, w):
    xf = x.astype(jnp.float32)
    y = xf * lax.rsqrt(jnp.mean(xf * xf, axis=-1, keepdims=True) + EPS)
    return (y * w.astype(jnp.float32)).astype(x.dtype)


def masked_softmax(s, mask):
    s = jnp.where(mask, s.astype(jnp.float32), -jnp.inf)
    m = jnp.max(s, axis=-1, keepdims=True)
    m = jnp.where(jnp.isfinite(m), m, 0.0)
    e = jnp.where(mask, jnp.exp(s - m), 0.0)
    return e / jnp.maximum(jnp.sum(e, axis=-1, keepdims=True), 1e-30)


def gated_recurrence(q, k, v, log_a, s0):
    B_, T, H, _ = q.shape
    V = v.shape[-1]
    c = math.gcd(T, REC_CHUNK)
    n = T // c
    f32 = jnp.float32

    def blocks(a):
        return a.astype(f32).reshape(B_, n, c, H, a.shape[-1]).transpose(1, 0, 3, 2, 4)

    causal = jnp.tril(jnp.ones((c, c), dtype=bool))[None, None, :, :, None]

    def step(s, xs):
        qc, kc, vc, gc = xs
        b = jnp.cumsum(gc, axis=2)
        decay = jnp.exp(jnp.where(causal, b[:, :, :, None, :] - b[:, :, None, :, :], -jnp.inf))
        att = jnp.einsum('bhik,bhijk,bhjk->bhij', qc, decay, kc)
        o = jnp.einsum('bhij,bhjv->bhiv', att, vc) + jnp.einsum('bhik,bhkv->bhiv', qc * jnp.exp(b), s)
        b_last = b[:, :, -1:, :]
        s = jnp.exp(b_last)[:, :, 0, :, None] * s + jnp.einsum('bhjk,bhjv->bhkv', kc * jnp.exp(b_last - b), vc)
        return s, o

    s_fin, o = lax.scan(step, s0.astype(f32), (blocks(q), blocks(k), blocks(v), blocks(log_a)))
    o = o.transpose(1, 0, 3, 2, 4).reshape(B_, T, H, V)
    return o.astype(v.dtype), s_fin.astype(s0.dtype)


def compress_blocks(x, pe, w1, b1, w2):
    B_, L = x.shape[:2]
    n_str = L // D_CMP
    nc = n_str - CMP_R + 1
    s = x[:, :n_str * D_CMP].reshape(B_, n_str, D_CMP, HKV, DH)
    w1r = w1.reshape(CMP_R, D_CMP, DH, CMP_HID)
    u = jnp.einsum('bnphd,rpde->rbnhe', s, w1r)
    h = b1 + jnp.einsum('rpd,rpde->e', pe.reshape(CMP_R, D_CMP, DH), w1r)
    for r in range(CMP_R):
        h = h + u[r, :, r:r + nc]
    return jax.nn.gelu(h) @ w2


def nsa_attend(q, gates, kv, win_kv, q_start, win_base, cmp_pe, cmp_w1, cmp_b1, cmp_w2):
    B_, Tq = q.shape[:2]
    L = kv.shape[1]
    scale = DH ** -0.5
    kc = compress_blocks(kv[:, :, 0], cmp_pe[0], cmp_w1[0], cmp_b1[0], cmp_w2[0])
    vc = compress_blocks(kv[:, :, 1], cmp_pe[1], cmp_w1[1], cmp_b1[1], cmp_w2[1])
    nc = kc.shape[1]
    ns = -(-L // L_SEL)

    def sel_blocks(a):
        a = jnp.pad(a, ((0, 0), (0, ns * L_SEL - L), (0, 0), (0, 0)))
        return a.reshape(B_, ns, L_SEL, HKV, DH).transpose(0, 3, 1, 2, 4)

    ks_all = sel_blocks(kv[:, :, 2])
    vs_all = sel_blocks(kv[:, :, 3])
    c_start = np.arange(nc)[:, None] * D_CMP
    s_start = np.arange(ns)[None, :] * L_SEL
    overlap = np.clip(np.minimum(c_start + L_CMP, s_start + L_SEL) - np.maximum(c_start, s_start), 0, None)
    cmp_to_sel = jnp.asarray(overlap / D_CMP, dtype=jnp.float32)
    cmp_end = jnp.asarray(np.arange(nc) * D_CMP + L_CMP - 1, dtype=jnp.int32)
    blk = jnp.arange(ns, dtype=jnp.int32)
    n_top = min(N_TOP, ns)
    qb = math.gcd(Tq, Q_BLOCK)
    nq = Tq // qb
    sel_off = jnp.arange(L_SEL, dtype=jnp.int32)
    win_off = jnp.arange(WINDOW + qb, dtype=jnp.int32) - WINDOW
    g_idx = jnp.arange(HKV, dtype=jnp.int32)[None, :, None]

    def chunk(args):
        qx, gx, bi, t0 = args
        tpos = t0 + jnp.arange(qb, dtype=jnp.int32)
        qg = qx.reshape(qb, HKV, GRP, DH)
        s = jnp.einsum('qgrd,cgd->qgrc', qg, kc[bi]) * scale
        p_c = masked_softmax(s, (cmp_end[None, :] <= tpos[:, None])[:, None, None, :])
        o_c = jnp.einsum('qgrc,cgd->qgrd', p_c, vc[bi])
        imp = jnp.einsum('qgrc,cs->qgs', p_c, cmp_to_sel)
        cur = (tpos // L_SEL)[:, None]
        valid = blk[None, :] <= cur
        forced = (blk[None, :] == 0) | (blk[None, :] == cur) | (blk[None, :] == cur - 1)
        score = jnp.where(valid[:, None, :], jnp.where(forced[:, None, :], FORCE_SCORE, imp), -jnp.inf)
        _, top = lax.top_k(score, n_top)
        ks = ks_all[bi][g_idx, top]
        vs = vs_all[bi][g_idx, top]
        kpos = (top[..., None] * L_SEL + sel_off).reshape(qb, HKV, 1, n_top * L_SEL)
        s = jnp.einsum('qgrd,qgnkd->qgrnk', qg, ks).reshape(qb, HKV, GRP, n_top * L_SEL) * scale
        p_s = masked_softmax(s, kpos <= tpos[:, None, None, None])
        o_s = jnp.einsum('qgrm,qgmd->qgrd', p_s, vs.reshape(qb, HKV, n_top * L_SEL, DH))
        wk = lax.dynamic_slice_in_dim(win_kv[bi], t0 - WINDOW - win_base, WINDOW + qb, axis=0)
        wpos = t0 + win_off
        wmask = (wpos[None, :] >= 0) & (wpos[None, :] <= tpos[:, None]) & (wpos[None, :] > tpos[:, None] - WINDOW)
        s = jnp.einsum('qgrd,kgd->qgrk', qg, wk[:, 0]) * scale
        p_w = masked_softmax(s, wmask[:, None, None, :])
        o_w = jnp.einsum('qgrk,kgd->qgrd', p_w, wk[:, 1])
        gx = gx.reshape(qb, HKV, GRP, 3)
        o = gx[..., 0:1] * o_c + gx[..., 1:2] * o_s + gx[..., 2:3] * o_w
        return o.reshape(qb, H_A, DH).astype(qx.dtype)

    bi = jnp.repeat(jnp.arange(B_, dtype=jnp.int32), nq)
    t0 = q_start + jnp.tile(jnp.arange(nq, dtype=jnp.int32) * qb, B_)
    out = lax.map(chunk, (q.reshape(B_ * nq, qb, H_A, DH), gates.reshape(B_ * nq, qb, H_A, 3), bi, t0))
    return out.reshape(B_, Tq, H_A * DH)


def layer_a(x, norm_w, w_in, gla_w2, gla_b, gla_gn, cmp_pe, cmp_w1, cmp_b1, cmp_w2, w_out,
            past_kv, win_buf, gla_s0, q_start):
    B_, T, _ = x.shape
    h = rmsnorm(x, norm_w)
    q, kv, g_br, z_a, q_b, k_b, v_b, lr_b, z_b = split_cols(h @ w_in, A_SIZES)
    q = q.reshape(B_, T, H_A, DH)
    kv = kv.reshape(B_, T, 6, HKV, DH)
    gates = jax.nn.sigmoid(g_br.astype(jnp.float32)).reshape(B_, T, H_A, 3)
    new_rows = kv[:, :, :N_KV_SLOTS]
    new_win = kv[:, :, N_KV_SLOTS:]
    if past_kv is None:
        full = new_rows
        keep = min(WINDOW, T)
        win_state = new_win[:, T - keep:]
        win_kv = jnp.pad(new_win, ((0, 0), (WINDOW, 0), (0, 0), (0, 0), (0, 0)))
        win_base = -WINDOW
    else:
        full = jnp.concatenate([past_kv, new_rows], axis=1)
        buf = jnp.concatenate([win_buf, new_win], axis=1)
        wb = win_buf.shape[1]
        win_state = buf[:, buf.shape[1] - wb:]
        win_kv = jnp.pad(buf, ((0, 0), (WINDOW - wb, 0), (0, 0), (0, 0), (0, 0)))
        win_base = q_start - WINDOW
    o_a = nsa_attend(q, gates, full, win_kv, q_start, win_base, cmp_pe, cmp_w1, cmp_b1, cmp_w2) * jax.nn.silu(z_a)
    log_a = jax.nn.log_sigmoid((lr_b @ gla_w2 + gla_b).astype(jnp.float32)) / GLA_GATE_NORM
    o_b, s_b = gated_recurrence(q_b.reshape(B_, T, H_B, DK_B) * (DK_B ** -0.5),
                                k_b.reshape(B_, T, H_B, DK_B),
                                v_b.reshape(B_, T, H_B, DV_B),
                                log_a.reshape(B_, T, H_B, DK_B), gla_s0)
    o_b = rmsnorm(o_b, gla_gn).reshape(B_, T, H_B * DV_B) * jax.nn.silu(z_b)
    y = x + jnp.concatenate([o_a, o_b], axis=-1) @ w_out
    return y, new_rows, win_state, s_b


def layer_c(x, layer_idx, norm_w, w_in, lb_logits, gn, w_out, s0):
    B_, T, _ = x.shape
    h = rmsnorm(x, norm_w)
    q, f, i, z = split_cols(h @ w_in, C_SIZES)
    prob = jax.nn.softmax(lb_logits.astype(jnp.float32), axis=0)
    lb = jnp.cumsum(prob, axis=0)[layer_idx] - prob[0]
    log_f = jnp.logaddexp(jnp.log(lb), jnp.log1p(-lb) + jax.nn.log_sigmoid(f.astype(jnp.float32)))
    k = -jnp.expm1(log_f)
    o, s = gated_recurrence(jax.nn.silu(q).reshape(B_, T, H_C, DK_C), k.reshape(B_, T, H_C, DK_C),
                            i.reshape(B_, T, H_C, DV_C), log_f.reshape(B_, T, H_C, DK_C), s0)
    o = rmsnorm(o, gn).reshape(B_, T, H_C * DV_C) * jax.nn.silu(z)
    return x + o @ w_out, s


def setup_inputs(seed: int = 0) -> dict:
    key = jax.random.key(seed)
    ks = jax.random.split(key, 24)
    n_pages = PAST_LEN // PAGE_SIZE
    n_used = DEC_BATCH * n_pages
    n_pool = n_used + n_used // 4
    wb = min(WINDOW, PAST_LEN)

    def nrm(k, shape, s):
        return s * jax.random.normal(k, shape, jnp.float32)

    a_out_in = H_A * DH + H_B * DV_B
    return {
        'x_prompt': nrm(ks[0], (BATCH, SEQ, D_MODEL), 1.0),
        'x_sample': nrm(ks[1], (DEC_BATCH, DEC_SEQ, D_MODEL), 1.0),
        'cache_kv': nrm(ks[2], (N_A_LAYERS, n_pool, PAGE_SIZE, N_KV_SLOTS, HKV, DH), 1.0),
        'cache_win': nrm(ks[3], (N_A_LAYERS, DEC_BATCH, wb, 2, HKV, DH), 1.0),
        'state_gla': nrm(ks[4], (N_A_LAYERS, DEC_BATCH, H_B, DK_B, DV_B), 1.0),
        'state_hgrn': nrm(ks[5], (N_C_LAYERS, DEC_BATCH, H_C, DK_C, DV_C), 0.5),
        'page_table': jax.random.permutation(ks[6], n_pool)[:n_used].reshape(DEC_BATCH, n_pages).astype(jnp.int32),
        'a_norm': 1.0 + nrm(ks[7], (N_A_LAYERS, D_MODEL), 0.02),
        'a_w_in': nrm(ks[8], (N_A_LAYERS, D_MODEL, sum(A_SIZES)), D_MODEL ** -0.5),
        'a_gla_w2': nrm(ks[9], (N_A_LAYERS, GLA_LR, H_B * DK_B), GLA_LR ** -0.5),
        'a_gla_b': nrm(ks[10], (N_A_LAYERS, H_B * DK_B), 0.1),
        'a_gla_gn': 1.0 + nrm(ks[11], (N_A_LAYERS, DV_B), 0.02),
        'a_cmp_pe': nrm(ks[12], (N_A_LAYERS, 2, L_CMP, DH), 0.1),
        'a_cmp_w1': nrm(ks[13], (N_A_LAYERS, 2, L_CMP * DH, CMP_HID), (L_CMP * DH) ** -0.5),
        'a_cmp_b1': nrm(ks[14], (N_A_LAYERS, 2, CMP_HID), 0.02),
        'a_cmp_w2': nrm(ks[15], (N_A_LAYERS, 2, CMP_HID, DH), CMP_HID ** -0.5),
        'a_w_out': nrm(ks[16], (N_A_LAYERS, a_out_in, D_MODEL), a_out_in ** -0.5),
        'c_norm': 1.0 + nrm(ks[17], (N_C_LAYERS, D_MODEL), 0.02),
        'c_w_in': nrm(ks[18], (N_C_LAYERS, D_MODEL, sum(C_SIZES)), D_MODEL ** -0.5),
        'c_lb_logits': nrm(ks[19], (DEPTH, H_C * DK_C), 0.5),
        'c_gn': 1.0 + nrm(ks[20], (N_C_LAYERS, DV_C), 0.02),
        'c_w_out': nrm(ks[21], (N_C_LAYERS, H_C * DV_C, D_MODEL), (H_C * DV_C) ** -0.5),
        'final_norm': 1.0 + nrm(ks[22], (D_MODEL,), 0.02),
    }


def reference(x_prompt, x_sample, cache_kv, cache_win, state_gla, state_hgrn, page_table,
              a_norm, a_w_in, a_gla_w2, a_gla_b, a_gla_gn, a_cmp_pe, a_cmp_w1, a_cmp_b1, a_cmp_w2, a_w_out,
              c_norm, c_w_in, c_lb_logits, c_gn, c_w_out, final_norm):
    n_seq, n_pages = page_table.shape
    past_len = n_pages * cache_kv.shape[2]

    def run(x, sample):
        rows_l, win_l, gla_l, hg_l = [], [], [], []
        for l in range(DEPTH):
            if l % 2 == 0:
                a = l // 2
                if sample:
                    past = cache_kv[a][page_table].reshape(n_seq, past_len, N_KV_SLOTS, HKV, DH)
                    buf, s0, q_start = cache_win[a], state_gla[a], past_len
                else:
                    past, buf, q_start = None, None, 0
                    s0 = jnp.zeros((x.shape[0], H_B, DK_B, DV_B), x.dtype)
                x, rows, win, sg = layer_a(x, a_norm[a], a_w_in[a], a_gla_w2[a], a_gla_b[a], a_gla_gn[a],
                                           a_cmp_pe[a], a_cmp_w1[a], a_cmp_b1[a], a_cmp_w2[a], a_w_out[a],
                                           past, buf, s0, q_start)
                rows_l.append(rows)
                win_l.append(win)
                gla_l.append(sg)
            else:
                c = l // 2
                s0 = state_hgrn[c] if sample else jnp.zeros((x.shape[0], H_C, DK_C, DV_C), x.dtype)
                x, sh = layer_c(x, l, c_norm[c], c_w_in[c], c_lb_logits, c_gn[c], c_w_out[c], s0)
                hg_l.append(sh)
        return rmsnorm(x, final_norm), jnp.stack(rows_l), jnp.stack(win_l), jnp.stack(gla_l), jnp.stack(hg_l)

    y_prompt, kv_p, win_p, gla_p, hg_p = run(x_prompt, False)
    y_sample, kv_s, win_s, gla_s, hg_s = run(x_sample, True)
    return (y_prompt, y_sample, kv_p, kv_s, win_p, win_s, gla_p, gla_s, hg_p, hg_s)
```

```cpp
#include <hip/hip_runtime.h>
#include <stdint.h>

typedef unsigned short u16;
typedef unsigned int u32;
typedef unsigned long long u64;
using bf16x8 = __attribute__((ext_vector_type(8))) short;
using f32x4  = __attribute__((ext_vector_type(4))) float;
using f32x16 = __attribute__((ext_vector_type(16))) float;
using u32x4  = __attribute__((ext_vector_type(4))) unsigned;
using u32x2  = __attribute__((ext_vector_type(2))) unsigned;
#define DI __device__ __forceinline__

constexpr int DM = 2048, NTP = 8192, NTS = 512, NT = 8704;
constexpr int SEQ = 2048, NB = 4, DB = 128, DSEQ = 4, PAST = 2048;
constexpr int NA = 6696, NAP = 6912, NC = 8192;
constexpr int CQ = 0, CKV = 1024, CZA = 2560, CQB = 3584, CKB = 4096, CVB = 4608, CZB = 5632, CGB = 6656, CLR = 6680;
constexpr float QSCALE = 0.08838834764831845f;
constexpr float QSCALE_L2E = 0.08838834764831845f * 1.4426950408889634f;

constexpr long O_YP = 0, O_YS = 16777216, O_KVP = 17825792, O_KVS = 26214400, O_WINP = 26738688, O_WINS = 27787264,
               O_GLAP = 61341696, O_GLAS = 61865984, O_HGP = 78643200, O_HGS = 79691776;

constexpr size_t AL(size_t x) { return (x + 255) & ~(size_t)255; }
constexpr size_t WS_BAR   = 0;
constexpr size_t WS_WINA  = 65536;
constexpr size_t WS_WOUTA = WS_WINA  + AL((size_t)NAP * DM * 2);
constexpr size_t WS_WINC  = WS_WOUTA + AL((size_t)DM * DM * 2);
constexpr size_t WS_WOUTC = WS_WINC  + AL((size_t)NC * DM * 2);
constexpr size_t WS_W1T   = WS_WOUTC + AL((size_t)DM * DM * 2);
constexpr size_t WS_W2T   = WS_W1T   + AL((size_t)2 * 256 * 4096 * 2);
constexpr size_t WS_HCONST= WS_W2T   + AL((size_t)2 * 256 * 256 * 2);
constexpr size_t WS_H     = WS_HCONST+ AL(2 * 256 * 4);
constexpr size_t WS_XCS   = WS_H     + AL((size_t)NT * DM * 2);
constexpr size_t WS_KV6   = WS_XCS   + AL((size_t)2 * 128 * 2 * 2048 * 128 * 2 + 16384);
constexpr size_t WS_VT    = WS_KV6   + AL((size_t)6 * 4 * 2 * 2048 * 128 * 2 + 16384);
constexpr size_t WS_KF    = WS_VT    + AL((size_t)2 * 4 * 2 * 128 * 2048 * 2 + 16384);
constexpr size_t WS_A2S   = WS_KF    + AL((size_t)2 * 4 * 2 * 128 * 2048 * 2 + 16384);
constexpr size_t WS_A2P   = WS_A2S   + AL((size_t)2 * 32768 * 256 * 2);
constexpr size_t WS_KCS   = WS_A2P   + AL((size_t)2 * 1024 * 256 * 2);
constexpr size_t WS_KCP   = WS_KCS   + AL((size_t)2 * 256 * 128 * 128 * 4);
constexpr size_t WS_VCTP  = WS_KCP   + AL((size_t)8 * 128 * 128 * 2 + 4096);
constexpr size_t WS_PROJ  = WS_VCTP  + AL((size_t)8 * 128 * 128 * 2 + 4096);
constexpr size_t WS_Q     = WS_PROJ  + AL((size_t)NT * NAP * 4);
constexpr size_t WS_GQT   = WS_Q     + AL((size_t)NT * 1024 * 2);
constexpr size_t WS_GKA   = WS_GQT   + AL((size_t)NTP * 512 * 2);
constexpr size_t WS_GKST  = WS_GKA   + AL((size_t)NTP * 512 * 2);
constexpr size_t WS_GVT   = WS_GKST  + AL((size_t)NTP * 512 * 2);
constexpr size_t WS_GDC   = WS_GVT   + AL((size_t)NTP * 1024 * 2);
constexpr size_t WS_GOI   = WS_GDC   + AL((size_t)16 * 128 * 128 * 4);
constexpr size_t WS_OB32  = WS_GOI   + AL((size_t)16 * 128 * 16 * 256 * 4);
constexpr size_t WS_OA    = WS_OB32  + AL((size_t)NTP * 1024 * 4);
constexpr size_t WS_X1    = WS_OA    + AL((size_t)NT * DM * 2);
constexpr size_t WS_PROJC = WS_X1    + AL((size_t)NT * DM * 4);
constexpr size_t WS_HQT   = WS_PROJC + AL((size_t)NT * NC * 4);
constexpr size_t WS_HKA   = WS_HQT   + AL((size_t)NTP * DM * 2);
constexpr size_t WS_HKST  = WS_HKA   + AL((size_t)NTP * DM * 2);
constexpr size_t WS_HVT   = WS_HKST  + AL((size_t)NTP * DM * 2);
constexpr size_t WS_HDC   = WS_HVT   + AL((size_t)NTP * DM * 2);
constexpr size_t WS_HOI   = WS_HDC   + AL((size_t)64 * 128 * 128 * 4);
constexpr size_t WS_OC32  = WS_HOI   + AL((size_t)64 * 128 * 8 * 256 * 4);
constexpr size_t WS_X2    = WS_OC32  + AL((size_t)NTP * DM * 4);
constexpr size_t WS_ZB    = WS_X2    + AL((size_t)NT * DM * 4);
constexpr size_t WS_PCS   = WS_ZB    + AL((size_t)NTP * DM * 2);
constexpr size_t WS_CPP   = WS_PCS   + AL((size_t)2 * NTS * NC * 4);
constexpr size_t WS_END   = WS_CPP   + AL((size_t)4 * 1024 * 256 * 4);

struct Params {
    const float *x_prompt, *x_sample, *cache_kv, *cache_win, *state_gla, *state_hgrn;
    const int* page_table;
    const float *a_norm, *a_w_in, *a_gla_w2, *a_gla_b, *a_gla_gn, *a_cmp_pe, *a_cmp_w1, *a_cmp_b1, *a_cmp_w2, *a_w_out;
    const float *c_norm, *c_w_in, *c_lb_logits, *c_gn, *c_w_out, *final_norm;
    float* out;
    char* ws;
};

extern __shared__ __attribute__((aligned(16))) char smem[];
constexpr int LDS_BYTES = 148480;

typedef float f32x2_t __attribute__((ext_vector_type(2))); typedef __bf16 bf16x2_t __attribute__((ext_vector_type(2)));
DI u32 cvt_pk(float lo, float hi) { f32x2_t v = {lo, hi}; bf16x2_t b = __builtin_convertvector(v, bf16x2_t); return __builtin_bit_cast(u32, b); }
DI u16 f2bf(float x) { return (u16)(cvt_pk(x, 0.f) & 0xffffu); }
DI float bf2f(u16 x) { return __uint_as_float(((u32)x) << 16); }
DI float bflo(u32 w) { return __uint_as_float(w << 16); }
DI float bfhi(u32 w) { return __uint_as_float(w & 0xffff0000u); }
DI float wave_sum(float v) {
#pragma unroll
    for (int o = 32; o >= 1; o >>= 1) v += __shfl_xor(v, o, 64);
    return v;
}
DI float exp2f_(float x) { return __builtin_amdgcn_exp2f(x); }
using f16x2 = __attribute__((ext_vector_type(2))) _Float16;
DI u16 f2h(float x) { const _Float16 h = (_Float16)x; return __builtin_bit_cast(u16, h); }
DI float sigmoidf_(float x) { return 1.f / (1.f + __expf(-x)); }
DI float siluf_(float x) { return x / (1.f + __expf(-x)); }
DI float logsigmoidf_(float x) { return fminf(x, 0.f) - log1pf(__expf(-fabsf(x))); }
DI float gelu_tanh(float x) { const float u = 0.7978845608028654f * (x + 0.044715f * x * x * x); return x / (1.f + __expf(-2.f * u)); }
DI bf16x8 mk8(u32 a, u32 b, u32 c, u32 d) { u32x4 v = {a, b, c, d}; return __builtin_bit_cast(bf16x8, v); }
DI bf16x8 ld8(const u16* p) { return *reinterpret_cast<const bf16x8*>(p); }
DI f32x4 mfma16(bf16x8 a, bf16x8 b, f32x4 c) { return __builtin_amdgcn_mfma_f32_16x16x32_bf16(a, b, c, 0, 0, 0); }
DI f32x16 mfma32(bf16x8 a, bf16x8 b, f32x16 c) { return __builtin_amdgcn_mfma_f32_32x32x16_bf16(a, b, c, 0, 0, 0); }

#define XB_TMO      128
#define XB_XCNT(j)  (256  + 64 * (j))
#define XB_XSUB(j)  (1280 + 64 * (j))
#define XB_XGEN(j)  (2304 + 64 * (j))
#define XB_TOP      3328
#define XB_TOPGEN   3392
#define XCD_BAR_WORDS 3456
#define XB_SPIN_CAP (1u << 18)
#define LAS __attribute__((address_space(3)))

__device__ __forceinline__ unsigned xb_ld(unsigned* p)              { return __hip_atomic_load(p, __ATOMIC_RELAXED, __HIP_MEMORY_SCOPE_AGENT); }
__device__ __forceinline__ unsigned xb_add(unsigned* p, unsigned v) { return __hip_atomic_fetch_add(p, v, __ATOMIC_RELAXED, __HIP_MEMORY_SCOPE_AGENT); }
__device__ __forceinline__ unsigned xb_xcc_id() { return (unsigned)__builtin_amdgcn_s_getreg((3 << 11) | 20) & 0xFu; }
#define XB_SPIN(cond, bar) do { unsigned _sp = 0; while (cond) { __builtin_amdgcn_s_sleep(1); \
    if ((++_sp & 255u) == 0u) { if (xb_ld(&(bar)[XB_TMO])) break; if (_sp > XB_SPIN_CAP) { atomicAdd(&(bar)[XB_TMO], 1u); break; } } } } while (0)

struct XcdBarrier { unsigned* bar; unsigned x; volatile LAS unsigned* st; };

__device__ __forceinline__ XcdBarrier xcd_barrier_post(unsigned* bar, volatile LAS unsigned* st) {
    XcdBarrier b; b.bar = bar; b.x = xb_xcc_id(); b.st = st;
    if (threadIdx.x == 0) (void)xb_add(&bar[XB_XCNT(b.x)], 1u);
    return b;
}
__device__ __forceinline__ void xcd_barrier_complete(unsigned* bar, unsigned x, unsigned& nloc, unsigned& nx) {
    const unsigned G = gridDim.x * gridDim.y * gridDim.z;
    unsigned sum, cnt, mine, sp = 0u;
    for (;;) {
        sum = 0u; cnt = 0u; mine = 0u;
#pragma unroll
        for (unsigned j = 0; j < 16; ++j) { const unsigned c = xb_ld(&bar[XB_XCNT(j)]); sum += c; cnt += (c > 0u) ? 1u : 0u; mine = (j == x) ? c : mine; }
        if (sum == G) break;
        __builtin_amdgcn_s_sleep(1);
        if ((++sp & 255u) == 0u) { if (xb_ld(&bar[XB_TMO])) break; if (sp > XB_SPIN_CAP) { atomicAdd(&bar[XB_TMO], 1u); break; } }
    }
    nloc = mine > 0u ? mine : 1u; nx = cnt > 0u ? cnt : 1u;
}
__device__ __forceinline__ void xcd_barrier(const XcdBarrier& b) {
    asm volatile("s_waitcnt vmcnt(0)" ::: "memory");
    __syncthreads();
    if (threadIdx.x == 0) {
        unsigned* bar = b.bar;
        __builtin_amdgcn_s_waitcnt(0);
        unsigned nloc = b.st[0], nx = b.st[1];
        if (nloc == 0u) { xcd_barrier_complete(bar, b.x, nloc, nx); b.st[0] = nloc; b.st[1] = nx; }
        const unsigned old = xb_add(&bar[XB_XSUB(b.x)], 1u);
        const unsigned gen = old / nloc;
        if (old + 1u == (gen + 1u) * nloc) {
            __builtin_amdgcn_fence(__ATOMIC_RELEASE, "agent");
            asm volatile("s_waitcnt vmcnt(0)" ::: "memory");
            const unsigned og = xb_add(&bar[XB_TOP], 1u);
            const unsigned tg = og / nx;
            if (og + 1u == (tg + 1u) * nx) xb_add(&bar[XB_TOPGEN], 1u);
            else XB_SPIN(xb_ld(&bar[XB_TOPGEN]) == tg, bar);
            __builtin_amdgcn_fence(__ATOMIC_ACQUIRE, "agent");
            xb_add(&bar[XB_XGEN(b.x)], 1u);
            asm volatile("s_waitcnt vmcnt(0)" ::: "memory");
        } else {
            XB_SPIN(xb_ld(&bar[XB_XGEN(b.x)]) == gen, bar);
            __builtin_amdgcn_fence(__ATOMIC_ACQUIRE, "agent");
            asm volatile("s_waitcnt vmcnt(0)" ::: "memory");
        }
    }
    __syncthreads();
}

constexpr int G_BK = 64, G_HALF = 128, G_HT = G_HALF * G_BK;
DI int g_lds_byte(int r, int c) {
    int st = (r >> 4) * 2 + (c >> 5), rr = r & 15, cc = c & 31, ob = rr * 64 + cc * 2;
    return st * 1024 + (ob ^ (((ob >> 9) & 1) << 5));
}
DI void g_stage_rc(int b, int& R, int& C) {
    int st = b / 1024, sb = b % 1024, swz = sb ^ (((sb >> 9) & 1) << 5);
    R = (st >> 1) * 16 + swz / 64; C = (st & 1) * 32 + (swz % 64) / 2;
}

template <class Epi>
DI void gemm_tile(const u16* __restrict__ A, int lda, const u16* __restrict__ Bt, int ldb, int K, int brow, int bcol, const Epi& epi) {
    u16* shm = reinterpret_cast<u16*>(smem);
#define SA(b,h) (shm+((b)*2+(h))*G_HT)
#define SB(b,h) (shm+(4+(b)*2+(h))*G_HT)
#define STAGE_X(T,P,BASE,LD,br,kt,OFF) do{const u16* _gb=(BASE)+((long)(br)*(LD)+(long)(kt)*G_BK); \
    for(int _i=0;_i<2;++_i){int _b=(T)*16+_i*8192; \
      __builtin_amdgcn_global_load_lds((const unsigned*)(_gb+OFF[_i]), \
        (unsigned*)((char*)(P)+_b),16,0,0);}}while(0)
#define STAGEA(P,br,kt) STAGE_X(t0,P,A,lda,br,kt,offA)
#define STAGEB(P,br,kt) STAGE_X(t0,P,Bt,ldb,br,kt,offB)
#define MKOFF(T) do{for(int _i=0;_i<2;++_i){int _r,_c;g_stage_rc((T)*16+_i*8192,_r,_c);offA[_i]=_r*lda+_c;offB[_i]=_r*ldb+_c;}}while(0)
#define LDA(dst,b,h) for(int m=0;m<4;++m)for(int k=0;k<2;++k) \
    dst[m][k]=*reinterpret_cast<const bf16x8*>((char*)SA(b,h)+g_lds_byte(wr*64+m*16+fr,k*32+fq*8))
#define LDB(dst,b,h) for(int n=0;n<2;++n)for(int k=0;k<2;++k) \
    dst[n][k]=*reinterpret_cast<const bf16x8*>((char*)SB(b,h)+g_lds_byte(wc*32+n*16+fr,k*32+fq*8))
#define MMA(ai,bj,At,Bx) do{__builtin_amdgcn_s_setprio(1); \
    for(int m=0;m<4;++m)for(int n=0;n<2;++n)for(int k=0;k<2;++k) \
      acc[ai][bj][m][n]=__builtin_amdgcn_mfma_f32_16x16x32_bf16(At[m][k],Bx[n][k],acc[ai][bj][m][n],0,0,0); \
    __builtin_amdgcn_s_setprio(0);}while(0)
#define WAIT_V(n) asm volatile("s_waitcnt vmcnt(" #n ")":::"memory")
#define WAIT_L(n) asm volatile("s_waitcnt lgkmcnt(" #n ")":::"memory")
#define BAR __builtin_amdgcn_s_barrier()
#define SCHED __builtin_amdgcn_sched_barrier(0)
    int t0 = threadIdx.x; asm volatile("" : "+v"(t0));
    int wid = t0 >> 6, lane = t0 & 63, wr = wid >> 2, wc = wid & 3, fr = lane & 15, fq = lane >> 4;
    f32x4 acc[2][2][4][2] = {};
    bf16x8 At[4][2], B0[2][2], B1[2][2];
    const int nt = K / G_BK;
    int offA[2], offB[2];
    MKOFF(t0);
    WAIT_V(0);
    STAGEB(SB(0,0),bcol,0); STAGEA(SA(0,0),brow,0);
    STAGEB(SB(0,1),bcol+G_HALF,0); STAGEA(SA(0,1),brow+G_HALF,0);
    if(wr==1)BAR;
    WAIT_V(4); BAR;
    STAGEB(SB(1,0),bcol,1); STAGEA(SA(1,0),brow,1); STAGEB(SB(1,1),bcol+G_HALF,1);
    WAIT_V(6); BAR;
    for(int t=0;t<nt-2;t+=2){
      LDB(B0,0,0); SCHED; LDA(At,0,0); STAGEA(SA(1,1),brow+G_HALF,t+1);
      WAIT_L(8); BAR; WAIT_L(0); MMA(0,0,At,B0); BAR; SCHED;
      LDB(B1,0,1); STAGEB(SB(0,0),bcol,t+2);
      BAR; WAIT_L(0); MMA(0,1,At,B1); BAR;
      LDA(At,0,1); STAGEA(SA(0,0),brow,t+2);
      BAR; WAIT_L(0); MMA(1,0,At,B0); BAR; SCHED;
      STAGEB(SB(0,1),bcol+G_HALF,t+2);
      WAIT_V(6); BAR; MMA(1,1,At,B1); BAR;
      LDB(B0,1,0); SCHED; LDA(At,1,0); STAGEA(SA(0,1),brow+G_HALF,t+2);
      WAIT_L(8); BAR; WAIT_L(0); MMA(0,0,At,B0); BAR; SCHED;
      LDB(B1,1,1); STAGEB(SB(1,0),bcol,t+3);
      BAR; WAIT_L(0); MMA(0,1,At,B1); BAR;
      LDA(At,1,1); STAGEA(SA(1,0),brow,t+3);
      BAR; WAIT_L(0); MMA(1,0,At,B0); BAR; SCHED;
      STAGEB(SB(1,1),bcol+G_HALF,t+3);
      WAIT_V(6); BAR; MMA(1,1,At,B1); BAR;
    }
    int tz=t0; asm volatile("":"+v"(tz)); wid=tz>>6; lane=tz&63; wr=wid>>2; wc=wid&3; fr=lane&15; fq=lane>>4;
    MKOFF(tz);
    { LDB(B0,0,0); WAIT_V(0); LDA(At,0,0); STAGE_X(tz,SA(1,1),A,lda,brow+G_HALF,nt-1,offA);
      BAR; WAIT_L(0); MMA(0,0,At,B0); BAR;
      LDB(B1,0,1); BAR; WAIT_L(0); MMA(0,1,At,B1); BAR;
      LDA(At,0,1); WAIT_V(4); BAR; WAIT_L(0); MMA(1,0,At,B0); MMA(1,1,At,B1); BAR; }
    { LDB(B0,1,0); LDA(At,1,0); WAIT_V(2); BAR; WAIT_L(0); MMA(0,0,At,B0); BAR;
      LDB(B1,1,1); WAIT_V(0); BAR; WAIT_L(0); MMA(0,1,At,B1); BAR;
      LDA(At,1,1); BAR; WAIT_L(0); MMA(1,0,At,B0); MMA(1,1,At,B1); BAR; }
    if(wr==0)BAR;
    {
        float* Cs = reinterpret_cast<float*>(smem);
        const bool cm = epi.colmode(brow, bcol), tm = epi.tilemode(brow, bcol);
#pragma unroll
        for (int ai = 0; ai < 2; ++ai) {
#pragma unroll
            for (int bj = 0; bj < 2; ++bj)
#pragma unroll
                for (int m = 0; m < 4; ++m)
#pragma unroll
                    for (int n = 0; n < 2; ++n)
#pragma unroll
                        for (int j = 0; j < 4; ++j)
                            Cs[(wr * 64 + m * 16 + fq * 4 + j) * 256 + bj * G_HALF + wc * 32 + n * 16 + fr] = acc[ai][bj][m][n][j];
            __syncthreads();
            if (tm) {
                epi.tile(Cs, brow + ai * G_HALF, bcol, tz);
            } else if (cm) {
#pragma unroll 4
                for (int i = 0; i < 16; ++i) {
                    const int idx = i * 512 + tz, col = idx & 255, rg = idx >> 8;
                    f32x4 v;
                    v[0] = Cs[(rg * 4 + 0) * 256 + col]; v[1] = Cs[(rg * 4 + 1) * 256 + col]; v[2] = Cs[(rg * 4 + 2) * 256 + col]; v[3] = Cs[(rg * 4 + 3) * 256 + col];
                    epi.col4(brow + ai * G_HALF + rg * 4, bcol + col, v);
                }
            } else {
#pragma unroll 4
                for (int i = 0; i < 16; ++i) {
                    const int idx = i * 512 + tz, row = idx >> 6, c4 = (idx & 63) * 4;
                    epi.row4(brow + ai * G_HALF + row, bcol + c4, *reinterpret_cast<const f32x4*>(Cs + row * 256 + c4));
                }
            }
            __syncthreads();
        }
    }
#undef SA
#undef SB
#undef STAGE_X
#undef STAGEA
#undef STAGEB
#undef MKOFF
#undef LDA
#undef LDB
#undef MMA
}

DI u32x2 pk4(f32x4 v) { u32x2 w = {cvt_pk(v[0], v[1]), cvt_pk(v[2], v[3])}; return w; }
struct EpiInA {
    float* proj; u16* Q; u16* KV6; u16* VT; u16* KF; float* out;
    DI bool tilemode(int, int) const { return false; }
    DI void tile(const float*, int, int, int) const {}
    DI bool colmode(int brow, int bcol) const { const int slot = (bcol - CKV) >> 8; return brow < NTP && bcol >= CKV && (slot == 3 || slot == 5); }
    DI void row4(int row, int col0, f32x4 v) const {
        if (col0 < CKV) {
            *reinterpret_cast<u32x2*>(Q + row * 1024 + col0) = pk4(v * QSCALE_L2E);
        } else if (col0 < CZA) {
            const int c1 = col0 - CKV, slot = c1 >> 8, g = (c1 >> 7) & 1, d = c1 & 127;
            if (row < NTP) {
                const int b = row >> 11, t = row & 2047;
                if (slot < 2) {
                    *reinterpret_cast<u32x2*>(KV6 + ((((slot * 4 + b) * 2 + g) * 2048 + t) * 128 + d)) = pk4(v);
                } else {
                    const int which = slot == 4 ? 1 : 0;
                    *reinterpret_cast<u32x2*>(KF + ((((which * 4 + b) * 2 + g) * 64 + (t >> 5)) * 4096 + (d >> 4) * 512 + (((d >> 3) & 1) * 32 + (t & 31)) * 8 + (d & 7))) = pk4(v);
                }
                if (c1 < 1024) *reinterpret_cast<f32x4*>(out + O_KVP + row * 1024 + c1) = v;
                else if (t >= 1536) *reinterpret_cast<f32x4*>(out + O_WINP + (b * 512 + t - 1536) * 512 + (c1 - 1024)) = v;
            } else {
                const int rr = row - NTP, b = rr >> 2, t = rr & 3;
                if (c1 < 1024) *reinterpret_cast<f32x4*>(out + O_KVS + rr * 1024 + c1) = v;
                else *reinterpret_cast<f32x4*>(out + O_WINS + (b * 512 + 508 + t) * 512 + (c1 - 1024)) = v;
                *reinterpret_cast<f32x4*>(proj + (long)row * NAP + col0) = v;
            }
        } else {
            *reinterpret_cast<f32x4*>(proj + (long)row * NAP + col0) = v;
        }
    }
    DI void col4(int row0, int col, f32x4 v) const {
        const int c1 = col - CKV, slot = c1 >> 8, g = (c1 >> 7) & 1, d = c1 & 127;
        const int b = row0 >> 11, t = row0 & 2047;
        {
            const int which = slot == 5 ? 1 : 0, r = t & 31, kk = r & 15;
            *reinterpret_cast<u32x2*>(VT + (((((which * 4 + b) * 2 + g) * 64 + (t >> 5)) * 8 + (r >> 4) * 4 + (d >> 5)) * 512 + (((kk >> 2) & 1) * 32 + (d & 31)) * 8 + (kk >> 3) * 4)) = pk4(v);
        }
        if (c1 < 1024) {
#pragma unroll
            for (int j = 0; j < 4; ++j) out[O_KVP + (row0 + j) * 1024 + c1] = v[j];
        } else if (t >= 1536) {
#pragma unroll
            for (int j = 0; j < 4; ++j) out[O_WINP + (b * 512 + t + j - 1536) * 512 + (c1 - 1024)] = v[j];
        }
    }
};
struct EpiCmp1 {
    const float* hc; u16* A2;
    DI bool tilemode(int, int) const { return false; }
    DI void tile(const float*, int, int, int) const {}
    DI bool colmode(int, int) const { return false; }
    DI void col4(int, int, f32x4) const {}
    DI void row4(int row, int col0, f32x4 v) const {
        const f32x4 h0 = *reinterpret_cast<const f32x4*>(hc + col0);
        f32x4 o;
#pragma unroll
        for (int j = 0; j < 4; ++j) o[j] = ((row & 127) == 127) ? 0.f : gelu_tanh(v[j] + h0[j]);
        *reinterpret_cast<u32x2*>(A2 + row * 256 + col0) = pk4(o);
    }
};
struct EpiCmp2S {
    float* dst;
    DI bool tilemode(int, int) const { return false; }
    DI void tile(const float*, int, int, int) const {}
    DI bool colmode(int, int) const { return false; }
    DI void col4(int, int, f32x4) const {}
    DI void row4(int row, int col0, f32x4 v) const { if (col0 < 128) *reinterpret_cast<f32x4*>(dst + row * 128 + col0) = v; }
};
struct EpiCmp2P {
    u16* kc; u16* vct; int slot;
    DI bool tilemode(int, int) const { return false; }
    DI void tile(const float*, int, int, int) const {}
    DI bool colmode(int, int) const { return slot == 1; }
    DI void row4(int row, int col0, f32x4 v) const { if (col0 < 128) *reinterpret_cast<u32x2*>(kc + row * 128 + col0) = pk4(v); }
    DI void col4(int row0, int col, f32x4 v) const {
        if (col < 128) { const int bg = row0 >> 7, c = row0 & 127; *reinterpret_cast<u32x2*>(vct + (bg * 128 + col) * 128 + c) = pk4(v); }
    }
};
struct EpiRes {
    const float* rp; const float* rs; float* dst;
    DI bool tilemode(int, int) const { return false; }
    DI void tile(const float*, int, int, int) const {}
    DI bool colmode(int, int) const { return false; }
    DI void col4(int, int, f32x4) const {}
    DI void row4(int row, int col0, f32x4 v) const {
        const f32x4 r = row < NTP ? *reinterpret_cast<const f32x4*>(rp + row * DM + col0) : *reinterpret_cast<const f32x4*>(rs + (row - NTP) * DM + col0);
        *reinterpret_cast<f32x4*>(dst + row * DM + col0) = v + r;
    }
};
struct EpiStore {
    float* dst; int ld;
    DI bool tilemode(int, int) const { return false; }
    DI void tile(const float*, int, int, int) const {}
    DI bool colmode(int, int) const { return false; }
    DI void col4(int, int, f32x4) const {}
    DI void row4(int row, int col0, f32x4 v) const { *reinterpret_cast<f32x4*>(dst + (long)row * ld + col0) = v; }
};

struct EpiInC {
    u16 *QT, *KA, *KST, *VT, *ZB, *DC; float *PCS; const float* lbl;
    DI bool colmode(int, int) const { return false; }
    DI void col4(int, int, f32x4) const {}
    DI bool tilemode(int brow, int) const { return brow < NTP; }
    DI void row4(int row, int col0, f32x4 v) const {
        const int T = col0 >> 8, cc = col0 & 255;
        *reinterpret_cast<f32x4*>(PCS + (long)(row - NTP) * NC + (cc >> 6) * 2048 + 64 * T + (cc & 63)) = v;
    }
    DI void tile(const float* Cs, int row0, int bcol, int tid) const {
        const int ck = tid >> 6, ch = tid & 63, T = bcol >> 8;
        const int gc = 64 * T + ch, h = T >> 1, kch = gc & 127;
        const int tok0 = row0 + ck * 16, b = tok0 >> 11, chunk = (tok0 & 2047) >> 4, bh = b * 16 + h;
        const float* cs = Cs + (ck * 16) * 256 + ch;
        const float lb = sigmoidf_(lbl[2048 + gc] - lbl[gc]);
        float bc[16], kk[16]; float bs = 0.f;
#pragma unroll
        for (int t = 0; t < 16; ++t) {
            const float fr = cs[t * 256 + 64];
            const float sg = 1.f / (1.f + __expf(-fr)), sn = 1.f / (1.f + __expf(fr));
            bs += __logf(lb + (1.f - lb) * sg);
            bc[t] = bs;
            kk[t] = (1.f - lb) * sn;
        }
        u32 kw[8], vw[8];
#pragma unroll
        for (int t = 0; t < 16; t += 2) {
            float ks[2];
#pragma unroll
            for (int u = 0; u < 2; ++u) {
                const float qv = siluf_(cs[(t + u) * 256]);
                const int fo = ((bh * 128 + chunk) * 4 + ((kch >> 3) & 3)) * 512 + ((kch >> 5) * 16 + t + u) * 8 + (kch & 7);
                QT[fo] = f2bf(qv * __expf(bc[t + u]));
                KA[fo] = f2bf(kk[t + u] * __expf(-bc[t + u]));
                ZB[(tok0 + t + u) * DM + gc] = f2bf(cs[(t + u) * 256 + 192]);
                ks[u] = kk[t + u] * __expf(bs - bc[t + u]);
            }
            kw[t >> 1] = cvt_pk(ks[0], ks[1]);
            vw[t >> 1] = cvt_pk(cs[t * 256 + 128], cs[(t + 1) * 256 + 128]);
        }
        const int o16 = ((bh * 128 + chunk) * 128 + kch) * 16;
        {
            u16* kd = KST + (((bh * 128 + chunk) * 4 + ((kch & 7) >> 1)) * 64 + (kch >> 3)) * 8 + (kch & 1) * 4;
#pragma unroll
            for (int qq = 0; qq < 4; ++qq) { u32x2 w2 = {kw[2 * qq], kw[2 * qq + 1]}; *reinterpret_cast<u32x2*>(kd + qq * 128) = w2; }
        }
        u32x4 a0 = {vw[0], vw[1], vw[2], vw[3]}, a1 = {vw[4], vw[5], vw[6], vw[7]};
        reinterpret_cast<u32x4*>(VT + o16)[0] = a0; reinterpret_cast<u32x4*>(VT + o16)[1] = a1;
        DC[(bh * 128 + chunk) * 128 + kch] = f2bf(__expf(bs));
    }
};

DI int mapA(int n) {
    if (n < 2560) return n;
    if (n < 3584) return n - 2560 + 2584;
    if (n < 4096) return n - 3584 + 3608;
    if (n < 4608) return n - 4096 + 4120;
    if (n < 5632) return n - 4608 + 4632;
    if (n < 6656) return n - 5632 + 5672;
    if (n < 6680) return n - 6656 + 2560;
    if (n < 6696) return n - 6680 + 5656;
    return -1;
}
template <int MODE>
DI void tr_tile(const float* __restrict__ src, int lds_, u16* __restrict__ dst, int ldd, int n0, int k0) {
    float* t = reinterpret_cast<float*>(smem);
    int tid = threadIdx.x; asm volatile("" : "+v"(tid));
    {
        const int nn = tid & 63, n = n0 + nn;
        int sc = n;
        if (MODE == 1) sc = mapA(n);
        if (MODE == 2) sc = n < 128 ? n : -1;
        if (MODE == 3) sc = ((n & 255) >> 6) * 2048 + 64 * (n >> 8) + (n & 63);
        float v[32];
#pragma unroll
        for (int i = 0; i < 32; ++i) v[i] = sc >= 0 ? src[(long)(k0 + i * 8 + (tid >> 6)) * lds_ + sc] : 0.f;
#pragma unroll
        for (int i = 0; i < 32; ++i) t[nn * 257 + i * 8 + (tid >> 6)] = v[i];
    }
    __syncthreads();
#pragma unroll
    for (int j = 0; j < 4; ++j) {
        const int nn = tid >> 3, k8 = (tid & 7) * 8 + j * 64;
        const float* r = t + nn * 257 + k8;
        u32x4 w = {cvt_pk(r[0], r[1]), cvt_pk(r[2], r[3]), cvt_pk(r[4], r[5]), cvt_pk(r[6], r[7])};
        *reinterpret_cast<u32x4*>(dst + (long)(n0 + nn) * ldd + k0 + k8) = w;
    }
    __syncthreads();
}

DI void rmsnorm_rows_bf16(const float* __restrict__ xa, const float* __restrict__ xb, int nsplit, int nrows,
                          const float* __restrict__ w, u16* __restrict__ dst, int rank, int count) {
    const int lane = threadIdx.x & 63, wid = threadIdx.x >> 6;
    for (int row = rank * 8 + wid; row < nrows; row += count * 8) {
        const float4* x = reinterpret_cast<const float4*>(row < nsplit ? xa + (long)row * DM : xb + (long)(row - nsplit) * DM);
        float4 v[8]; float ss = 0.f;
#pragma unroll
        for (int i = 0; i < 8; ++i) { v[i] = x[lane + 64 * i]; ss += v[i].x * v[i].x + v[i].y * v[i].y + v[i].z * v[i].z + v[i].w * v[i].w; }
        ss = wave_sum(ss);
        const float inv = rsqrtf(ss * (1.f / DM) + 1e-6f);
#pragma unroll
        for (int i = 0; i < 8; ++i) {
            const float4 g = reinterpret_cast<const float4*>(w)[lane + 64 * i];
            u32x2 o = {cvt_pk(v[i].x * inv * g.x, v[i].y * inv * g.y), cvt_pk(v[i].z * inv * g.z, v[i].w * inv * g.w)};
            *reinterpret_cast<u32x2*>(dst + (long)row * DM + (lane + 64 * i) * 4) = o;
        }
    }
}

constexpr int TRD1 = 32 * 8, TRD2 = TRD1 + 128 * 8, TRD3 = TRD2 + 32 * 8;
DI void tr_deferred(const Params& p, int t) {
    char* ws = p.ws;
    if (t < TRD1)      { tr_tile<0>(p.a_w_out, DM, (u16*)(ws + WS_WOUTA), DM, (t >> 3) * 64, (t & 7) * 256); }
    else if (t < TRD2) { const int u = t - TRD1; tr_tile<3>(p.c_w_in, NC, (u16*)(ws + WS_WINC), DM, (u >> 3) * 64, (u & 7) * 256); }
    else               { const int u = t - TRD2; tr_tile<0>(p.c_w_out, DM, (u16*)(ws + WS_WOUTC), DM, (u >> 3) * 64, (u & 7) * 256); }
}

DI void phase0(const Params& p) {
    const int tid = threadIdx.x, bid = blockIdx.x, nb = gridDim.x;
    char* ws = p.ws;
    {
        constexpr int T0 = (NAP / 64) * 8, T4 = T0 + 2 * 4 * 16, T5 = T4 + 2 * 4;
        for (int t = bid; t < T5; t += nb) {
            if (t < T0)      { tr_tile<1>(p.a_w_in, NA, (u16*)(ws + WS_WINA), DM, (t >> 3) * 64, (t & 7) * 256); }
            else if (t < T4) { const int u = t - T0, s = u >> 6, v = u & 63;
                               tr_tile<0>(p.a_cmp_w1 + (long)s * 4096 * 256, 256, (u16*)(ws + WS_W1T) + (long)s * 256 * 4096, 4096, (v >> 4) * 64, (v & 15) * 256); }
            else             { const int u = t - T4, s = u >> 2, v = u & 3;
                               tr_tile<2>(p.a_cmp_w2 + (long)s * 256 * 128, 128, (u16*)(ws + WS_W2T) + (long)s * 256 * 256, 256, v * 64, 0); }
        }
    }
    rmsnorm_rows_bf16(p.x_prompt, p.x_sample, NTP, NT, p.a_norm, (u16*)(ws + WS_H), blockIdx.x, gridDim.x);
    for (int it = bid; it < 8; it += nb) {
        const int slot = it >> 2, e4 = (it & 3) * 64 + (tid & 15) * 4, kg = tid >> 4;
        const float* w1 = p.a_cmp_w1 + (long)slot * 4096 * 256 + e4;
        const float* pe = p.a_cmp_pe + slot * 4096;
        f32x4 s = {0.f, 0.f, 0.f, 0.f};
        for (int k0 = kg; k0 < 4096; k0 += 32 * 8) {
            f32x4 wv[8]; float pv[8];
#pragma unroll
            for (int u = 0; u < 8; ++u) { wv[u] = *reinterpret_cast<const f32x4*>(w1 + (long)(k0 + 32 * u) * 256); pv[u] = pe[k0 + 32 * u]; }
#pragma unroll
            for (int u = 0; u < 8; ++u) s += wv[u] * pv[u];
        }
        f32x4* red = reinterpret_cast<f32x4*>(smem);
        red[tid] = s;
        __syncthreads();
        if (tid < 16) {
            f32x4 a = {0.f, 0.f, 0.f, 0.f};
            for (int j = 0; j < 32; ++j) a += red[j * 16 + tid];
            const f32x4 b1 = *reinterpret_cast<const f32x4*>(p.a_cmp_b1 + slot * 256 + e4);
            *reinterpret_cast<f32x4*>(reinterpret_cast<float*>(ws + WS_HCONST) + slot * 256 + e4) = a + b1;
        }
        __syncthreads();
    }
}

template <int KS> DI int lds_byte_ks(int r, int c) {
    int st = (r >> 4) * KS + (c >> 5), ob = (r & 15) * 64 + (c & 31) * 2;
    return st * 1024 + (ob ^ (((ob >> 9) & 1) << 5));
}
DI void cmp_gemm_tile(const Params& p, int slot, int bg) {
    char* ws = p.ws;
    constexpr int TA = 128 * 32 * 4, TB = 512 * 32 * 2, NA = 5, B_OFF = NA * TA;
    int tid = threadIdx.x; asm volatile("" : "+v"(tid));
    const int wid = __builtin_amdgcn_readfirstlane(tid >> 6), lane = tid & 63, wr = wid >> 2, wc = wid & 3, fr = lane & 15, fq = lane >> 4;
    const int b = bg >> 1, g = bg & 1;
    const bool awave = wid < 4;
    const int t4 = tid & 255;
    int aoff[4];
#pragma unroll
    for (int i = 0; i < 4; ++i) {
        const int n = 32 * i + (t4 >> 3), sl = (t4 & 7) ^ (((n & 1) << 1) | ((n >> 1) & 1) | (n & 4));
        aoff[i] = (p.page_table[b * 16 + (n >> 3)] * 128 + 16 * (n & 7)) * 1024 + slot * 256 + g * 128 + sl * 4;
    }
    const u16* Bb = (const u16*)(ws + WS_W1T) + (long)slot * 256 * 4096;
    int boff[8];
#pragma unroll
    for (int i = 0; i < 8; ++i) {
        const int bb = (wid & 3) * 1024 + i * 4096 + lane * 16, st = bb >> 10, sb = bb & 1023, swz = sb ^ (((sb >> 9) & 1) << 5);
        const int R = st * 16 + swz / 64, C = (swz % 64) / 2;
        boff[i] = (R & 255) * 4096 + (R >> 8) * 2048 + C;
    }
    auto issue_a = [&](int kt) {
        char* l = smem + (kt % NA) * TA;
        const int o = (kt >> 2) * 1024 + (kt & 3) * 32;
#pragma unroll
        for (int i = 0; i < 4; ++i) __builtin_amdgcn_global_load_lds((const unsigned*)(p.cache_kv + aoff[i] + o), (unsigned*)(l + (i * 256 + t4) * 16), 16, 0, 0);
    };
    auto issue_b = [&](int kt) {
        char* l = smem + B_OFF + (kt & 1) * TB;
#pragma unroll
        for (int i = 0; i < 8; ++i) __builtin_amdgcn_global_load_lds((const unsigned*)(Bb + boff[i] + kt * 32), (unsigned*)(l + (wid & 3) * 1024 + i * 4096 + lane * 16), 16, 0, 0);
    };
    f32x4 acc[4][8];
#pragma unroll
    for (int m = 0; m < 4; ++m)
#pragma unroll
        for (int n = 0; n < 8; ++n) acc[m][n] = (f32x4){0.f, 0.f, 0.f, 0.f};
    constexpr int nt = 64;
    if (awave) { issue_a(0); issue_a(1); issue_a(2); issue_a(3); } else { issue_b(0); }
    for (int t = 0; t < nt; ++t) {
        if (awave) {
            const int rem = nt - t;
            if (rem >= 4) asm volatile("s_waitcnt vmcnt(12)" ::: "memory");
            else if (rem == 3) asm volatile("s_waitcnt vmcnt(8)" ::: "memory");
            else if (rem == 2) asm volatile("s_waitcnt vmcnt(4)" ::: "memory");
            else asm volatile("s_waitcnt vmcnt(0)" ::: "memory");
        } else {
            asm volatile("s_waitcnt vmcnt(0)" ::: "memory");
        }
        __builtin_amdgcn_s_barrier();
        if (awave) { if (t + 4 < nt) issue_a(t + 4); } else { if (t + 1 < nt) issue_b(t + 1); }
        const char* sA = smem + (t % NA) * TA; const char* sB = smem + B_OFF + (t & 1) * TB;
        bf16x8 At[4];
#pragma unroll
        for (int m = 0; m < 4; ++m) {
            const char* ra = sA + (wr * 64 + m * 16 + fr) * 128;
            const int sg = ((fr & 1) << 1) | ((fr >> 1) & 1) | (fr & 4);
            const f32x4 x0 = *reinterpret_cast<const f32x4*>(ra + (((2 * fq) ^ sg) << 4));
            const f32x4 x1 = *reinterpret_cast<const f32x4*>(ra + (((2 * fq + 1) ^ sg) << 4));
            At[m] = mk8(cvt_pk(x0[0], x0[1]), cvt_pk(x0[2], x0[3]), cvt_pk(x1[0], x1[1]), cvt_pk(x1[2], x1[3]));
        }
#pragma unroll
        for (int nh = 0; nh < 2; ++nh) {
            bf16x8 Bf[4];
#pragma unroll
            for (int n = 0; n < 4; ++n) Bf[n] = *reinterpret_cast<const bf16x8*>(sB + lds_byte_ks<1>(wc * 128 + (nh * 4 + n) * 16 + fr, fq * 8));
#pragma unroll
            for (int m = 0; m < 4; ++m)
#pragma unroll
                for (int n = 0; n < 4; ++n) acc[m][nh * 4 + n] = mfma16(At[m], Bf[n], acc[m][nh * 4 + n]);
        }
    }
    __syncthreads();
    float* Cs = reinterpret_cast<float*>(smem);
    if (wc >= 2) {
#pragma unroll
        for (int m = 0; m < 4; ++m)
#pragma unroll
            for (int n = 0; n < 8; ++n)
#pragma unroll
                for (int j = 0; j < 4; ++j) Cs[(wr * 64 + m * 16 + fq * 4 + j) * 256 + (wc - 2) * 128 + n * 16 + fr] = acc[m][n][j];
    }
    __syncthreads();
    if (wc < 2) {
        const float* hc = reinterpret_cast<const float*>(ws + WS_HCONST) + slot * 256;
        u16* A2 = (u16*)(ws + WS_A2S) + ((long)slot * 32768 + bg * 128) * 256;
#pragma unroll
        for (int n = 0; n < 8; ++n) {
            const int col = wc * 128 + n * 16 + fr;
            const float h0 = hc[col];
#pragma unroll
            for (int m = 0; m < 4; ++m)
#pragma unroll
                for (int j = 0; j < 4; ++j) {
                    const int row = wr * 64 + m * 16 + fq * 4 + j;
                    const float u1 = Cs[min(row + 1, 127) * 256 + col];
                    A2[row * 256 + col] = (row == 127) ? (u16)0 : f2bf(gelu_tanh(acc[m][n][j] + u1 + h0));
                    asm volatile("" ::: "memory");
                }
        }
    }
    asm volatile("s_waitcnt vmcnt(0)" ::: "memory");
    __syncthreads();
}
DI void phase1(const Params& p) {
    char* ws = p.ws;
    const int nb = gridDim.x, bid = blockIdx.x;
    const int n_full = (34 * 27 - 1 - bid) / nb + 1;
    const int n_cmp = bid < 256 ? (256 - 1 - bid) / nb + 1 : 0;
    const int cmp_at = (bid & 1) ? n_full : 0;
    int n_in = 0, n_c = 0;
#if defined(DBG_DUP1A) || defined(DBG_DUP1B) || defined(DBG_DUP1C)
    for (int rep = 0; rep < 2; ++rep) { n_in = 0; n_c = 0;
#endif
    for (int k = 0; k < n_full + n_cmp; ++k) {
        const bool is_cmp = (k >= cmp_at) && (n_c < n_cmp);
#ifdef DBG_DUP1A
        if (rep == 1 && is_cmp) { ++n_c; continue; }
#endif
#if defined(DBG_DUP1B) || defined(DBG_DUP1C)
        if (rep == 1 && !is_cmp) { ++n_in; continue; }
#endif
        if (is_cmp) {
            const int t = bid + n_c * nb, slot = t >> 7, rt = t & 127;
            cmp_gemm_tile(p, slot, 2 * rt);
            cmp_gemm_tile(p, slot, 2 * rt + 1);
            EpiCmp2S e{(float*)(ws + WS_KCS) + (long)slot * 32768 * 128};
            gemm_tile((const u16*)(ws + WS_A2S) + (long)slot * 32768 * 256, 256, (const u16*)(ws + WS_W2T) + (long)slot * 256 * 256, 256, 256, rt * 256, 0, e);
            ++n_c;
        } else {
            const int u = bid + n_in * nb, pm = u % 34, pn = u / 34;
            EpiInA e{(float*)(ws + WS_PROJ), (u16*)(ws + WS_Q), (u16*)(ws + WS_KV6), (u16*)(ws + WS_VT), (u16*)(ws + WS_KF), p.out};
            gemm_tile((const u16*)(ws + WS_H), DM, (const u16*)(ws + WS_WINA), DM, DM, pm * 256, pn * 256, e);
            ++n_in;
        }
    }
#if defined(DBG_DUP1A) || defined(DBG_DUP1B) || defined(DBG_DUP1C)
    }
#endif
    {
        const int rem = (34 * 27) % nb;
        const int sidx = rem == 0 ? bid : bid - rem, scount = rem == 0 ? nb : nb - rem;
        if (sidx >= 0) for (int t = sidx; t < TRD3; t += scount) tr_deferred(p, t);
    }
}

template <int NVT>
DI void rec_prep2(const u16* __restrict__ QT, const u16* __restrict__ KA, const u16* __restrict__ VTc,
                  float* __restrict__ OI, int chunk) {
    const int lane = threadIdx.x & 63, c = lane & 15, q = lane >> 4;
    bf16x8 fa[4], fb[4];
#pragma unroll
    for (int m = 0; m < 4; ++m) { const int o = ((chunk * 4 + q) * 64 + m * 16 + c) * 8; fa[m] = ld8(KA + o); fb[m] = ld8(QT + o); }
    u32x2 w[NVT];
#pragma unroll
    for (int vt = 0; vt < NVT; ++vt) w[vt] = *reinterpret_cast<const u32x2*>(VTc + ((chunk * NVT + vt) * 16 + c) * 16 + 4 * q);
    f32x4 att = {0.f, 0.f, 0.f, 0.f};
#pragma unroll
    for (int m = 0; m < 4; ++m) att = mfma16(fa[m], fb[m], att);
#pragma unroll
    for (int jj = 0; jj < 4; ++jj) if (4 * q + jj > c) att[jj] = 0.f;
    const bf16x8 Pa = mk8(cvt_pk(att[0], att[1]), cvt_pk(att[2], att[3]), 0u, 0u);
#pragma unroll
    for (int vt = 0; vt < NVT; ++vt) {
        const f32x4 zero4 = {0.f, 0.f, 0.f, 0.f};
        const f32x4 o = mfma16(Pa, mk8(w[vt].x, w[vt].y, 0u, 0u), zero4);
        *reinterpret_cast<f32x4*>(OI + ((chunk * NVT + vt) * 64 + lane) * 4) = o;
    }
}

using bf16x4 = __attribute__((ext_vector_type(4))) short;
DI bf16x4 ld4(const u16* p) { return *reinterpret_cast<const bf16x4*>(p); }
DI f32x4 mfma16k16(bf16x4 a, bf16x4 b, f32x4 c) { return __builtin_amdgcn_mfma_f32_16x16x16bf16_1k(a, b, c, 0, 0, 0); }
struct RecOps { bf16x8 Aq[4]; bf16x8 Ak[4]; u32x4 dv[4]; bf16x4 Bu; f32x4 oi; };
template <int NVT>
DI void rec_load(RecOps& R, const u16* __restrict__ QT, const u16* __restrict__ KST, const u16* __restrict__ VTc,
                 const u16* __restrict__ DC, const float* __restrict__ OI, int vt, int ch, int lane) {
    const int c = lane & 15, q = lane >> 4;
    const u16* qt = QT + ch * 2048 + lane * 8;
#pragma unroll
    for (int pp = 0; pp < 4; ++pp) R.Aq[pp] = ld8(qt + pp * 512);
    const u16* ks = KST + ch * 2048 + lane * 8;
#pragma unroll
    for (int r2 = 0; r2 < 4; ++r2) R.Ak[r2] = ld8(ks + r2 * 512);
    const u16* dc = DC + ch * 128 + 32 * q;
#pragma unroll
    for (int i = 0; i < 4; ++i) R.dv[i] = *reinterpret_cast<const u32x4*>(dc + 8 * i);
    R.Bu = ld4(VTc + ((ch * NVT + vt) * 16 + c) * 16 + 4 * q);
    R.oi = *reinterpret_cast<const f32x4*>(OI + ((ch * NVT + vt) * 64 + lane) * 4);
}
DI void rec_step(const RecOps& R, f32x4 (&S)[8], float* __restrict__ Orow, int ldo) {
    f32x4 o = R.oi;
#pragma unroll
    for (int pp = 0; pp < 4; ++pp) {
        const bf16x8 Bs = mk8(cvt_pk(S[0][pp], S[1][pp]), cvt_pk(S[2][pp], S[3][pp]), cvt_pk(S[4][pp], S[5][pp]), cvt_pk(S[6][pp], S[7][pp]));
        o = mfma16(R.Aq[pp], Bs, o);
    }
#pragma unroll
    for (int jj = 0; jj < 4; ++jj) Orow[jj * ldo] = o[jj];
#pragma unroll
    for (int rt = 0; rt < 8; ++rt) {
        f32x4 d;
#pragma unroll
        for (int jj = 0; jj < 4; ++jj) d[jj] = (rt & 1) ? bfhi(R.dv[jj][rt >> 1]) : bflo(R.dv[jj][rt >> 1]);
        const bf16x4 ak = (rt & 1) ? __builtin_shufflevector(R.Ak[rt >> 1], R.Ak[rt >> 1], 4, 5, 6, 7) : __builtin_shufflevector(R.Ak[rt >> 1], R.Ak[rt >> 1], 0, 1, 2, 3);
        S[rt] = mfma16k16(ak, R.Bu, S[rt] * d);
    }
}
template <int NVT>
DI void rec_walker(const u16* __restrict__ QT, const u16* __restrict__ KST, const u16* __restrict__ VTc,
                   const u16* __restrict__ DC, const float* __restrict__ OI, int vt,
                   float* __restrict__ O, int ldo, float* __restrict__ Sout, int DV) {
    int lane = threadIdx.x & 63; asm volatile("" : "+v"(lane));
    const int c = lane & 15, q = lane >> 4;
    f32x4 S[8];
#pragma unroll
    for (int rt = 0; rt < 8; ++rt) S[rt] = (f32x4){0.f, 0.f, 0.f, 0.f};
    float* o0 = O + (4 * q) * ldo + 16 * vt + c;
    RecOps A, B, C;
    rec_load<NVT>(A, QT, KST, VTc, DC, OI, vt, 0, lane);
    rec_load<NVT>(B, QT, KST, VTc, DC, OI, vt, 1, lane);
    rec_load<NVT>(C, QT, KST, VTc, DC, OI, vt, 2, lane);
    for (int ch = 0; ch < 126; ch += 3) {
        __builtin_amdgcn_sched_barrier(0);
        rec_step(A, S, o0 + (ch * 16) * ldo, ldo);
        __builtin_amdgcn_sched_barrier(0);
        rec_load<NVT>(A, QT, KST, VTc, DC, OI, vt, ch + 3, lane);
        __builtin_amdgcn_sched_barrier(0);
        rec_step(B, S, o0 + ((ch + 1) * 16) * ldo, ldo);
        __builtin_amdgcn_sched_barrier(0);
        rec_load<NVT>(B, QT, KST, VTc, DC, OI, vt, ch + 4, lane);
        __builtin_amdgcn_sched_barrier(0);
        rec_step(C, S, o0 + ((ch + 2) * 16) * ldo, ldo);
        __builtin_amdgcn_sched_barrier(0);
        rec_load<NVT>(C, QT, KST, VTc, DC, OI, vt, min(ch + 5, 127), lane);
    }
    __builtin_amdgcn_sched_barrier(0);
    rec_step(A, S, o0 + (126 * 16) * ldo, ldo);
    rec_step(B, S, o0 + (127 * 16) * ldo, ldo);
#pragma unroll
    for (int rt = 0; rt < 8; ++rt)
#pragma unroll
        for (int jj = 0; jj < 4; ++jj) Sout[(32 * q + 8 * jj + rt) * DV + 16 * vt + c] = S[rt][jj];
}

constexpr int RW_SLOTS = 8, RW_PAIR_BYTES = RW_SLOTS * 4096 + 64, RW_OFF = 32768;
DI void rw_wait_gt(volatile LAS int* f, int v) { while (*f <= v) __builtin_amdgcn_s_sleep(1); asm volatile("" ::: "memory"); }
struct RecSt { bf16x8 Ak[4]; u32x4 dv[4]; bf16x4 Bu; };
template <int NVT>
DI void rs_load(RecSt& R, const u16* __restrict__ KST, const u16* __restrict__ VTc, const u16* __restrict__ DC, int vt, int ch, int lane) {
    const int c = lane & 15, q = lane >> 4;
    const u16* ks = KST + ch * 2048 + lane * 8;
#pragma unroll
    for (int r2 = 0; r2 < 4; ++r2) R.Ak[r2] = ld8(ks + r2 * 512);
    const u16* dc = DC + ch * 128 + 32 * q;
#pragma unroll
    for (int i = 0; i < 4; ++i) R.dv[i] = *reinterpret_cast<const u32x4*>(dc + 8 * i);
    R.Bu = ld4(VTc + ((ch * NVT + vt) * 16 + c) * 16 + 4 * q);
}
DI void rs_step(const RecSt& R, f32x4 (&S)[8], char* __restrict__ slot, volatile LAS int* prod, volatile LAS int* cons, int s, int lane) {
    rw_wait_gt(cons, s - RW_SLOTS);
#pragma unroll
    for (int pp = 0; pp < 4; ++pp) {
        const bf16x8 Bs = mk8(cvt_pk(S[0][pp], S[1][pp]), cvt_pk(S[2][pp], S[3][pp]), cvt_pk(S[4][pp], S[5][pp]), cvt_pk(S[6][pp], S[7][pp]));
        *reinterpret_cast<bf16x8*>(slot + pp * 1024 + lane * 16) = Bs;
    }
    asm volatile("" ::: "memory");
    *prod = s + 1;
#pragma unroll
    for (int rt = 0; rt < 8; ++rt) {
        f32x4 d;
#pragma unroll
        for (int jj = 0; jj < 4; ++jj) d[jj] = (rt & 1) ? bfhi(R.dv[jj][rt >> 1]) : bflo(R.dv[jj][rt >> 1]);
        const bf16x4 ak = (rt & 1) ? __builtin_shufflevector(R.Ak[rt >> 1], R.Ak[rt >> 1], 4, 5, 6, 7) : __builtin_shufflevector(R.Ak[rt >> 1], R.Ak[rt >> 1], 0, 1, 2, 3);
        S[rt] = mfma16k16(ak, R.Bu, S[rt] * d);
    }
}
template <int NVT>
DI void rec_state_wave(const u16* __restrict__ KST, const u16* __restrict__ VTc, const u16* __restrict__ DC, int vt,
                       float* __restrict__ Sout, int DV, int ring_off) {
    char* ring = smem + ring_off;
    int lane = threadIdx.x & 63; asm volatile("" : "+v"(lane));
    const int c = lane & 15, q = lane >> 4;
    volatile LAS int* prod = (volatile LAS int*)(ring + RW_SLOTS * 4096);
    volatile LAS int* cons = prod + 1;
    f32x4 S[8];
#pragma unroll
    for (int rt = 0; rt < 8; ++rt) S[rt] = (f32x4){0.f, 0.f, 0.f, 0.f};
    RecSt R[4];
#pragma unroll
    for (int i = 0; i < 4; ++i) rs_load<NVT>(R[i], KST, VTc, DC, vt, i, lane);
    for (int ch = 0; ch < 128; ch += 4) {
#pragma unroll
        for (int i = 0; i < 4; ++i) {
            __builtin_amdgcn_sched_barrier(0);
            rs_step(R[i], S, ring + ((ch + i) & (RW_SLOTS - 1)) * 4096, prod, cons, ch + i, lane);
            __builtin_amdgcn_sched_barrier(0);
            rs_load<NVT>(R[i], KST, VTc, DC, vt, min(ch + i + 4, 127), lane);
        }
    }
#pragma unroll
    for (int rt = 0; rt < 8; ++rt)
#pragma unroll
        for (int jj = 0; jj < 4; ++jj) Sout[(32 * q + 8 * jj + rt) * DV + 16 * vt + c] = S[rt][jj];
}
struct RecOut { bf16x8 Aq[4]; f32x4 oi; };
template <int NVT>
DI void ro_load(RecOut& R, const u16* __restrict__ QT, const float* __restrict__ OI, int vt, int ch, int lane) {
    const u16* qt = QT + ch * 2048 + lane * 8;
#pragma unroll
    for (int pp = 0; pp < 4; ++pp) R.Aq[pp] = ld8(qt + pp * 512);
    R.oi = *reinterpret_cast<const f32x4*>(OI + ((ch * NVT + vt) * 64 + lane) * 4);
}
template <int NVT>
DI void rec_out_wave(const u16* __restrict__ QT, const float* __restrict__ OI, int vt, float* __restrict__ O, int ldo, int ring_off) {
    char* ring = smem + ring_off;
    int lane = threadIdx.x & 63; asm volatile("" : "+v"(lane));
    const int c = lane & 15, q = lane >> 4;
    volatile LAS int* prod = (volatile LAS int*)(ring + RW_SLOTS * 4096);
    volatile LAS int* cons = prod + 1;
    float* o0 = O + (4 * q) * ldo + 16 * vt + c;
    RecOut R[4];
#pragma unroll
    for (int i = 0; i < 4; ++i) ro_load<NVT>(R[i], QT, OI, vt, i, lane);
    for (int ch = 0; ch < 128; ch += 4) {
#pragma unroll
        for (int i = 0; i < 4; ++i) {
            const int s = ch + i;
            __builtin_amdgcn_sched_barrier(0);
            rw_wait_gt(prod, s);
            const char* slot = ring + (s & (RW_SLOTS - 1)) * 4096 + lane * 16;
            bf16x8 Bs[4];
#pragma unroll
            for (int pp = 0; pp < 4; ++pp) Bs[pp] = *reinterpret_cast<const bf16x8*>(slot + pp * 1024);
            f32x4 o = R[i].oi;
#pragma unroll
            for (int pp = 0; pp < 4; ++pp) o = mfma16(R[i].Aq[pp], Bs[pp], o);
            asm volatile("" ::: "memory");
            *cons = s + 1;
            float* orow = o0 + (s * 16) * ldo;
#pragma unroll
            for (int jj = 0; jj < 4; ++jj) orow[jj * ldo] = o[jj];
            __builtin_amdgcn_sched_barrier(0);
            ro_load<NVT>(R[i], QT, OI, vt, min(s + 4, 127), lane);
        }
    }
}

DI void gla_prep(const Params& p, int rank, int count) {
    char* ws = p.ws;
    const float* proj = (const float*)(ws + WS_PROJ);
    u16* QT = (u16*)(ws + WS_GQT); u16* KA = (u16*)(ws + WS_GKA); u16* KST = (u16*)(ws + WS_GKST); u16* VT = (u16*)(ws + WS_GVT);
    u16* DC = (u16*)(ws + WS_GDC);
    const int tid = threadIdx.x;
    for (int base = rank * 4; base < 2048; base += count * 4) {
        const int item = base + (tid >> 7), ch = tid & 127;
        const int b = item >> 9, h = (item >> 7) & 3, chunk = item & 127;
        const long tok0 = (long)b * 2048 + chunk * 16;
        float gw[16];
#pragma unroll
        for (int r = 0; r < 16; ++r) gw[r] = p.a_gla_w2[r * 512 + h * 128 + ch];
        const float gb = p.a_gla_b[h * 128 + ch];
        float bc[16]; float bs = 0.f;
#pragma unroll
        for (int t = 0; t < 16; ++t) {
            const float* lr = proj + (tok0 + t) * NAP + CLR;
            float z = gb;
#pragma unroll
            for (int r = 0; r < 16; ++r) z += lr[r] * gw[r];
            bs += logsigmoidf_(z) * (1.f / 16.f);
            bc[t] = bs;
        }
        u32 kw[8];
#pragma unroll
        for (int t = 0; t < 16; t += 2) {
            float kk[2];
#pragma unroll
            for (int u = 0; u < 2; ++u) {
                const float* pr = proj + (tok0 + t + u) * NAP;
                const float qv = pr[CQB + h * 128 + ch] * QSCALE, kv = pr[CKB + h * 128 + ch];
                const int fo = (((b * 4 + h) * 128 + chunk) * 4 + ((ch >> 3) & 3)) * 512 + ((ch >> 5) * 16 + t + u) * 8 + (ch & 7);
                QT[fo] = f2bf(qv * __expf(bc[t + u]));
                KA[fo] = f2bf(kv * __expf(-bc[t + u]));
                kk[u] = kv * __expf(bs - bc[t + u]);
            }
            kw[t >> 1] = cvt_pk(kk[0], kk[1]);
        }
        {
            u16* kd = KST + ((((long)(b * 4 + h) * 128 + chunk) * 4 + ((ch & 7) >> 1)) * 64 + (ch >> 3)) * 8 + (ch & 1) * 4;
#pragma unroll
            for (int qq = 0; qq < 4; ++qq) { u32x2 w2 = {kw[2 * qq], kw[2 * qq + 1]}; *reinterpret_cast<u32x2*>(kd + qq * 128) = w2; }
        }
        DC[((long)(b * 4 + h) * 128 + chunk) * 128 + ch] = f2bf(__expf(bs));
    }
    for (long i = (long)rank * 512 + tid; i < (long)16 * 128 * 256; i += (long)count * 512) {
        const int v = (int)(i & 255), chunk = (int)((i >> 8) & 127), bh = (int)(i >> 15), b = bh >> 2, h = bh & 3;
        const long tok0 = (long)b * 2048 + chunk * 16;
        u32 w[8];
#pragma unroll
        for (int t = 0; t < 16; t += 2)
            w[t >> 1] = cvt_pk(proj[(tok0 + t) * NAP + CVB + h * 256 + v], proj[(tok0 + t + 1) * NAP + CVB + h * 256 + v]);
        u32x4* d = reinterpret_cast<u32x4*>(VT + i * 16);
        u32x4 a0 = {w[0], w[1], w[2], w[3]}, a1 = {w[4], w[5], w[6], w[7]};
        d[0] = a0; d[1] = a1;
    }
}

DI void hgrn_prep(const Params& p) {
    char* ws = p.ws;
    const float* pc = (const float*)(ws + WS_PROJC);
    u16* QT = (u16*)(ws + WS_HQT); u16* KA = (u16*)(ws + WS_HKA); u16* KST = (u16*)(ws + WS_HKST); u16* VT = (u16*)(ws + WS_HVT);
    float* DC = (float*)(ws + WS_HDC);
    const int tid = threadIdx.x;
    for (int base = blockIdx.x * 4; base < 64 * 128; base += gridDim.x * 4) {
        const int item = base + (tid >> 7), ch = tid & 127;
        const int bh = item >> 7, b = bh >> 4, h = bh & 15, chunk = item & 127;
        const long tok0 = (long)b * 2048 + chunk * 16;
        const int gc = h * 128 + ch;
        const float lb = sigmoidf_(p.c_lb_logits[2048 + gc] - p.c_lb_logits[gc]);
        float bc[16], kk[16]; float bs = 0.f;
#pragma unroll
        for (int t = 0; t < 16; ++t) {
            const float fr = pc[(tok0 + t) * NC + 2048 + gc];
            const float sg = 1.f / (1.f + __expf(-fr)), sn = 1.f / (1.f + __expf(fr));
            bs += __logf(lb + (1.f - lb) * sg);
            bc[t] = bs;
            kk[t] = (1.f - lb) * sn;
        }
        u32 kw[8];
#pragma unroll
        for (int t = 0; t < 16; t += 2) {
            float ks[2];
#pragma unroll
            for (int u = 0; u < 2; ++u) {
                const float qv = siluf_(pc[(tok0 + t + u) * NC + gc]);
                QT[(tok0 + t + u) * DM + gc] = f2bf(qv * __expf(bc[t + u]));
                KA[(tok0 + t + u) * DM + gc] = f2bf(kk[t + u] * __expf(-bc[t + u]));
                ks[u] = kk[t + u] * __expf(bs - bc[t + u]);
            }
            kw[t >> 1] = cvt_pk(ks[0], ks[1]);
        }
        u32x4* kd = reinterpret_cast<u32x4*>(KST + (((long)bh * 128 + chunk) * 128 + ch) * 16);
        u32x4 k0 = {kw[0], kw[1], kw[2], kw[3]}, k1 = {kw[4], kw[5], kw[6], kw[7]};
        kd[0] = k0; kd[1] = k1;
        DC[((long)bh * 128 + chunk) * 128 + ch] = __expf(bs);
        u32 w[8];
#pragma unroll
        for (int t = 0; t < 16; t += 2) w[t >> 1] = cvt_pk(pc[(tok0 + t) * NC + 4096 + gc], pc[(tok0 + t + 1) * NC + 4096 + gc]);
        u32x4* d = reinterpret_cast<u32x4*>(VT + (((long)bh * 128 + chunk) * 128 + ch) * 16);
        u32x4 a0 = {w[0], w[1], w[2], w[3]}, a1 = {w[4], w[5], w[6], w[7]};
        d[0] = a0; d[1] = a1;
    }
}

DI void gla_sample_item(const Params& p, int b, int h) {
    char* ws = p.ws;
    const float* proj = (const float*)(ws + WS_PROJ);
    float* L = reinterpret_cast<float*>(smem);
    float* La = L; float* Lk = L + 512; float* Lq = L + 1024; float* Lv = L + 1536; float* Lp = L + 2560; float* Lr = L + 4608;
    int tid = threadIdx.x; asm volatile("" : "+v"(tid));
    {
        const int t = tid >> 7, ch = tid & 127;
        const float* pr = proj + (long)(NTP + b * 4 + t) * NAP;
        float z = p.a_gla_b[h * 128 + ch];
#pragma unroll
        for (int r = 0; r < 16; ++r) z += pr[CLR + r] * p.a_gla_w2[r * 512 + h * 128 + ch];
        La[tid] = __expf(logsigmoidf_(z) * (1.f / 16.f));
        Lk[tid] = pr[CKB + h * 128 + ch];
        Lq[tid] = pr[CQB + h * 128 + ch] * QSCALE;
        for (int i = tid; i < 1024; i += 512) Lv[i] = proj[(long)(NTP + b * 4 + (i >> 8)) * NAP + CVB + h * 256 + (i & 255)];
    }
    __syncthreads();
    {
        const int v = tid & 255, kh = tid >> 8;
        const float* S0 = p.state_gla + ((long)(b * 4 + h) * 128) * 256;
        float* S1 = p.out + O_GLAS + ((long)(b * 4 + h) * 128) * 256;
        const float v0 = Lv[v], v1 = Lv[256 + v], v2 = Lv[512 + v], v3 = Lv[768 + v];
        float o0 = 0.f, o1 = 0.f, o2 = 0.f, o3 = 0.f;
#pragma unroll 16
        for (int kk = 0; kk < 64; ++kk) {
            const int k = kh * 64 + kk;
            float s = S0[(long)k * 256 + v];
            s = La[k] * s + Lk[k] * v0;             o0 += Lq[k] * s;
            s = La[128 + k] * s + Lk[128 + k] * v1; o1 += Lq[128 + k] * s;
            s = La[256 + k] * s + Lk[256 + k] * v2; o2 += Lq[256 + k] * s;
            s = La[384 + k] * s + Lk[384 + k] * v3; o3 += Lq[384 + k] * s;
            S1[(long)k * 256 + v] = s;
        }
        Lp[(0 * 2 + kh) * 256 + v] = o0; Lp[(1 * 2 + kh) * 256 + v] = o1; Lp[(2 * 2 + kh) * 256 + v] = o2; Lp[(3 * 2 + kh) * 256 + v] = o3;
    }
    __syncthreads();
    {
        const int w = tid >> 6, lane = tid & 63, t = w >> 1, v = (w & 1) * 128 + lane * 2;
        const float a0 = Lp[(t * 2) * 256 + v] + Lp[(t * 2 + 1) * 256 + v], a1 = Lp[(t * 2) * 256 + v + 1] + Lp[(t * 2 + 1) * 256 + v + 1];
        const float ss = wave_sum(a0 * a0 + a1 * a1);
        if (lane == 0) Lr[w] = ss;
        __syncthreads();
        const float inv = rsqrtf((Lr[t * 2] + Lr[t * 2 + 1]) * (1.f / 256.f) + 1e-6f);
        const long tok = NTP + b * 4 + t;
        const float* zb = proj + tok * NAP + CZB + h * 256 + v;
        u16* oa = (u16*)(ws + WS_OA) + tok * DM + 1024 + h * 256 + v;
        *reinterpret_cast<u32*>(oa) = cvt_pk(a0 * inv * p.a_gla_gn[v] * siluf_(zb[0]), a1 * inv * p.a_gla_gn[v + 1] * siluf_(zb[1]));
    }
    __syncthreads();
}

DI void gla_sample_wave(const Params& p, int b, int h, float* __restrict__ Lw) {
    char* ws = p.ws;
    const float* proj = (const float*)(ws + WS_PROJ);
    int lane = threadIdx.x & 63; asm volatile("" : "+v"(lane));
    float* La = Lw; float* Lk = Lw + 512; float* Lq = Lw + 1024;
    const long tok0 = NTP + b * 4;
#pragma unroll
    for (int t = 0; t < 4; ++t) {
        const float* pr = proj + (tok0 + t) * NAP;
#pragma unroll
        for (int u = 0; u < 2; ++u) {
            const int ch = lane + 64 * u;
            float z = p.a_gla_b[h * 128 + ch];
#pragma unroll
            for (int r = 0; r < 16; ++r) z += pr[CLR + r] * p.a_gla_w2[r * 512 + h * 128 + ch];
            La[ch * 4 + t] = __expf(logsigmoidf_(z) * (1.f / 16.f));
            Lk[ch * 4 + t] = pr[CKB + h * 128 + ch];
            Lq[ch * 4 + t] = pr[CQB + h * 128 + ch] * QSCALE;
        }
    }
    f32x4 vv[4], o[4];
#pragma unroll
    for (int t = 0; t < 4; ++t) {
        vv[t] = *reinterpret_cast<const f32x4*>(proj + (tok0 + t) * NAP + CVB + h * 256 + lane * 4);
        o[t] = (f32x4){0.f, 0.f, 0.f, 0.f};
    }
    const float* S0 = p.state_gla + ((long)(b * 4 + h) * 128) * 256 + lane * 4;
    float* S1 = p.out + O_GLAS + ((long)(b * 4 + h) * 128) * 256 + lane * 4;
    for (int k0 = 0; k0 < 128; k0 += 16) {
        f32x4 s[16];
#pragma unroll
        for (int kk = 0; kk < 16; ++kk) s[kk] = *reinterpret_cast<const f32x4*>(S0 + (long)(k0 + kk) * 256);
#pragma unroll
        for (int kk = 0; kk < 16; ++kk) {
            const f32x4 a = *reinterpret_cast<const f32x4*>(La + (k0 + kk) * 4), kx = *reinterpret_cast<const f32x4*>(Lk + (k0 + kk) * 4),
                        qx = *reinterpret_cast<const f32x4*>(Lq + (k0 + kk) * 4);
#pragma unroll
            for (int t = 0; t < 4; ++t) { s[kk] = s[kk] * a[t] + vv[t] * kx[t]; o[t] += s[kk] * qx[t]; }
            *reinterpret_cast<f32x4*>(S1 + (long)(k0 + kk) * 256) = s[kk];
        }
    }
    const f32x4 gn = *reinterpret_cast<const f32x4*>(p.a_gla_gn + lane * 4);
#pragma unroll
    for (int t = 0; t < 4; ++t) {
        const float ss = wave_sum(o[t][0] * o[t][0] + o[t][1] * o[t][1] + o[t][2] * o[t][2] + o[t][3] * o[t][3]);
        const float inv = rsqrtf(ss * (1.f / 256.f) + 1e-6f);
        const f32x4 z = *reinterpret_cast<const f32x4*>(proj + (tok0 + t) * NAP + CZB + h * 256 + lane * 4);
        u32x2 w2 = {cvt_pk(o[t][0] * inv * gn[0] * siluf_(z[0]), o[t][1] * inv * gn[1] * siluf_(z[1])),
                    cvt_pk(o[t][2] * inv * gn[2] * siluf_(z[2]), o[t][3] * inv * gn[3] * siluf_(z[3]))};
        *reinterpret_cast<u32x2*>((u16*)(ws + WS_OA) + (tok0 + t) * DM + 1024 + h * 256 + lane * 4) = w2;
    }
}

DI void hgrn_sample_loop(const Params& p, int it0, int itN, int stride) {
    char* ws = p.ws;
    const float* pc = (const float*)(ws + WS_PCS);
    float* L = reinterpret_cast<float*>(smem);
    float* La = L; float* Lk = L + 512; float* Lq = L + 1024; float* Lv = L + 1536; float* Lp = L + 2048; float* Lr = L + 4096;
    int tid = threadIdx.x; asm volatile("" : "+v"(tid));
    const int t = tid >> 7, ch = tid & 127;
    const int v = tid & 127, kq = tid >> 7;
    const int w = tid >> 6, lane = tid & 63, tn = w >> 1, vn = (w & 1) * 64 + lane;
    float sreg[32], pf = 0.f, pq = 0.f, pv = 0.f, pz = 0.f, l0 = 0.f, l1 = 0.f;
    auto prefetch = [&](int it) {
        const int b = it >> 4, h = it & 15, gc = h * 128 + ch;
        const float* S0 = p.state_hgrn + ((long)it * 128 + kq * 32) * 128 + v;
#pragma unroll
        for (int kk = 0; kk < 32; ++kk) sreg[kk] = S0[kk * 128];
        const float* pr = pc + (long)(b * 4 + t) * NC;
        const float* pr2 = pr + (long)NTS * NC;
        pf = pr[2048 + gc] + pr2[2048 + gc]; pq = pr[gc] + pr2[gc]; pv = pr[4096 + gc] + pr2[4096 + gc];
        l0 = p.c_lb_logits[gc]; l1 = p.c_lb_logits[2048 + gc];
        pz = pc[(long)(b * 4 + tn) * NC + 6144 + h * 128 + vn] + pc[(long)(NTS + b * 4 + tn) * NC + 6144 + h * 128 + vn];
    };
    if (it0 < itN) prefetch(it0);
    for (int it = it0; it < itN; it += stride) {
        const int b = it >> 4, h = it & 15;
        {
            const float lb = sigmoidf_(l1 - l0);
            const float sg = 1.f / (1.f + __expf(-pf)), sn = 1.f / (1.f + __expf(pf));
            La[tid] = lb + (1.f - lb) * sg;
            Lk[tid] = (1.f - lb) * sn;
            Lq[tid] = siluf_(pq);
            Lv[tid] = pv;
        }
        const float zc = pz;
        __syncthreads();
        {
            float* S1 = p.out + O_HGS + ((long)it * 128 + kq * 32) * 128 + v;
            const float v0 = Lv[v], v1 = Lv[128 + v], v2 = Lv[256 + v], v3 = Lv[384 + v];
            float o0 = 0.f, o1 = 0.f, o2 = 0.f, o3 = 0.f;
#pragma unroll
            for (int kk = 0; kk < 32; ++kk) {
                const int k = kq * 32 + kk;
                float s = sreg[kk];
                s = La[k] * s + Lk[k] * v0;             o0 += Lq[k] * s;
                s = La[128 + k] * s + Lk[128 + k] * v1; o1 += Lq[128 + k] * s;
                s = La[256 + k] * s + Lk[256 + k] * v2; o2 += Lq[256 + k] * s;
                s = La[384 + k] * s + Lk[384 + k] * v3; o3 += Lq[384 + k] * s;
                S1[kk * 128] = s;
            }
            Lp[(0 * 4 + kq) * 128 + v] = o0; Lp[(1 * 4 + kq) * 128 + v] = o1; Lp[(2 * 4 + kq) * 128 + v] = o2; Lp[(3 * 4 + kq) * 128 + v] = o3;
        }
        if (it + stride < itN) prefetch(it + stride);
        __syncthreads();
        {
            const float a0 = Lp[(tn * 4) * 128 + vn] + Lp[(tn * 4 + 1) * 128 + vn] + Lp[(tn * 4 + 2) * 128 + vn] + Lp[(tn * 4 + 3) * 128 + vn];
            const float ss = wave_sum(a0 * a0);
            if (lane == 0) Lr[w] = ss;
            __syncthreads();
            const float inv = rsqrtf((Lr[tn * 2] + Lr[tn * 2 + 1]) * (1.f / 128.f) + 1e-6f);
            const long tok = NTP + b * 4 + tn;
            ((u16*)(ws + WS_OA))[tok * DM + h * 128 + vn] = f2bf(a0 * inv * p.c_gn[vn] * siluf_(zc));
        }
        __syncthreads();
    }
}

DI void hgrn_sample_wave(const Params& p, int it, float* __restrict__ Lw) {
    char* ws = p.ws;
    const float* pc = (const float*)(ws + WS_PCS);
    const long H2 = (long)NTS * NC;
    int lane = threadIdx.x & 63; asm volatile("" : "+v"(lane));
    const int b = it >> 4, h = it & 15, kp = lane >> 5, c4 = (lane & 31) * 4;
    float* La = Lw; float* Lk = Lw + 512; float* Lq = Lw + 1024;
#pragma unroll
    for (int u = 0; u < 2; ++u) {
        const int ch = lane + 64 * u, gc = h * 128 + ch;
        const float lb = sigmoidf_(p.c_lb_logits[2048 + gc] - p.c_lb_logits[gc]);
#pragma unroll
        for (int t = 0; t < 4; ++t) {
            const float* pr = pc + (long)(b * 4 + t) * NC;
            const float pf = pr[2048 + gc] + pr[H2 + 2048 + gc], pq = pr[gc] + pr[H2 + gc];
            const float sg = 1.f / (1.f + __expf(-pf)), sn = 1.f / (1.f + __expf(pf));
            La[ch * 4 + t] = lb + (1.f - lb) * sg;
            Lk[ch * 4 + t] = (1.f - lb) * sn;
            Lq[ch * 4 + t] = siluf_(pq);
        }
    }
    f32x4 vv[4], o[4];
#pragma unroll
    for (int t = 0; t < 4; ++t) {
        const float* pr = pc + (long)(b * 4 + t) * NC + 4096 + h * 128 + c4;
        vv[t] = *reinterpret_cast<const f32x4*>(pr) + *reinterpret_cast<const f32x4*>(pr + H2);
        o[t] = (f32x4){0.f, 0.f, 0.f, 0.f};
    }
    const float* S0 = p.state_hgrn + ((long)it * 128 + kp) * 128 + c4;
    float* S1 = p.out + O_HGS + ((long)it * 128 + kp) * 128 + c4;
    for (int i0 = 0; i0 < 64; i0 += 16) {
        f32x4 s[16];
#pragma unroll
        for (int ii = 0; ii < 16; ++ii) s[ii] = *reinterpret_cast<const f32x4*>(S0 + (long)(i0 + ii) * 256);
#pragma unroll
        for (int ii = 0; ii < 16; ++ii) {
            const int k = 2 * (i0 + ii) + kp;
            const f32x4 a = *reinterpret_cast<const f32x4*>(La + k * 4), kx = *reinterpret_cast<const f32x4*>(Lk + k * 4),
                        qx = *reinterpret_cast<const f32x4*>(Lq + k * 4);
#pragma unroll
            for (int t = 0; t < 4; ++t) { s[ii] = s[ii] * a[t] + vv[t] * kx[t]; o[t] += s[ii] * qx[t]; }
            *reinterpret_cast<f32x4*>(S1 + (long)(i0 + ii) * 256) = s[ii];
        }
    }
    const f32x4 gn = *reinterpret_cast<const f32x4*>(p.c_gn + c4);
#pragma unroll
    for (int t = 0; t < 4; ++t) {
#pragma unroll
        for (int j = 0; j < 4; ++j) o[t][j] += __shfl_xor(o[t][j], 32, 64);
        const float ss = 0.5f * wave_sum(o[t][0] * o[t][0] + o[t][1] * o[t][1] + o[t][2] * o[t][2] + o[t][3] * o[t][3]);
        const float inv = rsqrtf(ss * (1.f / 128.f) + 1e-6f);
        const float* zr = pc + (long)(b * 4 + t) * NC + 6144 + h * 128 + c4;
        const f32x4 z = *reinterpret_cast<const f32x4*>(zr) + *reinterpret_cast<const f32x4*>(zr + H2);
        u32x2 w2 = {cvt_pk(o[t][0] * inv * gn[0] * siluf_(z[0]), o[t][1] * inv * gn[1] * siluf_(z[1])),
                    cvt_pk(o[t][2] * inv * gn[2] * siluf_(z[2]), o[t][3] * inv * gn[3] * siluf_(z[3]))};
        if (kp == 0) *reinterpret_cast<u32x2*>((u16*)(ws + WS_OA) + (long)(NTP + b * 4 + t) * DM + h * 128 + c4) = w2;
    }
}

DI void gla_norm_gate(const Params& p, int rank, int count) {
    char* ws = p.ws;
    const float* ob = (const float*)(ws + WS_OB32);
    const float* proj = (const float*)(ws + WS_PROJ);
    u16* oa = (u16*)(ws + WS_OA);
    const int lane = threadIdx.x & 63, wid = threadIdx.x >> 6;
    const f32x4 g = reinterpret_cast<const f32x4*>(p.a_gla_gn)[lane];
    for (int it0 = (rank * 8 + wid) * 4; it0 < NTP * 4; it0 += count * 8 * 4) {
        f32x4 v[4], z[4];
#pragma unroll
        for (int u = 0; u < 4; ++u) {
            const int it = it0 + u; const long tok = it >> 2; const int h = it & 3;
            v[u] = reinterpret_cast<const f32x4*>(ob + tok * 1024 + h * 256)[lane];
            z[u] = reinterpret_cast<const f32x4*>(proj + tok * NAP + CZB + h * 256)[lane];
        }
#pragma unroll
        for (int u = 0; u < 4; ++u) {
            const int it = it0 + u; const long tok = it >> 2; const int h = it & 3;
            const float ss = wave_sum(v[u][0] * v[u][0] + v[u][1] * v[u][1] + v[u][2] * v[u][2] + v[u][3] * v[u][3]);
            const float inv = rsqrtf(ss * (1.f / 256.f) + 1e-6f);
            u32x2 o = {cvt_pk(v[u][0] * inv * g[0] * siluf_(z[u][0]), v[u][1] * inv * g[1] * siluf_(z[u][1])),
                       cvt_pk(v[u][2] * inv * g[2] * siluf_(z[u][2]), v[u][3] * inv * g[3] * siluf_(z[u][3]))};
            *reinterpret_cast<u32x2*>(oa + tok * DM + 1024 + h * 256 + lane * 4) = o;
        }
    }
}
DI void hgrn_norm_gate(const Params& p, int rank, int count) {
    char* ws = p.ws;
    const float* oc = (const float*)(ws + WS_OC32);
    const u16* zb = (const u16*)(ws + WS_ZB);
    u16* oa = (u16*)(ws + WS_OA);
    const int lane = threadIdx.x & 63, wid = threadIdx.x >> 6;
    const float2 g = reinterpret_cast<const float2*>(p.c_gn)[lane];
    for (int it0 = (rank * 8 + wid) * 8; it0 < NTP * 16; it0 += count * 8 * 8) {
        float2 v[8]; u32 zw[8];
#pragma unroll
        for (int u = 0; u < 8; ++u) {
            const int it = it0 + u; const long tok = it >> 4; const int h = it & 15;
            v[u] = reinterpret_cast<const float2*>(oc + tok * DM + h * 128)[lane];
            zw[u] = reinterpret_cast<const u32*>(zb + tok * DM + h * 128)[lane];
        }
#pragma unroll
        for (int u = 0; u < 8; ++u) {
            const int it = it0 + u; const long tok = it >> 4; const int h = it & 15;
            const float ss = wave_sum(v[u].x * v[u].x + v[u].y * v[u].y);
            const float inv = rsqrtf(ss * (1.f / 128.f) + 1e-6f);
            *reinterpret_cast<u32*>(oa + tok * DM + h * 128 + lane * 2) = cvt_pk(v[u].x * inv * g.x * siluf_(bflo(zw[u])), v[u].y * inv * g.y * siluf_(bfhi(zw[u])));
        }
    }
}

struct Acc16 { float m, l; f32x4 O[8]; };

DI f32x4 scores16(const float* __restrict__ kr, const bf16x8 (&Qb)[4], int q) {
    f32x4 s = {0.f, 0.f, 0.f, 0.f};
#pragma unroll
    for (int m = 0; m < 4; ++m) {
        const f32x4 a = *reinterpret_cast<const f32x4*>(kr + 32 * m + 4 * q);
        const f32x4 b = *reinterpret_cast<const f32x4*>(kr + 32 * m + 16 + 4 * q);
        s = mfma16(mk8(cvt_pk(a[0], a[1]), cvt_pk(a[2], a[3]), cvt_pk(b[0], b[1]), cvt_pk(b[2], b[3])), Qb[m], s);
    }
    return s;
}
template <class RV>
DI void pv16(int k0, const RV& rowv, const float (&pv)[8], f32x4 (&O)[8], int c, int q) {
    const bf16x8 P = mk8(cvt_pk(pv[0], pv[1]), cvt_pk(pv[2], pv[3]), cvt_pk(pv[4], pv[5]), cvt_pk(pv[6], pv[7]));
    f32x4 L[8], H[8];
#pragma unroll
    for (int e = 0; e < 8; ++e) {
        const int key = k0 + (e < 4 ? 4 * q + e : 16 + 4 * q + e - 4);
        const float* vr = rowv(key);
        L[e] = *reinterpret_cast<const f32x4*>(vr + 4 * c);
        H[e] = *reinterpret_cast<const f32x4*>(vr + 64 + 4 * c);
    }
#pragma unroll
    for (int dt = 0; dt < 4; ++dt) {
        O[dt] = mfma16(mk8(cvt_pk(L[0][dt], L[1][dt]), cvt_pk(L[2][dt], L[3][dt]), cvt_pk(L[4][dt], L[5][dt]), cvt_pk(L[6][dt], L[7][dt])), P, O[dt]);
        O[4 + dt] = mfma16(mk8(cvt_pk(H[0][dt], H[1][dt]), cvt_pk(H[2][dt], H[3][dt]), cvt_pk(H[4][dt], H[5][dt]), cvt_pk(H[6][dt], H[7][dt])), P, O[4 + dt]);
    }
}
template <class RK, class RV, class MK>
DI void attn16_group(int k0, const RK& rowk, const RV& rowv, const MK& valid, const bf16x8 (&Qb)[4], Acc16& A, int c, int q) {
    const f32x4 s0 = scores16(rowk(k0 + c), Qb, q), s1 = scores16(rowk(k0 + 16 + c), Qb, q);
    float sv[8];
#pragma unroll
    for (int jj = 0; jj < 4; ++jj) {
        sv[jj] = valid(k0 + 4 * q + jj) ? s0[jj] : -INFINITY;
        sv[4 + jj] = valid(k0 + 16 + 4 * q + jj) ? s1[jj] : -INFINITY;
    }
    float mx = sv[0];
#pragma unroll
    for (int i = 1; i < 8; ++i) mx = fmaxf(mx, sv[i]);
    mx = fmaxf(mx, __shfl_xor(mx, 16, 64)); mx = fmaxf(mx, __shfl_xor(mx, 32, 64));
    const float mnew = fmaxf(A.m, mx);
    const float muse = (mnew == -INFINITY) ? 0.f : mnew;
    const float alpha = exp2f_(A.m - muse);
    float pv[8]; float ps = 0.f;
#pragma unroll
    for (int i = 0; i < 8; ++i) { pv[i] = exp2f_(sv[i] - muse); ps += pv[i]; }
    ps += __shfl_xor(ps, 16, 64); ps += __shfl_xor(ps, 32, 64);
    A.l = A.l * alpha + ps; A.m = mnew;
#pragma unroll
    for (int dt = 0; dt < 8; ++dt) A.O[dt] *= alpha;
    pv16(k0, rowv, pv, A.O, c, q);
}

constexpr int AS_WAVE_BYTES = 9216;
constexpr int AS_OW_OFF = 8 * AS_WAVE_BYTES;
constexpr int AS_OW_LD = 132;

DI void attn_sample_item(const Params& p, int b, int g) {
    char* ws = p.ws;
    const float* proj = (const float*)(ws + WS_PROJ);
    int tid = threadIdx.x; asm volatile("" : "+v"(tid));
    const int w = tid >> 6, lane = tid & 63, c = lane & 15, q = lane >> 4;
    const int tokc = c >> 2, r = c & 3;
    float* Pl = reinterpret_cast<float*>(smem + w * AS_WAVE_BYTES);
    float* IMP = Pl + 16 * 128;
    float* Ow = reinterpret_cast<float*>(smem + AS_OW_OFF);
    float* ML = Ow + 8 * 16 * AS_OW_LD;
    bf16x8 Qb[4];
    {
        const u16* qb = (const u16*)(ws + WS_Q) + (long)(NTP + b * 4 + tokc) * 1024 + (g * 4 + r) * 128;
#pragma unroll
        for (int m = 0; m < 4; ++m) {
            const u32x2 w0 = *reinterpret_cast<const u32x2*>(qb + 32 * m + 4 * q), w1 = *reinterpret_cast<const u32x2*>(qb + 32 * m + 16 + 4 * q);
            Qb[m] = mk8(w0.x, w0.y, w1.x, w1.y);
        }
    }
    const int cq = tid >> 5, cd = (tid & 31) * 4;
    f32x4 acc = {0.f, 0.f, 0.f, 0.f};
    float gate[3];
    {
        const float* gp = proj + (long)(NTP + b * 4 + (cq >> 2)) * NAP + CGB + (g * 4 + (cq & 3)) * 3;
        gate[0] = sigmoidf_(gp[0]); gate[1] = sigmoidf_(gp[1]); gate[2] = sigmoidf_(gp[2]);
    }
    auto combine = [&](const Acc16& A, float gt) {
#pragma unroll
        for (int dt = 0; dt < 8; ++dt)
#pragma unroll
            for (int jj = 0; jj < 4; ++jj) Ow[(w * 16 + c) * AS_OW_LD + 4 * (4 * q + jj) + (dt & 3) + 64 * (dt >> 2)] = A.O[dt][jj];
        if (q == 0) { ML[(w * 16 + c) * 2] = A.m; ML[(w * 16 + c) * 2 + 1] = A.l; }
        __syncthreads();
        float M = -INFINITY;
#pragma unroll
        for (int ww = 0; ww < 8; ++ww) M = fmaxf(M, ML[(ww * 16 + cq) * 2]);
        float Lsum = 0.f; f32x4 o = {0.f, 0.f, 0.f, 0.f};
        if (M > -INFINITY) {
#pragma unroll
            for (int ww = 0; ww < 8; ++ww) {
                const float sc = exp2f_(ML[(ww * 16 + cq) * 2] - M);
                Lsum += ML[(ww * 16 + cq) * 2 + 1] * sc;
                o += *reinterpret_cast<const f32x4*>(Ow + (ww * 16 + cq) * AS_OW_LD + cd) * sc;
            }
        }
        if (Lsum > 0.f) acc += o * (gt / Lsum);
        __syncthreads();
    };

    const float* kcs = (const float*)(ws + WS_KCS) + ((long)(b * 2 + g) * 128) * 128;
    const float* vcs = kcs + (long)256 * 128 * 128;
    float pc[4][8];
    {
        float mx = -INFINITY;
#pragma unroll
        for (int gi = 0; gi < 4; ++gi) {
            const f32x4 s0 = scores16(kcs + (long)(32 * gi + c) * 128, Qb, q), s1 = scores16(kcs + (long)(32 * gi + 16 + c) * 128, Qb, q);
#pragma unroll
            for (int jj = 0; jj < 4; ++jj) {
                pc[gi][jj] = s0[jj];
                pc[gi][4 + jj] = (32 * gi + 16 + 4 * q + jj < 127) ? s1[jj] : -INFINITY;
                mx = fmaxf(mx, fmaxf(pc[gi][jj], pc[gi][4 + jj]));
            }
        }
        mx = fmaxf(mx, __shfl_xor(mx, 16, 64)); mx = fmaxf(mx, __shfl_xor(mx, 32, 64));
        float ls = 0.f;
#pragma unroll
        for (int gi = 0; gi < 4; ++gi)
#pragma unroll
            for (int i = 0; i < 8; ++i) { pc[gi][i] = exp2f_(pc[gi][i] - mx); ls += pc[gi][i]; }
        ls += __shfl_xor(ls, 16, 64); ls += __shfl_xor(ls, 32, 64);
        const float il = 1.f / ls;
#pragma unroll
        for (int gi = 0; gi < 4; ++gi)
#pragma unroll
            for (int jj = 0; jj < 4; ++jj) {
                pc[gi][jj] *= il; pc[gi][4 + jj] *= il;
                Pl[c * 128 + 32 * gi + 4 * q + jj] = pc[gi][jj];
                Pl[c * 128 + 32 * gi + 16 + 4 * q + jj] = pc[gi][4 + jj];
            }
    }
    __syncthreads();
#pragma unroll
    for (int n = 0; n < 2; ++n) {
        const int pi = lane + 64 * n, tk = pi >> 5, u = pi & 31;
        float s = 0.f;
#pragma unroll
        for (int rr = 0; rr < 4; ++rr) {
            const float* pr = Pl + (tk * 4 + rr) * 128 + 4 * u;
            s += 2.f * (pr[0] + pr[1] + pr[2]) + pr[3] + (u > 0 ? pr[-1] : 0.f);
        }
        IMP[pi] = s;
    }
    __syncthreads();
    u32 mymask;
    {
        u64 bal[2];
#pragma unroll
        for (int n = 0; n < 2; ++n) {
            const int pi = lane + 64 * n, tk = pi >> 5, u = pi & 31;
            bool sel;
            if (u == 0 || u == 31) sel = true;
            else {
                const float mine = IMP[pi];
                int rank = 0;
                for (int u2 = 1; u2 <= 30; ++u2) { const float o = IMP[tk * 32 + u2]; rank += (o > mine || (o == mine && u2 < u)) ? 1 : 0; }
                sel = rank < 13;
            }
            bal[n] = __ballot(sel);
        }
        mymask = tokc == 0 ? (u32)bal[0] : tokc == 1 ? (u32)(bal[0] >> 32) : tokc == 2 ? (u32)bal[1] : (u32)(bal[1] >> 32);
    }
    const u32 umask = (u32)__builtin_amdgcn_readfirstlane((int)(__shfl(mymask, 0, 64) | __shfl(mymask, 4, 64) | __shfl(mymask, 8, 64) | __shfl(mymask, 12, 64)));
    {
        Acc16 A; A.m = -INFINITY; A.l = 0.f;
#pragma unroll
        for (int dt = 0; dt < 8; ++dt) A.O[dt] = (f32x4){0.f, 0.f, 0.f, 0.f};
        if (w < 4) {
            float pvv[8]; float ps = 0.f;
#pragma unroll
            for (int i = 0; i < 8; ++i) { pvv[i] = w == 0 ? pc[0][i] : w == 1 ? pc[1][i] : w == 2 ? pc[2][i] : pc[3][i]; ps += pvv[i]; }
            ps += __shfl_xor(ps, 16, 64); ps += __shfl_xor(ps, 32, 64);
            A.m = 0.f; A.l = ps;
            pv16(32 * w, [&](int key) { return vcs + (long)key * 128; }, pvv, A.O, c, q);
        }
        combine(A, gate[0]);
    }
    {
        Acc16 A; A.m = -INFINITY; A.l = 0.f;
#pragma unroll
        for (int dt = 0; dt < 8; ++dt) A.O[dt] = (f32x4){0.f, 0.f, 0.f, 0.f};
        const int tpos = PAST + tokc;
        for (int gi = w; gi < 65; gi += 8) {
            const int j = gi >> 1;
            if (j < 32 && !((umask >> j) & 1u)) continue;
            const int k0 = 32 * gi;
            const float* pagep = p.cache_kv + (long)p.page_table[b * 16 + (k0 < PAST ? (k0 >> 7) : 15)] * 128 * 1024 + 512 + g * 128;
            const float* newp = proj + (long)(NTP + b * 4) * NAP + CKV + 512 + g * 128;
            auto rowk = [&](int key) { return key < PAST ? pagep + (long)(key & 127) * 1024 : newp + (long)min(key - PAST, 3) * NAP; };
            auto rowv = [&](int key) { return (key < PAST ? pagep + (long)(key & 127) * 1024 : newp + (long)min(key - PAST, 3) * NAP) + 256; };
            const bool selj = j >= 32 || ((mymask >> j) & 1u);
            auto valid = [&](int key) { return selj && key <= tpos; };
            attn16_group(k0, rowk, rowv, valid, Qb, A, c, q);
        }
        combine(A, gate[1]);
    }
    {
        Acc16 A; A.m = -INFINITY; A.l = 0.f;
#pragma unroll
        for (int dt = 0; dt < 8; ++dt) A.O[dt] = (f32x4){0.f, 0.f, 0.f, 0.f};
        const float* winp = p.cache_win + (long)b * 512 * 512 + g * 128;
        const float* newp = proj + (long)(NTP + b * 4) * NAP + CKV + 1024 + g * 128;
        for (int gi = w; gi < 17; gi += 8) {
            const int k0 = 32 * gi;
            auto rowk = [&](int key) { return key < 512 ? winp + (long)key * 512 : newp + (long)min(key - 512, 3) * NAP; };
            auto rowv = [&](int key) { return (key < 512 ? winp + (long)key * 512 : newp + (long)min(key - 512, 3) * NAP) + 256; };
            auto valid = [&](int key) { return key <= 512 + tokc && key > tokc; };
            attn16_group(k0, rowk, rowv, valid, Qb, A, c, q);
        }
        combine(A, gate[2]);
    }
    {
        const long tok = NTP + b * 4 + (cq >> 2); const int h = g * 4 + (cq & 3);
        const f32x4 z = *reinterpret_cast<const f32x4*>(proj + tok * NAP + CZA + h * 128 + cd);
        u32x2 o = {cvt_pk(acc[0] * siluf_(z[0]), acc[1] * siluf_(z[1])), cvt_pk(acc[2] * siluf_(z[2]), acc[3] * siluf_(z[3]))};
        *reinterpret_cast<u32x2*>((u16*)(ws + WS_OA) + tok * DM + h * 128 + cd) = o;
    }
}

DI f32x16 scores32(const u16* __restrict__ kr, const bf16x8 (&Qb)[8], int hh) {
    f32x16 s;
#pragma unroll
    for (int i = 0; i < 16; ++i) s[i] = 0.f;
#pragma unroll
    for (int ks = 0; ks < 8; ++ks) s = mfma32(ld8(kr + 16 * ks + 8 * hh), Qb[ks], s);
    return s;
}
DI void pv32(const u16* __restrict__ vt, int ldt, const float (&pr)[16], f32x16 (&O)[4], int c, int hh) {
#pragma unroll
    for (int s2 = 0; s2 < 2; ++s2) {
        const bf16x8 B = mk8(cvt_pk(pr[8 * s2 + 0], pr[8 * s2 + 1]), cvt_pk(pr[8 * s2 + 2], pr[8 * s2 + 3]),
                             cvt_pk(pr[8 * s2 + 4], pr[8 * s2 + 5]), cvt_pk(pr[8 * s2 + 6], pr[8 * s2 + 7]));
#pragma unroll
        for (int mt = 0; mt < 4; ++mt) {
            const u16* a = vt + (long)(32 * mt + c) * ldt + 16 * s2 + 4 * hh;
            const u32x2 w0 = *reinterpret_cast<const u32x2*>(a), w1 = *reinterpret_cast<const u32x2*>(a + 8);
            O[mt] = mfma32(mk8(w0.x, w0.y, w1.x, w1.y), B, O[mt]);
        }
    }
}
struct Acc32 { float m, l; f32x16 O[4]; };
DI void acc32_init(Acc32& A) {
    A.m = -INFINITY; A.l = 0.f;
#pragma unroll
    for (int mt = 0; mt < 4; ++mt)
#pragma unroll
        for (int i = 0; i < 16; ++i) A.O[mt][i] = 0.f;
}
DI void load_kf(bf16x8 (&kf)[8], const u16* __restrict__ kt, int koff) {
#pragma unroll
    for (int ks = 0; ks < 8; ++ks) kf[ks] = ld8(kt + koff + 16 * ks);
}
DI void load_vf(u32x2 (&vf)[2][4][2], const u16* __restrict__ vt, int ldt, int voff) {
#pragma unroll
    for (int mt = 0; mt < 4; ++mt) {
        const u16* a = vt + 32 * mt * ldt;
#pragma unroll
        for (int s2 = 0; s2 < 2; ++s2) {
            vf[s2][mt][0] = *reinterpret_cast<const u32x2*>(a + voff + 16 * s2);
            vf[s2][mt][1] = *reinterpret_cast<const u32x2*>(a + voff + 16 * s2 + 8);
        }
    }
}
DI void load_kff(bf16x8 (&kf)[8], const u16* __restrict__ kt, int l8) {
#pragma unroll
    for (int ks = 0; ks < 8; ++ks) kf[ks] = ld8(kt + ks * 512 + l8);
}
DI void load_vff(bf16x8 (&vf)[2][4], const u16* __restrict__ vt, int l8) {
#pragma unroll
    for (int s2 = 0; s2 < 2; ++s2)
#pragma unroll
        for (int mt = 0; mt < 4; ++mt) vf[s2][mt] = ld8(vt + (s2 * 4 + mt) * 512 + l8);
}
DI void pv32ff(const bf16x8 (&vf)[2][4], const float (&pr)[16], f32x16 (&O)[4]) {
#pragma unroll
    for (int s2 = 0; s2 < 2; ++s2) {
        const bf16x8 B = mk8(cvt_pk(pr[8 * s2 + 0], pr[8 * s2 + 1]), cvt_pk(pr[8 * s2 + 2], pr[8 * s2 + 3]),
                             cvt_pk(pr[8 * s2 + 4], pr[8 * s2 + 5]), cvt_pk(pr[8 * s2 + 6], pr[8 * s2 + 7]));
#pragma unroll
        for (int mt = 0; mt < 4; ++mt) O[mt] = mfma32(vf[s2][mt], B, O[mt]);
    }
}
DI void pv32f(const u32x2 (&vf)[2][4][2], const float (&pr)[16], f32x16 (&O)[4]) {
#pragma unroll
    for (int s2 = 0; s2 < 2; ++s2) {
        const bf16x8 B = mk8(cvt_pk(pr[8 * s2 + 0], pr[8 * s2 + 1]), cvt_pk(pr[8 * s2 + 2], pr[8 * s2 + 3]),
                             cvt_pk(pr[8 * s2 + 4], pr[8 * s2 + 5]), cvt_pk(pr[8 * s2 + 6], pr[8 * s2 + 7]));
#pragma unroll
        for (int mt = 0; mt < 4; ++mt) O[mt] = mfma32(mk8(vf[s2][mt][0].x, vf[s2][mt][0].y, vf[s2][mt][1].x, vf[s2][mt][1].y), B, O[mt]);
    }
}
template <class LIM>
DI void attn32_run(u64 tmask, const u16* __restrict__ K, const u16* __restrict__ VT, const bf16x8 (&Qb)[8], Acc32& A, int c, int hh, const LIM& lim) {
    if (tmask == 0) return;
    int T = __builtin_ctzll(tmask); tmask &= tmask - 1;
    bf16x8 kf[8];
    const int l8 = (hh * 32 + c) * 8;
    load_kff(kf, K + T * 4096, l8);
    for (;;) {
        f32x16 s;
#pragma unroll
        for (int i = 0; i < 16; ++i) s[i] = 0.f;
#pragma unroll
        for (int ks = 0; ks < 8; ++ks) s = mfma32(kf[ks], Qb[ks], s);
        __builtin_amdgcn_sched_barrier(0);
        bf16x8 vf[2][4];
        load_vff(vf, VT + T * 4096, l8);
        const bool more = tmask != 0;
        const int Tn = more ? (int)__builtin_ctzll(tmask) : T;
        tmask &= tmask - 1;
        load_kff(kf, K + Tn * 4096, l8);
        int lo, hi; lim(T, lo, hi);
        float sv[16];
        float mx = -INFINITY;
#pragma unroll
        for (int i = 0; i < 16; ++i) {
            const int kc = (i & 3) + 8 * (i >> 2);
            sv[i] = (kc <= hi && kc > lo) ? s[i] : -INFINITY;
            mx = fmaxf(mx, sv[i]);
        }
        mx = fmaxf(mx, __shfl_xor(mx, 32, 64));
        const float mnew = fmaxf(A.m, mx);
        const float muse = (mnew == -INFINITY) ? 0.f : mnew;
        const float alpha = exp2f_(A.m - muse);
        float ps = 0.f;
#pragma unroll
        for (int i = 0; i < 16; ++i) { sv[i] = exp2f_(sv[i] - muse); ps += sv[i]; }
        ps += __shfl_xor(ps, 32, 64);
        A.l = A.l * alpha + ps; A.m = mnew;
#pragma unroll
        for (int mt = 0; mt < 4; ++mt) A.O[mt] *= alpha;
        pv32ff(vf, sv, A.O);
        if (!more) break;
        T = Tn;
    }
}

constexpr int AP_WAVE_BYTES = 17408;
constexpr int AP_UM_OFF = 8 * AP_WAVE_BYTES;
constexpr int AP_ST_LD = 132;
constexpr int AP_ST_BYTES = 32 * AP_ST_LD * 2;
constexpr int AP_RING_OFF = 69632;

template <class LIM, class USE>
DI void attn32_ring(u64 tmask, const u16* __restrict__ K, const u16* __restrict__ VT, int tid, int lane,
                    const bf16x8 (&Qb)[8], Acc32& A, const LIM& lim, const USE& use) {
    if (tmask == 0) return;
    int T0 = __builtin_ctzll(tmask); tmask &= tmask - 1;
    int T1 = -1; if (tmask) { T1 = __builtin_ctzll(tmask); tmask &= tmask - 1; }
    auto issue = [&](int T, int buf) {
        char* l = smem + AP_RING_OFF + buf * 16384 + tid * 16;
        __builtin_amdgcn_global_load_lds((const unsigned*)(K + T * 4096 + tid * 8), (unsigned*)l, 16, 0, 0);
        __builtin_amdgcn_global_load_lds((const unsigned*)(VT + T * 4096 + tid * 8), (unsigned*)(l + 8192), 16, 0, 0);
    };
    issue(T0, 0);
    if (T1 >= 0) issue(T1, 1);
    int buf = 0;
    for (;;) {
        int T2 = -1; if (tmask) { T2 = __builtin_ctzll(tmask); tmask &= tmask - 1; }
        if (T1 >= 0) asm volatile("s_waitcnt vmcnt(2)" ::: "memory"); else asm volatile("s_waitcnt vmcnt(0)" ::: "memory");
        __builtin_amdgcn_s_barrier();
        if (T2 >= 0) issue(T2, buf == 0 ? 2 : buf - 1);
        if (use(T0)) {
            const char* kb = smem + AP_RING_OFF + buf * 16384 + lane * 16;
            f32x16 s;
#pragma unroll
            for (int i = 0; i < 16; ++i) s[i] = 0.f;
#pragma unroll
            for (int ks = 0; ks < 8; ++ks) s = mfma32(*reinterpret_cast<const bf16x8*>(kb + ks * 1024), Qb[ks], s);
            int lo, hi; lim(T0, lo, hi);
            float sv[16];
            float mx = -INFINITY;
#pragma unroll
            for (int i = 0; i < 16; ++i) {
                const int kc = (i & 3) + 8 * (i >> 2);
                sv[i] = (kc <= hi && kc > lo) ? s[i] : -INFINITY;
                mx = fmaxf(mx, sv[i]);
            }
            mx = fmaxf(mx, __shfl_xor(mx, 32, 64));
            if (__any(mx > A.m)) {
                const float mnew = fmaxf(A.m, mx);
                const float alpha = exp2f_(A.m - ((mnew == -INFINITY) ? 0.f : mnew));
                A.l *= alpha; A.m = mnew;
#pragma unroll
                for (int mt = 0; mt < 4; ++mt) A.O[mt] *= alpha;
            }
            const float muse = (A.m == -INFINITY) ? 0.f : A.m;
            float ps = 0.f;
#pragma unroll
            for (int i = 0; i < 16; ++i) { sv[i] = exp2f_(sv[i] - muse); ps += sv[i]; }
            ps += __shfl_xor(ps, 32, 64);
            A.l += ps;
#pragma unroll
            for (int s2 = 0; s2 < 2; ++s2) {
                const bf16x8 B = mk8(cvt_pk(sv[8 * s2 + 0], sv[8 * s2 + 1]), cvt_pk(sv[8 * s2 + 2], sv[8 * s2 + 3]),
                                     cvt_pk(sv[8 * s2 + 4], sv[8 * s2 + 5]), cvt_pk(sv[8 * s2 + 6], sv[8 * s2 + 7]));
#pragma unroll
                for (int mt = 0; mt < 4; ++mt) A.O[mt] = mfma32(*reinterpret_cast<const bf16x8*>(kb + 8192 + (s2 * 4 + mt) * 1024), B, A.O[mt]);
            }
        }
        if (T1 < 0) break;
        T0 = T1; T1 = T2; buf = buf == 2 ? 0 : buf + 1;
    }
    __builtin_amdgcn_s_barrier();
}

DI void attn_prompt_item(const Params& p, int b, int g, int X) {
    char* ws = p.ws;
    const float* proj = (const float*)(ws + WS_PROJ);
    int tid = threadIdx.x; asm volatile("" : "+v"(tid));
    const int w = __builtin_amdgcn_readfirstlane(tid >> 6), lane = tid & 63, c = lane & 31, hh = lane >> 5;
    const int ti = c >> 2, r = c & 3;
    const int t0w = 64 * X + 8 * w;
    const int tpos = t0w + ti;
    const long tok = (long)b * 2048 + tpos;
    const int h = g * 4 + r;
    float* OS = reinterpret_cast<float*>(smem + w * AP_WAVE_BYTES);
    float* IMP = OS + 128 * 32;
    int osl = 128 * hh + c;
    asm volatile("" : "+v"(osl));
    bf16x8 Qb[8];
    {
        const u16* qb = (const u16*)(ws + WS_Q) + tok * 1024 + h * 128;
#pragma unroll
        for (int ks = 0; ks < 8; ++ks) Qb[ks] = ld8(qb + 16 * ks + 8 * hh);
    }
    float gate[3];
    {
        const float* gp = proj + tok * NAP + CGB + h * 3;
        gate[0] = sigmoidf_(gp[0]); gate[1] = sigmoidf_(gp[1]); gate[2] = sigmoidf_(gp[2]);
    }
    const int bg = b * 2 + g;
    const int cur = X;
    u32 mymask, umask, bmask;
    u16* ST = reinterpret_cast<u16*>(smem + w * AP_ST_BYTES) + c * AP_ST_LD + 4 * hh;
    {
        const u16* kc = (const u16*)(ws + WS_KCP) + (long)bg * 128 * 128;
        const u16* vct = (const u16*)(ws + WS_VCTP) + (long)bg * 128 * 128;
        float pc[4][16];
        float mx = -INFINITY;
        const int lim2 = min((tpos - 31) >> 4, 126) - 4 * hh;
        bf16x8 kf[8];
        load_kf(kf, kc, c * 128 + 8 * hh);
#pragma unroll
        for (int tl = 0; tl < 4; ++tl) {
            f32x16 s;
#pragma unroll
            for (int i = 0; i < 16; ++i) s[i] = 0.f;
#pragma unroll
            for (int ks = 0; ks < 8; ++ks) s = mfma32(kf[ks], Qb[ks], s);
            if (tl < 3) load_kf(kf, kc + 32 * (tl + 1) * 128, c * 128 + 8 * hh);
#pragma unroll
            for (int i = 0; i < 16; ++i) {
                pc[tl][i] = (32 * tl + (i & 3) + 8 * (i >> 2) <= lim2) ? s[i] : -INFINITY;
                mx = fmaxf(mx, pc[tl][i]);
            }
        }
        mx = fmaxf(mx, __shfl_xor(mx, 32, 64));
        const float muse = (mx == -INFINITY) ? 0.f : mx;
        float ls = 0.f;
#pragma unroll
        for (int tl = 0; tl < 4; ++tl)
#pragma unroll
            for (int i = 0; i < 16; ++i) { pc[tl][i] = exp2f_(pc[tl][i] - muse); ls += pc[tl][i]; }
        ls += __shfl_xor(ls, 32, 64);
        const float il = ls > 0.f ? 1.f / ls : 0.f;
#pragma unroll
        for (int tl = 0; tl < 4; ++tl)
#pragma unroll
            for (int i = 0; i < 16; ++i) {
                pc[tl][i] *= il;
                OS[osl + ((32 * tl + (i & 3) + 8 * (i >> 2))) * 32] = pc[tl][i];
            }
        __syncthreads();
#pragma unroll
        for (int n = 0; n < 4; ++n) {
            const int pi = lane + 64 * n, tk = pi >> 5, u = pi & 31;
            float s = 0.f;
#pragma unroll
            for (int rr = 0; rr < 4; ++rr) {
                const float* pr = OS + (4 * u) * 32 + tk * 4 + rr;
                s += 2.f * (pr[0] + pr[32] + pr[64]) + pr[96] + (u > 0 ? pr[-32] : 0.f);
            }
            IMP[pi] = s;
        }
        __syncthreads();
        u64 bal[4];
#pragma unroll
        for (int n = 0; n < 4; ++n) {
            const int pi = lane + 64 * n, tk = pi >> 5, u = pi & 31;
            bool sel;
            const bool forced = (u == 0) || (u == cur) || (u == cur - 1);
            if (u > cur) sel = false;
            else if (forced) sel = true;
            else {
                const int nf = cur == 0 ? 1 : cur == 1 ? 2 : 3;
                const float mine = IMP[pi];
                int rank = 0;
                for (int u2 = 1; u2 < cur - 1; ++u2) { const float o = IMP[tk * 32 + u2]; rank += (o > mine || (o == mine && u2 < u)) ? 1 : 0; }
                sel = rank < 16 - nf;
            }
            bal[n] = __ballot(sel);
        }
        const u64 bsel = ti < 2 ? bal[0] : ti < 4 ? bal[1] : ti < 6 ? bal[2] : bal[3];
        mymask = (ti & 1) ? (u32)(bsel >> 32) : (u32)bsel;
        umask = (u32)(bal[0] | (bal[0] >> 32) | bal[1] | (bal[1] >> 32) | bal[2] | (bal[2] >> 32) | bal[3] | (bal[3] >> 32));
        if (lane == 0) reinterpret_cast<u32*>(smem + AP_UM_OFF)[w] = umask;
        f32x16 O[4];
#pragma unroll
        for (int mt = 0; mt < 4; ++mt)
#pragma unroll
            for (int i = 0; i < 16; ++i) O[mt][i] = 0.f;
#pragma unroll
        for (int tl = 0; tl < 4; ++tl) {
            u32x2 vf[2][4][2]; load_vf(vf, vct + 32 * tl, 128, c * 128 + 4 * hh);
            float pr[16];
#pragma unroll
            for (int i = 0; i < 16; ++i) pr[i] = OS[osl + ((32 * tl + (i & 3) + 8 * (i >> 2))) * 32];
            pv32f(vf, pr, O);
            __builtin_amdgcn_sched_barrier(0);
        }
        __syncthreads();
        {
            const u32* um = reinterpret_cast<const u32*>(smem + AP_UM_OFF);
            bmask = um[0] | um[1] | um[2] | um[3] | um[4] | um[5] | um[6] | um[7];
            bmask = (u32)__builtin_amdgcn_readfirstlane((int)bmask);
        }
#pragma unroll
        for (int mt = 0; mt < 4; ++mt)
#pragma unroll
            for (int rr = 0; rr < 4; ++rr) {
                u32x2 wv = {cvt_pk(gate[0] * O[mt][4 * rr], gate[0] * O[mt][4 * rr + 1]), cvt_pk(gate[0] * O[mt][4 * rr + 2], gate[0] * O[mt][4 * rr + 3])};
                *reinterpret_cast<u32x2*>(ST + 32 * mt + 8 * rr) = wv;
            }
    }
    const int tp4 = tpos - 4 * hh;
    {
        Acc32 A; acc32_init(A);
        const u16* K = (const u16*)(ws + WS_KF) + ((long)(0 * 4 + b) * 2 + g) * 64 * 4096;
        const u16* VT = (const u16*)(ws + WS_VT) + ((long)(0 * 4 + b) * 2 + g) * 64 * 4096;
        u64 tm = 0;
        for (int j = 0; j <= cur; ++j) if ((bmask >> j) & 1u) tm |= 3ull << (2 * j);
        attn32_ring(tm, K, VT, tid, lane, Qb, A,
                    [&](int T, int& lo, int& hi) { lo = -(1 << 30); hi = ((mymask >> (T >> 1)) & 1u) ? tp4 - 32 * T : -1; },
                    [&](int T) { return ((umask >> (T >> 1)) & 1u) && 32 * T <= t0w + 7; });
#ifdef DBG_DUPSEL
        {
            Acc32 A2; acc32_init(A2);
            attn32_ring(tm, K, VT, tid, lane, Qb, A2,
                        [&](int T, int& lo, int& hi) { lo = -(1 << 30); hi = ((mymask >> (T >> 1)) & 1u) ? tp4 - 32 * T : -1; },
                        [&](int T) { return ((umask >> (T >> 1)) & 1u) && 32 * T <= t0w + 7; });
            asm volatile("" :: "v"(A2.l), "v"(A2.O[0][0]), "v"(A2.O[1][0]), "v"(A2.O[2][0]), "v"(A2.O[3][0]));
        }
#endif
        const float cf = A.l > 0.f ? gate[1] / A.l : 0.f;
#pragma unroll
        for (int mt = 0; mt < 4; ++mt)
#pragma unroll
            for (int rr = 0; rr < 4; ++rr) {
                const u32x2 o = *reinterpret_cast<const u32x2*>(ST + 32 * mt + 8 * rr);
                u32x2 wv = {cvt_pk(bflo(o.x) + cf * A.O[mt][4 * rr], bfhi(o.x) + cf * A.O[mt][4 * rr + 1]),
                            cvt_pk(bflo(o.y) + cf * A.O[mt][4 * rr + 2], bfhi(o.y) + cf * A.O[mt][4 * rr + 3])};
                *reinterpret_cast<u32x2*>(ST + 32 * mt + 8 * rr) = wv;
            }
    }
    {
        Acc32 A; acc32_init(A);
        const u16* K = (const u16*)(ws + WS_KF) + ((long)(1 * 4 + b) * 2 + g) * 64 * 4096;
        const u16* VT = (const u16*)(ws + WS_VT) + ((long)(1 * 4 + b) * 2 + g) * 64 * 4096;
        const int Tlo = max(0, 64 * X - 511) >> 5, Tmax = 2 * X + 1;
        const u64 tm = ((2ull << Tmax) - 1ull) & ~((1ull << Tlo) - 1ull);
        attn32_ring(tm, K, VT, tid, lane, Qb, A,
                    [&](int T, int& lo, int& hi) { hi = tp4 - 32 * T; lo = hi - 512; },
                    [&](int T) { return 32 * T <= t0w + 7 && 32 * T + 31 > t0w - 512; });
        const float cf = A.l > 0.f ? gate[2] / A.l : 0.f;
        int h4 = 4 * hh; asm volatile("" : "+v"(h4));
        u16* oa = (u16*)(ws + WS_OA) + tok * DM + h * 128 + h4;
        const float* za = proj + tok * NAP + CZA + h * 128 + h4;
#pragma unroll
        for (int mt = 0; mt < 4; ++mt)
#pragma unroll
            for (int rr = 0; rr < 4; ++rr) {
                const int d0 = 32 * mt + 8 * rr;
                const f32x4 z = *reinterpret_cast<const f32x4*>(za + d0);
                const u32x2 o = *reinterpret_cast<const u32x2*>(ST + d0);
                u32x2 wv = {cvt_pk((bflo(o.x) + cf * A.O[mt][4 * rr]) * siluf_(z[0]), (bfhi(o.x) + cf * A.O[mt][4 * rr + 1]) * siluf_(z[1])),
                            cvt_pk((bflo(o.y) + cf * A.O[mt][4 * rr + 2]) * siluf_(z[2]), (bfhi(o.y) + cf * A.O[mt][4 * rr + 3]) * siluf_(z[3]))};
                *reinterpret_cast<u32x2*>(oa + d0) = wv;
                asm volatile("" ::: "memory");
            }
    }
    __syncthreads();
}

DI int gemm_tile_id(int i) {
    const int nb = gridDim.x, nx = nb >> 5;
    if ((nb & 31) != 0) return blockIdx.x + i * nb;
    return ((i * nx + (int)(blockIdx.x % nx)) << 5) + (int)(blockIdx.x / nx);
}
DI void gemm_tile_pos(int u, int ncol, int& pm, int& pn) {
    const int P = u / (2 * ncol), rem = u - P * 2 * ncol;
    pn = rem >> 1; pm = 2 * P + (rem & 1);
}
DI void phase2(const Params& p) {
    char* ws = p.ws;
    const int nb = gridDim.x, bid = blockIdx.x;
    const bool split = nb >= 32;
    if (!split || bid < 16) {
        for (int u = bid; u < 16; u += nb) {
            const int half = u >> 3, slot = (u >> 2) & 1, rt = u & 3;
            EpiStore e{(float*)(ws + WS_CPP) + (long)(half * 2 + slot) * 1024 * 256, 256};
            gemm_tile((const u16*)(ws + WS_KV6) + (long)slot * 1024 * 2048 + half * 2048, 2048,
                      (const u16*)(ws + WS_W1T) + (long)slot * 256 * 4096 + half * 2048, 4096, 2048, rt * 256, 0, e);
        }
    }
    if (!split || bid >= 16) {
        const int rank = split ? bid - 16 : bid, count = split ? nb - 16 : nb;
        gla_prep(p, rank, count);
    }
}
DI int first_item(int start) { const int nb = gridDim.x; return start + (int)((blockIdx.x + nb - start % nb) % nb); }
DI void phase3(const Params& p) {
    char* ws = p.ws;
    for (int it = first_item(0); it < 256; it += gridDim.x) {
        const int bh = it >> 4, b = bh >> 2, h = bh & 3, chunk = (it & 15) * 8 + (threadIdx.x >> 6);
        rec_prep2<16>((const u16*)(ws + WS_GQT) + (long)bh * 262144, (const u16*)(ws + WS_GKA) + (long)bh * 262144,
                      (const u16*)(ws + WS_GVT) + (long)bh * 128 * 256 * 16, (float*)(ws + WS_GOI) + (long)bh * 128 * 16 * 256, chunk);
    }
    for (int it = first_item(256); it < 512; it += gridDim.x) { const int u = it - 256; attn_sample_item(p, u >> 1, u & 1); }
    {
        const float* cp = (const float*)(ws + WS_CPP);
        const float* hc = (const float*)(ws + WS_HCONST);
        u16* a2 = (u16*)(ws + WS_A2P);
        for (int i = blockIdx.x * 512 + threadIdx.x; i < 2 * 1024 * 64; i += gridDim.x * 512) {
            const int slot = i >> 16, row = (i >> 6) & 1023, c4 = (i & 63) * 4;
            const f32x4 a = *reinterpret_cast<const f32x4*>(cp + ((long)slot * 1024 + row) * 256 + c4);
            const f32x4 b2 = *reinterpret_cast<const f32x4*>(cp + ((long)(2 + slot) * 1024 + row) * 256 + c4);
            const f32x4 h0 = *reinterpret_cast<const f32x4*>(hc + slot * 256 + c4);
            f32x4 o;
#pragma unroll
            for (int j = 0; j < 4; ++j) o[j] = ((row & 127) == 127) ? 0.f : gelu_tanh(a[j] + b2[j] + h0[j]);
            *reinterpret_cast<u32x2*>(a2 + ((long)slot * 1024 + row) * 256 + c4) = pk4(o);
        }
    }
}
DI void phase4(const Params& p) {
    char* ws = p.ws;
    const int w = __builtin_amdgcn_readfirstlane((int)(threadIdx.x >> 6));
    const bool pair = gridDim.x == 256;
    if (threadIdx.x < 2) reinterpret_cast<int*>(smem + RW_OFF + RW_SLOTS * 4096)[threadIdx.x] = 0;
    __syncthreads();
    if (w == 0 || (pair && w == 3)) {
        for (int t0 = blockIdx.x; t0 < 256; t0 += gridDim.x) {
            const int t = (gridDim.x == 256) ? (((t0 & 7) * 2 + (t0 >> 7)) << 4) + ((t0 >> 3) & 15) : t0;
            const int bh = t >> 4, b = bh >> 2, h = bh & 3, vt = t & 15;
            if (!pair)
                rec_walker<16>((const u16*)(ws + WS_GQT) + (long)bh * 262144, (const u16*)(ws + WS_GKST) + (long)bh * 128 * 2048,
                               (const u16*)(ws + WS_GVT) + (long)bh * 128 * 256 * 16, (const u16*)(ws + WS_GDC) + (long)bh * 128 * 128,
                               (const float*)(ws + WS_GOI) + (long)bh * 128 * 16 * 256, vt,
                               (float*)(ws + WS_OB32) + (long)b * 2048 * 1024 + h * 256, 1024, p.out + O_GLAP + (long)bh * 128 * 256, 256);
            else if (w == 0)
                rec_state_wave<16>((const u16*)(ws + WS_GKST) + (long)bh * 128 * 2048, (const u16*)(ws + WS_GVT) + (long)bh * 128 * 256 * 16,
                                   (const u16*)(ws + WS_GDC) + (long)bh * 128 * 128, vt, p.out + O_GLAP + (long)bh * 128 * 256, 256, RW_OFF);
            else
                rec_out_wave<16>((const u16*)(ws + WS_GQT) + (long)bh * 262144, (const float*)(ws + WS_GOI) + (long)bh * 128 * 16 * 256, vt,
                                 (float*)(ws + WS_OB32) + (long)b * 2048 * 1024 + h * 256, 1024, RW_OFF);
        }
    } else {
        if (!(pair && w >= 3))
            for (int it = blockIdx.x + gridDim.x * (w - 1); it < 512; it += gridDim.x * 7)
                gla_sample_wave(p, it >> 2, it & 3, reinterpret_cast<float*>(smem + w * 8192));
    }
    __syncthreads();
    for (int it = first_item(0); it < 8; it += gridDim.x) {
        const int slot = it >> 2, rt = it & 3;
        EpiCmp2P e{(u16*)(ws + WS_KCP), (u16*)(ws + WS_VCTP), slot};
        gemm_tile((const u16*)(ws + WS_A2P) + (long)slot * 1024 * 256, 256, (const u16*)(ws + WS_W2T) + (long)slot * 256 * 256, 256, 256, rt * 256, 0, e);
    }
}
DI void final_norm_rows(const Params& p, int r0, int r1, int parts) {
    const float* x2 = (const float*)(p.ws + (parts > 0 ? WS_X1 : WS_X2));
    const float* pp = (const float*)(p.ws + WS_PROJC);
    const int lane = threadIdx.x & 63, wid = threadIdx.x >> 6;
    for (int row = r0 + blockIdx.x * 8 + wid; row < r1; row += gridDim.x * 8) {
        const float4* x = reinterpret_cast<const float4*>(x2 + (long)row * DM);
        float4* y = reinterpret_cast<float4*>(row < NTP ? p.out + O_YP + (long)row * DM : p.out + O_YS + (long)(row - NTP) * DM);
        float4 v[8]; float ss = 0.f;
#pragma unroll
        for (int i = 0; i < 8; ++i) v[i] = x[lane + 64 * i];
        for (int q4 = 0; q4 < parts; ++q4) {
            const float4* xp = reinterpret_cast<const float4*>(pp + ((long)q4 * NTS + (row - NTP)) * DM);
#pragma unroll
            for (int i = 0; i < 8; ++i) { const float4 a = xp[lane + 64 * i]; v[i].x += a.x; v[i].y += a.y; v[i].z += a.z; v[i].w += a.w; }
        }
#pragma unroll
        for (int i = 0; i < 8; ++i) ss += v[i].x * v[i].x + v[i].y * v[i].y + v[i].z * v[i].z + v[i].w * v[i].w;
        ss = wave_sum(ss);
        const float inv = rsqrtf(ss * (1.f / DM) + 1e-6f);
#pragma unroll
        for (int i = 0; i < 8; ++i) {
            const float4 g = reinterpret_cast<const float4*>(p.final_norm)[lane + 64 * i];
            y[lane + 64 * i] = make_float4(v[i].x * inv * g.x, v[i].y * inv * g.y, v[i].z * inv * g.z, v[i].w * inv * g.w);
        }
    }
}
DI void win_copy_range(const Params& p, int i0, int i1) {
    const int n = 128 * 508 * 128;
    const f32x4* src = reinterpret_cast<const f32x4*>(p.cache_win);
    f32x4* dst = reinterpret_cast<f32x4*>(p.out + O_WINS);
    i1 = min(i1, n);
    for (int ib = i0 + (int)threadIdx.x; ib < i1; ib += 16 * 512) {
        f32x4 v[16];
#pragma unroll
        for (int u = 0; u < 16; ++u) { const int i = min(ib + u * 512, i1 - 1); const int b = i / (508 * 128), r = i - b * (508 * 128); v[u] = src[b * 512 * 128 + 4 * 128 + r]; }
#pragma unroll
        for (int u = 0; u < 16; ++u) { const int i = min(ib + u * 512, i1 - 1); const int b = i / (508 * 128), r = i - b * (508 * 128); dst[b * 512 * 128 + r] = v[u]; }
    }
}
DI int win_w(int x) { return x < 14 ? (int)((0x23345567788867ull >> (4 * x)) & 15) : 0; }
DI int win_wsum(int x) { int s = 0; for (int i = 0; i < x; ++i) s += win_w(i); return s; }
constexpr int WIN_U5 = 79, WIN_UT = 90;
DI void phase5(const Params& p) {
    char* ws = p.ws;
    for (int it = blockIdx.x; it < 256; it += gridDim.x) attn_prompt_item(p, it >> 6, (it >> 5) & 1, it & 31);
    for (int it = blockIdx.x; it < 256; it += gridDim.x) {
        const int x = it & 31;
        if (x >= 2) continue;
        const int j = (it >> 5) * 2 + x;
        EpiRes e{p.x_prompt, p.x_sample, (float*)(ws + WS_X1)};
        gemm_tile((const u16*)(ws + WS_OA), DM, (const u16*)(ws + WS_WOUTA), DM, DM, (32 + (j >> 3)) * 256, (j & 7) * 256, e);
    }
    if (gridDim.x == 256) {
        const int x = blockIdx.x & 31;
        if (x >= 2 && x < 16) gla_norm_gate(p, (blockIdx.x >> 5) * 14 + (x - 2), 112);
        if (win_w(x) > 0) {
            const long n = 128 * 508 * 128, units = 8 * WIN_UT;
            const long u0 = (blockIdx.x >> 5) * WIN_U5 + win_wsum(x), u1 = u0 + win_w(x);
            win_copy_range(p, (int)(n * u0 / units), (int)(n * u1 / units));
        }
    } else {
        gla_norm_gate(p, blockIdx.x, gridDim.x);
    }
}
DI void phase6(const Params& p) {
    char* ws = p.ws;
    for (int t = blockIdx.x; t < 32 * 8; t += gridDim.x) {
        EpiRes e{p.x_prompt, p.x_sample, (float*)(ws + WS_X1)};
        gemm_tile((const u16*)(ws + WS_OA), DM, (const u16*)(ws + WS_WOUTA), DM, DM, (t & 31) * 256, (t >> 5) * 256, e);
    }
    rmsnorm_rows_bf16((const float*)(ws + WS_X1) + (long)NTP * DM, (const float*)(ws + WS_X1) + (long)NTP * DM, NTS, NTS, p.c_norm, (u16*)(ws + WS_H) + (long)NTP * DM, blockIdx.x, gridDim.x);
}
DI EpiInC make_epi_c(const Params& p) {
    char* ws = p.ws;
    return EpiInC{(u16*)(ws + WS_HQT), (u16*)(ws + WS_HKA), (u16*)(ws + WS_HKST), (u16*)(ws + WS_HVT), (u16*)(ws + WS_ZB),
                  (u16*)(ws + WS_HDC), (float*)(ws + WS_PCS), p.c_lb_logits};
}
DI void phase7(const Params& p) {
    char* ws = p.ws;
    for (int t = blockIdx.x; t < 128; t += gridDim.x) {
        const int half = t >> 6, tile = t & 63;
        EpiInC e = make_epi_c(p);
        e.PCS += (long)half * NTS * NC;
        gemm_tile((const u16*)(ws + WS_H) + half * 1024, DM, (const u16*)(ws + WS_WINC) + half * 1024, DM, 1024, (32 + (tile & 1)) * 256, (tile >> 1) * 256, e);
    }
    {
        const int nb = gridDim.x, first = nb > 128 ? 128 : 0, cnt = nb - first;
        if ((int)blockIdx.x >= first) {
            const int rank = blockIdx.x - first;
            rmsnorm_rows_bf16((const float*)(ws + WS_X1), (const float*)(ws + WS_X1), NTP, NTP, p.c_norm, (u16*)(ws + WS_H), rank, cnt);
            const long n = 128 * 508 * 128;
            const long c0 = nb == 256 ? n * (8 * WIN_U5) / (8 * WIN_UT) : 0;
            win_copy_range(p, (int)(c0 + (n - c0) * rank / cnt), (int)(c0 + (n - c0) * (rank + 1) / cnt));
        }
    }
}
DI void phase8(const Params& p) {
    char* ws = p.ws;
    for (int t = blockIdx.x; t < 32 * 32; t += gridDim.x) {
        const EpiInC e = make_epi_c(p);
        gemm_tile((const u16*)(ws + WS_H), DM, (const u16*)(ws + WS_WINC), DM, DM, (t & 31) * 256, (t >> 5) * 256, e);
    }
}
DI void phase9(const Params& p) {
    char* ws = p.ws;
    for (int it = first_item(0); it < 1024; it += gridDim.x) {
        const int bh = it >> 4, b = bh >> 4, h = bh & 15, chunk = (it & 15) * 8 + (threadIdx.x >> 6);
        rec_prep2<8>((const u16*)(ws + WS_HQT) + (long)bh * 262144, (const u16*)(ws + WS_HKA) + (long)bh * 262144,
                     (const u16*)(ws + WS_HVT) + (long)bh * 128 * 128 * 16, (float*)(ws + WS_HOI) + (long)bh * 128 * 8 * 256, chunk);
    }
    if (gridDim.x != 256) hgrn_sample_loop(p, first_item(1024) - 1024, 2048, gridDim.x);
}
DI void phase10(const Params&) {}
DI void phase11(const Params& p) {
    char* ws = p.ws;
    const int nb = gridDim.x, w = __builtin_amdgcn_readfirstlane((int)(threadIdx.x >> 6));
    if (nb == 256) {
        if (threadIdx.x < 4) reinterpret_cast<int*>(smem + RW_OFF + (threadIdx.x >> 1) * RW_PAIR_BYTES + RW_SLOTS * 4096)[threadIdx.x & 1] = 0;
        __syncthreads();
        if (w == 2 || w >= 5) {
            const int sw = w == 2 ? 0 : w - 4;
            for (int n = 0; n < 2; ++n) hgrn_sample_wave(p, (int)blockIdx.x * 4 + sw + 1024 * n, reinterpret_cast<float*>(smem + sw * 8192));
        } else {
            const int ww = w >= 3 ? w - 3 : w;
            const int j = blockIdx.x & 7, local = ((int)blockIdx.x >> 3) + 32 * ww;
            const int t = (j * 8 + (local >> 3)) * 8 + (local & 7);
            const int bh = t >> 3, b = bh >> 4, h = bh & 15, vt = t & 7;
            if (w < 3)
                rec_state_wave<8>((const u16*)(ws + WS_HKST) + (long)bh * 128 * 2048, (const u16*)(ws + WS_HVT) + (long)bh * 128 * 128 * 16,
                                  (const u16*)(ws + WS_HDC) + (long)bh * 128 * 128, vt, p.out + O_HGP + (long)bh * 128 * 128, 128,
                                  RW_OFF + ww * RW_PAIR_BYTES);
            else
                rec_out_wave<8>((const u16*)(ws + WS_HQT) + (long)bh * 262144, (const float*)(ws + WS_HOI) + (long)bh * 128 * 8 * 256, vt,
                                (float*)(ws + WS_OC32) + (long)b * 2048 * DM + h * 128, DM, RW_OFF + ww * RW_PAIR_BYTES);
        }
    } else if (nb >= 64) {
        if ((int)blockIdx.x < 16) {
            for (int t = blockIdx.x; t < 16; t += 16) {
                EpiRes e{(const float*)(ws + WS_X1), (const float*)(ws + WS_X1) + (long)NTP * DM, (float*)(ws + WS_X2)};
                gemm_tile((const u16*)(ws + WS_OA), DM, (const u16*)(ws + WS_WOUTC), DM, DM, (32 + (t >> 3)) * 256, (t & 7) * 256, e);
            }
        } else {
            const int nw = nb - 16;
            if (nb == 256) {
                if (threadIdx.x < 6) reinterpret_cast<int*>(smem + RW_OFF + (threadIdx.x >> 1) * RW_PAIR_BYTES + RW_SLOTS * 4096)[threadIdx.x & 1] = 0;
                __syncthreads();
                const int ww = w >= 3 ? w - 3 : w;
                const int j = blockIdx.x & 7, local = ((int)(blockIdx.x - 16) >> 3) + 30 * ww;
                if (w < 6 && local < 64) {
                    const int t = (j * 8 + (local >> 3)) * 8 + (local & 7);
                    const int bh = t >> 3, b = bh >> 4, h = bh & 15, vt = t & 7;
                    if (w < 3)
                        rec_state_wave<8>((const u16*)(ws + WS_HKST) + (long)bh * 128 * 2048, (const u16*)(ws + WS_HVT) + (long)bh * 128 * 128 * 16,
                                          (const u16*)(ws + WS_HDC) + (long)bh * 128 * 128, vt, p.out + O_HGP + (long)bh * 128 * 128, 128,
                                          RW_OFF + ww * RW_PAIR_BYTES);
                    else
                        rec_out_wave<8>((const u16*)(ws + WS_HQT) + (long)bh * 262144, (const float*)(ws + WS_HOI) + (long)bh * 128 * 8 * 256, vt,
                                        (float*)(ws + WS_OC32) + (long)b * 2048 * DM + h * 128, DM, RW_OFF + ww * RW_PAIR_BYTES);
                }
            } else {
                for (int t0 = (blockIdx.x - 16) + nw * w; t0 < 512; t0 += nw * 8) {
                    const int t = t0;
                    const int bh = t >> 3, b = bh >> 4, h = bh & 15, vt = t & 7;
                    rec_walker<8>((const u16*)(ws + WS_HQT) + (long)bh * 262144, (const u16*)(ws + WS_HKST) + (long)bh * 128 * 2048,
                                  (const u16*)(ws + WS_HVT) + (long)bh * 128 * 128 * 16, (const u16*)(ws + WS_HDC) + (long)bh * 128 * 128,
                                  (const float*)(ws + WS_HOI) + (long)bh * 128 * 8 * 256, vt,
                                  (float*)(ws + WS_OC32) + (long)b * 2048 * DM + h * 128, DM, p.out + O_HGP + (long)bh * 128 * 128, 128);
                }
            }
        }
    } else {
        for (int t = blockIdx.x; t < 16; t += nb) {
            EpiRes e{(const float*)(ws + WS_X1), (const float*)(ws + WS_X1) + (long)NTP * DM, (float*)(ws + WS_X2)};
            gemm_tile((const u16*)(ws + WS_OA), DM, (const u16*)(ws + WS_WOUTC), DM, DM, (32 + (t >> 3)) * 256, (t & 7) * 256, e);
        }
        for (int t = blockIdx.x + nb * w; t < 512; t += nb * 8) {
            const int bh = t >> 3, b = bh >> 4, h = bh & 15, vt = t & 7;
            rec_walker<8>((const u16*)(ws + WS_HQT) + (long)bh * 262144, (const u16*)(ws + WS_HKST) + (long)bh * 128 * 2048,
                          (const u16*)(ws + WS_HVT) + (long)bh * 128 * 128 * 16, (const u16*)(ws + WS_HDC) + (long)bh * 128 * 128,
                          (const float*)(ws + WS_HOI) + (long)bh * 128 * 8 * 256, vt,
                          (float*)(ws + WS_OC32) + (long)b * 2048 * DM + h * 128, DM, p.out + O_HGP + (long)bh * 128 * 128, 128);
        }
    }
}
DI void phase12(const Params& p) {
    char* ws = p.ws;
    if (gridDim.x == 256) {
        if (blockIdx.x < 64) {
            const int q4 = blockIdx.x >> 4, t = blockIdx.x & 15;
            EpiStore e{(float*)(ws + WS_PROJC) + ((long)q4 * NTS - NTP) * DM, DM};
            gemm_tile((const u16*)(ws + WS_OA) + q4 * 512, DM, (const u16*)(ws + WS_WOUTC) + q4 * 512, DM, 512, (32 + (t >> 3)) * 256, (t & 7) * 256, e);
        } else {
            hgrn_norm_gate(p, blockIdx.x - 64, 192);
        }
    } else {
        hgrn_norm_gate(p, blockIdx.x, gridDim.x);
    }
}
DI void phase13(const Params& p) {
    char* ws = p.ws;
    for (int t = blockIdx.x; t < 32 * 8; t += gridDim.x) {
        EpiRes e{(const float*)(ws + WS_X1), (const float*)(ws + WS_X1) + (long)NTP * DM, (float*)(ws + WS_X2)};
        gemm_tile((const u16*)(ws + WS_OA), DM, (const u16*)(ws + WS_WOUTC), DM, DM, (t & 31) * 256, (t >> 5) * 256, e);
    }
    final_norm_rows(p, NTP, NT, gridDim.x == 256 ? 4 : 0);
}
DI void phase14(const Params& p) { final_norm_rows(p, 0, NTP, 0); }

template <int PH> DI void run_phase(const Params& p) {
    if (PH == 0) phase0(p);
    if (PH == 1) phase1(p);
    if (PH == 2) phase2(p);
    if (PH == 3) phase3(p);
    if (PH == 4) phase4(p);
    if (PH == 5) phase5(p);
    if (PH == 6) phase6(p);
    if (PH == 7) phase7(p);
    if (PH == 8) phase8(p);
    if (PH == 9) phase9(p);
    if (PH == 10) phase10(p);
    if (PH == 11) phase11(p);
    if (PH == 12) phase12(p);
    if (PH == 13) phase13(p);
    if (PH == 14) phase14(p);
}

#ifndef MK_MULTI
#define MK_MULTI 0
#endif

#ifndef MK_DUMP_LO
#define MK_DUMP_LO 0
#define MK_DUMP_HI 4096
#endif
#if MK_MULTI
template <int PH> __global__ void __launch_bounds__(512, 2) k_phase(Params p) { run_phase<PH>(p); }
__global__ void k_dump(const float4* src, float4* dst, long n) {
    const u16* s = (const u16*)src; float* d = (float*)dst;
    for (long i = (long)blockIdx.x * blockDim.x + threadIdx.x; i < n; i += (long)gridDim.x * blockDim.x) { float v = bf2f(s[i]); const int col = (int)(i & 2047); if (col < MK_DUMP_LO || col >= MK_DUMP_HI) v = 0.f; d[i] = (fabsf(v) < 1e30f) ? v : 12345.f; } }
#else
__global__ void __launch_bounds__(512, 2) k_forward(Params p) {
    volatile LAS unsigned* xbw = (volatile LAS unsigned*)(smem + LDS_BYTES - 16);
    if (threadIdx.x == 0) { xbw[0] = 0u; xbw[1] = 0u; xbw[2] = 0u; xbw[3] = 0u; }
    __syncthreads();
    XcdBarrier bar = xcd_barrier_post(reinterpret_cast<unsigned*>(p.ws + WS_BAR), xbw);
#ifndef MK_DUP
#define MK_DUP -1
#endif
#define RUN_PH(PH) do { run_phase<PH>(p); if (MK_DUP == PH) { xcd_barrier(bar); run_phase<PH>(p); } } while (0)
    RUN_PH(0);  xcd_barrier(bar);
    RUN_PH(1);  xcd_barrier(bar);
    RUN_PH(2);  xcd_barrier(bar);
    RUN_PH(3);  xcd_barrier(bar);
    RUN_PH(4);  xcd_barrier(bar);
    RUN_PH(5);  xcd_barrier(bar);
    RUN_PH(6);  xcd_barrier(bar);
    RUN_PH(7);  xcd_barrier(bar);
    RUN_PH(8);  xcd_barrier(bar);
    RUN_PH(9);  xcd_barrier(bar);
#ifdef DBG_XBAR
    for (int i = 0; i < DBG_XBAR; ++i) xcd_barrier(bar);
#endif
    RUN_PH(11); xcd_barrier(bar);
    RUN_PH(12); xcd_barrier(bar);
    RUN_PH(13); xcd_barrier(bar);
    RUN_PH(14);
}
#endif

extern "C" void kernel_launch(void* const* d_in, const int* in_sizes, int n_in, void* d_out, int out_size, void* d_ws, size_t ws_size,
                              hipStream_t stream) {
    (void)in_sizes; (void)n_in; (void)out_size; (void)ws_size;
    Params p{};
    p.x_prompt = (const float*)d_in[0];  p.x_sample = (const float*)d_in[1];  p.cache_kv = (const float*)d_in[2];
    p.cache_win = (const float*)d_in[3]; p.state_gla = (const float*)d_in[4]; p.state_hgrn = (const float*)d_in[5];
    p.page_table = (const int*)d_in[6];
    p.a_norm = (const float*)d_in[7];    p.a_w_in = (const float*)d_in[8];    p.a_gla_w2 = (const float*)d_in[9];
    p.a_gla_b = (const float*)d_in[10];  p.a_gla_gn = (const float*)d_in[11]; p.a_cmp_pe = (const float*)d_in[12];
    p.a_cmp_w1 = (const float*)d_in[13]; p.a_cmp_b1 = (const float*)d_in[14]; p.a_cmp_w2 = (const float*)d_in[15];
    p.a_w_out = (const float*)d_in[16];  p.c_norm = (const float*)d_in[17];   p.c_w_in = (const float*)d_in[18];
    p.c_lb_logits = (const float*)d_in[19]; p.c_gn = (const float*)d_in[20];  p.c_w_out = (const float*)d_in[21];
    p.final_norm = (const float*)d_in[22];
    p.out = (float*)d_out; p.ws = (char*)d_ws;
    static int grid = 0;
#if MK_MULTI
    if (!grid) {
        int dev = 0, cus = 0; (void)hipGetDevice(&dev); (void)hipDeviceGetAttribute(&cus, hipDeviceAttributeMultiprocessorCount, dev);
        grid = cus > 0 ? cus : 256;
    }
#define LAUNCH_PH(PH) do { (void)hipFuncSetAttribute((const void*)k_phase<PH>, hipFuncAttributeMaxDynamicSharedMemorySize, LDS_BYTES); \
        hipLaunchKernelGGL(k_phase<PH>, dim3(grid), dim3(512), LDS_BYTES, stream, p); } while (0)
#ifndef MK_LAST
#define MK_LAST 14
#endif
#ifndef MK_SKIP
#define MK_SKIP 99
#endif
#define LAUNCH_IF(PH) do { if (PH <= MK_LAST && PH != MK_SKIP) LAUNCH_PH(PH); } while (0)
    LAUNCH_IF(0); LAUNCH_IF(1); LAUNCH_IF(2); LAUNCH_IF(3); LAUNCH_IF(4); LAUNCH_IF(5); LAUNCH_IF(6);
    LAUNCH_IF(7); LAUNCH_IF(8); LAUNCH_IF(9); LAUNCH_IF(10); LAUNCH_IF(11); LAUNCH_IF(12); LAUNCH_IF(13); LAUNCH_IF(14);
#ifdef MK_DUMP_OFF
    hipLaunchKernelGGL(k_dump, dim3(1024), dim3(256), 0, stream, (const float4*)(p.ws + MK_DUMP_OFF), (float4*)p.out, (long)MK_DUMP_N4);
#endif
#else
    if (!grid) {
        int dev = 0, cus = 0, per_cu = 0; (void)hipGetDevice(&dev); (void)hipDeviceGetAttribute(&cus, hipDeviceAttributeMultiprocessorCount, dev);
        (void)hipFuncSetAttribute((const void*)k_forward, hipFuncAttributeMaxDynamicSharedMemorySize, LDS_BYTES);
        (void)hipOccupancyMaxActiveBlocksPerMultiprocessor(&per_cu, (const void*)k_forward, 512, LDS_BYTES);
        if (cus <= 0) cus = 256;
        grid = cus * (per_cu < 1 ? 1 : 1);
    }
    (void)hipMemsetAsync(d_ws, 0, 65536, stream);
    hipLaunchKernelGGL(k_forward, dim3(grid), dim3(512), LDS_BYTES, stream, p);
#endif
}
```

```cpp
#include <hip/hip_runtime.h>
#include <stdint.h>

typedef unsigned short u16;
typedef unsigned int u32;
typedef unsigned long long u64;
using bf16x8 = __attribute__((ext_vector_type(8))) short;
using f32x4  = __attribute__((ext_vector_type(4))) float;
using f32x16 = __attribute__((ext_vector_type(16))) float;
using u32x4  = __attribute__((ext_vector_type(4))) unsigned;
using u32x2  = __attribute__((ext_vector_type(2))) unsigned;
#define DI __device__ __forceinline__

constexpr int DM = 2048, NTP = 8192, NTS = 512, NT = 8704;
constexpr int SEQ = 2048, NB = 4, DB = 128, DSEQ = 4, PAST = 2048;
constexpr int NA = 6696, NAP = 6912, NC = 8192;
constexpr int CQ = 0, CKV = 1024, CZA = 2560, CQB = 3584, CKB = 4096, CVB = 4608, CZB = 5632, CGB = 6656, CLR = 6680;
constexpr float QSCALE = 0.08838834764831845f;
constexpr float QSCALE_L2E = 0.08838834764831845f * 1.4426950408889634f;

constexpr long O_YP = 0, O_YS = 16777216, O_KVP = 17825792, O_KVS = 26214400, O_WINP = 26738688, O_WINS = 27787264,
               O_GLAP = 61341696, O_GLAS = 61865984, O_HGP = 78643200, O_HGS = 79691776;

constexpr size_t AL(size_t x) { return (x + 255) & ~(size_t)255; }
constexpr size_t WS_BAR   = 0;
constexpr size_t WS_WINA  = 65536;
constexpr size_t WS_WOUTA = WS_WINA  + AL((size_t)NAP * DM * 2);
constexpr size_t WS_WINC  = WS_WOUTA + AL((size_t)DM * DM * 2);
constexpr size_t WS_WOUTC = WS_WINC  + AL((size_t)NC * DM * 2);
constexpr size_t WS_W1T   = WS_WOUTC + AL((size_t)DM * DM * 2);
constexpr size_t WS_W2T   = WS_W1T   + AL((size_t)2 * 256 * 4096 * 2);
constexpr size_t WS_HCONST= WS_W2T   + AL((size_t)2 * 256 * 256 * 2);
constexpr size_t WS_H     = WS_HCONST+ AL(2 * 256 * 4);
constexpr size_t WS_XCS   = WS_H     + AL((size_t)NT * DM * 2);
constexpr size_t WS_KV6   = WS_XCS   + AL((size_t)2 * 128 * 2 * 2048 * 128 * 2 + 16384);
constexpr size_t WS_VT    = WS_KV6   + AL((size_t)6 * 4 * 2 * 2048 * 128 * 2 + 16384);
constexpr size_t WS_KF    = WS_VT    + AL((size_t)2 * 4 * 2 * 128 * 2048 * 2 + 16384);
constexpr size_t WS_A2S   = WS_KF    + AL((size_t)2 * 4 * 2 * 128 * 2048 * 2 + 16384);
constexpr size_t WS_A2P   = WS_A2S   + AL((size_t)2 * 32768 * 256 * 2);
constexpr size_t WS_KCS   = WS_A2P   + AL((size_t)2 * 1024 * 256 * 2);
constexpr size_t WS_KCP   = WS_KCS   + AL((size_t)2 * 256 * 128 * 128 * 4);
constexpr size_t WS_VCTP  = WS_KCP   + AL((size_t)8 * 128 * 128 * 2 + 4096);
constexpr size_t WS_PROJ  = WS_VCTP  + AL((size_t)8 * 128 * 128 * 2 + 4096);
constexpr size_t WS_Q     = WS_PROJ  + AL((size_t)NT * NAP * 4);
constexpr size_t WS_GQT   = WS_Q     + AL((size_t)NT * 1024 * 2);
constexpr size_t WS_GKA   = WS_GQT   + AL((size_t)NTP * 512 * 2);
constexpr size_t WS_GKST  = WS_GKA   + AL((size_t)NTP * 512 * 2);
constexpr size_t WS_GVT   = WS_GKST  + AL((size_t)NTP * 512 * 2);
constexpr size_t WS_GDC   = WS_GVT   + AL((size_t)NTP * 1024 * 2);
constexpr size_t WS_GOI   = WS_GDC   + AL((size_t)16 * 128 * 128 * 4);
constexpr size_t WS_OB32  = WS_GOI   + AL((size_t)16 * 128 * 16 * 256 * 4);
constexpr size_t WS_OA    = WS_OB32  + AL((size_t)NTP * 1024 * 4);
constexpr size_t WS_X1    = WS_OA    + AL((size_t)NT * DM * 2);
constexpr size_t WS_PROJC = WS_X1    + AL((size_t)NT * DM * 4);
constexpr size_t WS_HQT   = WS_PROJC + AL((size_t)NT * NC * 4);
constexpr size_t WS_HKA   = WS_HQT   + AL((size_t)NTP * DM * 2);
constexpr size_t WS_HKST  = WS_HKA   + AL((size_t)NTP * DM * 2);
constexpr size_t WS_HVT   = WS_HKST  + AL((size_t)NTP * DM * 2);
constexpr size_t WS_HDC   = WS_HVT   + AL((size_t)NTP * DM * 2);
constexpr size_t WS_HOI   = WS_HDC   + AL((size_t)64 * 128 * 128 * 4);
constexpr size_t WS_OC32  = WS_HOI   + AL((size_t)64 * 128 * 8 * 256 * 4);
constexpr size_t WS_X2    = WS_OC32  + AL((size_t)NTP * DM * 4);
constexpr size_t WS_ZB    = WS_X2    + AL((size_t)NT * DM * 4);
constexpr size_t WS_PCS   = WS_ZB    + AL((size_t)NTP * DM * 2);
constexpr size_t WS_CPP   = WS_PCS   + AL((size_t)2 * NTS * NC * 4);
constexpr size_t WS_END   = WS_CPP   + AL((size_t)4 * 1024 * 256 * 4);

struct Params {
    const float *x_prompt, *x_sample, *cache_kv, *cache_win, *state_gla, *state_hgrn;
    const int* page_table;
    const float *a_norm, *a_w_in, *a_gla_w2, *a_gla_b, *a_gla_gn, *a_cmp_pe, *a_cmp_w1, *a_cmp_b1, *a_cmp_w2, *a_w_out;
    const float *c_norm, *c_w_in, *c_lb_logits, *c_gn, *c_w_out, *final_norm;
    float* out;
    char* ws;
};

extern __shared__ __attribute__((aligned(16))) char smem[];
constexpr int LDS_BYTES = 148480;

typedef float f32x2_t __attribute__((ext_vector_type(2))); typedef __bf16 bf16x2_t __attribute__((ext_vector_type(2)));
DI u32 cvt_pk(float lo, float hi) { f32x2_t v = {lo, hi}; bf16x2_t b = __builtin_convertvector(v, bf16x2_t); return __builtin_bit_cast(u32, b); }
DI u16 f2bf(float x) { return (u16)(cvt_pk(x, 0.f) & 0xffffu); }
DI float bf2f(u16 x) { return __uint_as_float(((u32)x) << 16); }
DI float bflo(u32 w) { return __uint_as_float(w << 16); }
DI float bfhi(u32 w) { return __uint_as_float(w & 0xffff0000u); }
DI float wave_sum(float v) {
#pragma unroll
    for (int o = 32; o >= 1; o >>= 1) v += __shfl_xor(v, o, 64);
    return v;
}
DI float exp2f_(float x) { return __builtin_amdgcn_exp2f(x); }
using f16x2 = __attribute__((ext_vector_type(2))) _Float16;
DI u16 f2h(float x) { const _Float16 h = (_Float16)x; return __builtin_bit_cast(u16, h); }
DI float sigmoidf_(float x) { return 1.f / (1.f + __expf(-x)); }
DI float siluf_(float x) { return x / (1.f + __expf(-x)); }
DI float logsigmoidf_(float x) { return fminf(x, 0.f) - log1pf(__expf(-fabsf(x))); }
DI float gelu_tanh(float x) { const float u = 0.7978845608028654f * (x + 0.044715f * x * x * x); return x / (1.f + __expf(-2.f * u)); }
DI bf16x8 mk8(u32 a, u32 b, u32 c, u32 d) { u32x4 v = {a, b, c, d}; return __builtin_bit_cast(bf16x8, v); }
DI bf16x8 ld8(const u16* p) { return *reinterpret_cast<const bf16x8*>(p); }
DI f32x4 mfma16(bf16x8 a, bf16x8 b, f32x4 c) { return __builtin_amdgcn_mfma_f32_16x16x32_bf16(a, b, c, 0, 0, 0); }
DI f32x16 mfma32(bf16x8 a, bf16x8 b, f32x16 c) { return __builtin_amdgcn_mfma_f32_32x32x16_bf16(a, b, c, 0, 0, 0); }

#define XB_TMO      128
#define XB_XCNT(j)  (256  + 64 * (j))
#define XB_XSUB(j)  (1280 + 64 * (j))
#define XB_XGEN(j)  (2304 + 64 * (j))
#define XB_TOP      3328
#define XB_TOPGEN   3392
#define XCD_BAR_WORDS 3456
#define XB_SPIN_CAP (1u << 18)
#define LAS __attribute__((address_space(3)))

__device__ __forceinline__ unsigned xb_ld(unsigned* p)              { return __hip_atomic_load(p, __ATOMIC_RELAXED, __HIP_MEMORY_SCOPE_AGENT); }
__device__ __forceinline__ unsigned xb_add(unsigned* p, unsigned v) { return __hip_atomic_fetch_add(p, v, __ATOMIC_RELAXED, __HIP_MEMORY_SCOPE_AGENT); }
__device__ __forceinline__ unsigned xb_xcc_id() { return (unsigned)__builtin_amdgcn_s_getreg((3 << 11) | 20) & 0xFu; }
#define XB_SPIN(cond, bar) do { unsigned _sp = 0; while (cond) { __builtin_amdgcn_s_sleep(1); \
    if ((++_sp & 255u) == 0u) { if (xb_ld(&(bar)[XB_TMO])) break; if (_sp > XB_SPIN_CAP) { atomicAdd(&(bar)[XB_TMO], 1u); break; } } } } while (0)

struct XcdBarrier { unsigned* bar; unsigned x; volatile LAS unsigned* st; };

__device__ __forceinline__ XcdBarrier xcd_barrier_post(unsigned* bar, volatile LAS unsigned* st) {
    XcdBarrier b; b.bar = bar; b.x = xb_xcc_id(); b.st = st;
    if (threadIdx.x == 0) (void)xb_add(&bar[XB_XCNT(b.x)], 1u);
    return b;
}
__device__ __forceinline__ void xcd_barrier_complete(unsigned* bar, unsigned x, unsigned& nloc, unsigned& nx) {
    const unsigned G = gridDim.x * gridDim.y * gridDim.z;
    unsigned sum, cnt, mine, sp = 0u;
    for (;;) {
        sum = 0u; cnt = 0u; mine = 0u;
#pragma unroll
        for (unsigned j = 0; j < 16; ++j) { const unsigned c = xb_ld(&bar[XB_XCNT(j)]); sum += c; cnt += (c > 0u) ? 1u : 0u; mine = (j == x) ? c : mine; }
        if (sum == G) break;
        __builtin_amdgcn_s_sleep(1);
        if ((++sp & 255u) == 0u) { if (xb_ld(&bar[XB_TMO])) break; if (sp > XB_SPIN_CAP) { atomicAdd(&bar[XB_TMO], 1u); break; } }
    }
    nloc = mine > 0u ? mine : 1u; nx = cnt > 0u ? cnt : 1u;
}
__device__ __forceinline__ void xcd_barrier(const XcdBarrier& b) {
    asm volatile("s_waitcnt vmcnt(0)" ::: "memory");
    __syncthreads();
    if (threadIdx.x == 0) {
        unsigned* bar = b.bar;
        __builtin_amdgcn_s_waitcnt(0);
        unsigned nloc = b.st[0], nx = b.st[1];
        if (nloc == 0u) { xcd_barrier_complete(bar, b.x, nloc, nx); b.st[0] = nloc; b.st[1] = nx; }
        const unsigned old = xb_add(&bar[XB_XSUB(b.x)], 1u);
        const unsigned gen = old / nloc;
        if (old + 1u == (gen + 1u) * nloc) {
            __builtin_amdgcn_fence(__ATOMIC_RELEASE, "agent");
            asm volatile("s_waitcnt vmcnt(0)" ::: "memory");
            const unsigned og = xb_add(&bar[XB_TOP], 1u);
            const unsigned tg = og / nx;
            if (og + 1u == (tg + 1u) * nx) xb_add(&bar[XB_TOPGEN], 1u);
            else XB_SPIN(xb_ld(&bar[XB_TOPGEN]) == tg, bar);
            __builtin_amdgcn_fence(__ATOMIC_ACQUIRE, "agent");
            xb_add(&bar[XB_XGEN(b.x)], 1u);
            asm volatile("s_waitcnt vmcnt(0)" ::: "memory");
        } else {
            XB_SPIN(xb_ld(&bar[XB_XGEN(b.x)]) == gen, bar);
            __builtin_amdgcn_fence(__ATOMIC_ACQUIRE, "agent");
            asm volatile("s_waitcnt vmcnt(0)" ::: "memory");
        }
    }
    __syncthreads();
}

constexpr int G_BK = 64, G_HALF = 128, G_HT = G_HALF * G_BK;
DI int g_lds_byte(int r, int c) {
    int st = (r >> 4) * 2 + (c >> 5), rr = r & 15, cc = c & 31, ob = rr * 64 + cc * 2;
    return st * 1024 + (ob ^ (((ob >> 9) & 1) << 5));
}
DI void g_stage_rc(int b, int& R, int& C) {
    int st = b / 1024, sb = b % 1024, swz = sb ^ (((sb >> 9) & 1) << 5);
    R = (st >> 1) * 16 + swz / 64; C = (st & 1) * 32 + (swz % 64) / 2;
}

template <class Epi>
DI void gemm_tile(const u16* __restrict__ A, int lda, const u16* __restrict__ Bt, int ldb, int K, int brow, int bcol, const Epi& epi) {
    u16* shm = reinterpret_cast<u16*>(smem);
#define SA(b,h) (shm+((b)*2+(h))*G_HT)
#define SB(b,h) (shm+(4+(b)*2+(h))*G_HT)
#define STAGE_X(T,P,BASE,LD,br,kt,OFF) do{const u16* _gb=(BASE)+((long)(br)*(LD)+(long)(kt)*G_BK); \
    for(int _i=0;_i<2;++_i){int _b=(T)*16+_i*8192; \
      __builtin_amdgcn_global_load_lds((const unsigned*)(_gb+OFF[_i]), \
        (unsigned*)((char*)(P)+_b),16,0,0);}}while(0)
#define STAGEA(P,br,kt) STAGE_X(t0,P,A,lda,br,kt,offA)
#define STAGEB(P,br,kt) STAGE_X(t0,P,Bt,ldb,br,kt,offB)
#define MKOFF(T) do{for(int _i=0;_i<2;++_i){int _r,_c;g_stage_rc((T)*16+_i*8192,_r,_c);offA[_i]=_r*lda+_c;offB[_i]=_r*ldb+_c;}}while(0)
#define LDA(dst,b,h) for(int m=0;m<4;++m)for(int k=0;k<2;++k) \
    dst[m][k]=*reinterpret_cast<const bf16x8*>((char*)SA(b,h)+g_lds_byte(wr*64+m*16+fr,k*32+fq*8))
#define LDB(dst,b,h) for(int n=0;n<2;++n)for(int k=0;k<2;++k) \
    dst[n][k]=*reinterpret_cast<const bf16x8*>((char*)SB(b,h)+g_lds_byte(wc*32+n*16+fr,k*32+fq*8))
#define MMA(ai,bj,At,Bx) do{__builtin_amdgcn_s_setprio(1); \
    for(int m=0;m<4;++m)for(int n=0;n<2;++n)for(int k=0;k<2;++k) \
      acc[ai][bj][m][n]=__builtin_amdgcn_mfma_f32_16x16x32_bf16(At[m][k],Bx[n][k],acc[ai][bj][m][n],0,0,0); \
    __builtin_amdgcn_s_setprio(0);}while(0)
#define WAIT_V(n) asm volatile("s_waitcnt vmcnt(" #n ")":::"memory")
#define WAIT_L(n) asm volatile("s_waitcnt lgkmcnt(" #n ")":::"memory")
#define BAR __builtin_amdgcn_s_barrier()
#define SCHED __builtin_amdgcn_sched_barrier(0)
    int t0 = threadIdx.x; asm volatile("" : "+v"(t0));
    int wid = t0 >> 6, lane = t0 & 63, wr = wid >> 2, wc = wid & 3, fr = lane & 15, fq = lane >> 4;
    f32x4 acc[2][2][4][2] = {};
    bf16x8 At[4][2], B0[2][2], B1[2][2];
    const int nt = K / G_BK;
    int offA[2], offB[2];
    MKOFF(t0);
    WAIT_V(0);
    STAGEB(SB(0,0),bcol,0); STAGEA(SA(0,0),brow,0);
    STAGEB(SB(0,1),bcol+G_HALF,0); STAGEA(SA(0,1),brow+G_HALF,0);
    if(wr==1)BAR;
    WAIT_V(4); BAR;
    STAGEB(SB(1,0),bcol,1); STAGEA(SA(1,0),brow,1); STAGEB(SB(1,1),bcol+G_HALF,1);
    WAIT_V(6); BAR;
    for(int t=0;t<nt-2;t+=2){
      LDB(B0,0,0); SCHED; LDA(At,0,0); STAGEA(SA(1,1),brow+G_HALF,t+1);
      WAIT_L(8); BAR; WAIT_L(0); MMA(0,0,At,B0); BAR; SCHED;
      LDB(B1,0,1); STAGEB(SB(0,0),bcol,t+2);
      BAR; WAIT_L(0); MMA(0,1,At,B1); BAR;
      LDA(At,0,1); STAGEA(SA(0,0),brow,t+2);
      BAR; WAIT_L(0); MMA(1,0,At,B0); BAR; SCHED;
      STAGEB(SB(0,1),bcol+G_HALF,t+2);
      WAIT_V(6); BAR; MMA(1,1,At,B1); BAR;
      LDB(B0,1,0); SCHED; LDA(At,1,0); STAGEA(SA(0,1),brow+G_HALF,t+2);
      WAIT_L(8); BAR; WAIT_L(0); MMA(0,0,At,B0); BAR; SCHED;
      LDB(B1,1,1); STAGEB(SB(1,0),bcol,t+3);
      BAR; WAIT_L(0); MMA(0,1,At,B1); BAR;
      LDA(At,1,1); STAGEA(SA(1,0),brow,t+3);
      BAR; WAIT_L(0); MMA(1,0,At,B0); BAR; SCHED;
      STAGEB(SB(1,1),bcol+G_HALF,t+3);
      WAIT_V(6); BAR; MMA(1,1,At,B1); BAR;
    }
    int tz=t0; asm volatile("":"+v"(tz)); wid=tz>>6; lane=tz&63; wr=wid>>2; wc=wid&3; fr=lane&15; fq=lane>>4;
    MKOFF(tz);
    { LDB(B0,0,0); WAIT_V(0); LDA(At,0,0); STAGE_X(tz,SA(1,1),A,lda,brow+G_HALF,nt-1,offA);
      BAR; WAIT_L(0); MMA(0,0,At,B0); BAR;
      LDB(B1,0,1); BAR; WAIT_L(0); MMA(0,1,At,B1); BAR;
      LDA(At,0,1); WAIT_V(4); BAR; WAIT_L(0); MMA(1,0,At,B0); MMA(1,1,At,B1); BAR; }
    { LDB(B0,1,0); LDA(At,1,0); WAIT_V(2); BAR; WAIT_L(0); MMA(0,0,At,B0); BAR;
      LDB(B1,1,1); WAIT_V(0); BAR; WAIT_L(0); MMA(0,1,At,B1); BAR;
      LDA(At,1,1); BAR; WAIT_L(0); MMA(1,0,At,B0); MMA(1,1,At,B1); BAR; }
    if(wr==0)BAR;
    {
        float* Cs = reinterpret_cast<float*>(smem);
        const bool cm = epi.colmode(brow, bcol), tm = epi.tilemode(brow, bcol);
#pragma unroll
        for (int ai = 0; ai < 2; ++ai) {
#pragma unroll
            for (int bj = 0; bj < 2; ++bj)
#pragma unroll
                for (int m = 0; m < 4; ++m)
#pragma unroll
                    for (int n = 0; n < 2; ++n)
#pragma unroll
                        for (int j = 0; j < 4; ++j)
                            Cs[(wr * 64 + m * 16 + fq * 4 + j) * 256 + bj * G_HALF + wc * 32 + n * 16 + fr] = acc[ai][bj][m][n][j];
            __syncthreads();
            if (tm) {
                epi.tile(Cs, brow + ai * G_HALF, bcol, tz);
            } else if (cm) {
#pragma unroll 4
                for (int i = 0; i < 16; ++i) {
                    const int idx = i * 512 + tz, col = idx & 255, rg = idx >> 8;
                    f32x4 v;
                    v[0] = Cs[(rg * 4 + 0) * 256 + col]; v[1] = Cs[(rg * 4 + 1) * 256 + col]; v[2] = Cs[(rg * 4 + 2) * 256 + col]; v[3] = Cs[(rg * 4 + 3) * 256 + col];
                    epi.col4(brow + ai * G_HALF + rg * 4, bcol + col, v);
                }
            } else {
#pragma unroll 4
                for (int i = 0; i < 16; ++i) {
                    const int idx = i * 512 + tz, row = idx >> 6, c4 = (idx & 63) * 4;
                    epi.row4(brow + ai * G_HALF + row, bcol + c4, *reinterpret_cast<const f32x4*>(Cs + row * 256 + c4));
                }
            }
            __syncthreads();
        }
    }
#undef SA
#undef SB
#undef STAGE_X
#undef STAGEA
#undef STAGEB
#undef MKOFF
#undef LDA
#undef LDB
#undef MMA
}

DI u32x2 pk4(f32x4 v) { u32x2 w = {cvt_pk(v[0], v[1]), cvt_pk(v[2], v[3])}; return w; }
struct EpiInA {
    float* proj; u16* Q; u16* KV6; u16* VT; u16* KF; float* out;
    DI bool tilemode(int, int) const { return false; }
    DI void tile(const float*, int, int, int) const {}
    DI bool colmode(int brow, int bcol) const { const int slot = (bcol - CKV) >> 8; return brow < NTP && bcol >= CKV && (slot == 3 || slot == 5); }
    DI void row4(int row, int col0, f32x4 v) const {
        if (col0 < CKV) {
            *reinterpret_cast<u32x2*>(Q + row * 1024 + col0) = pk4(v * QSCALE_L2E);
        } else if (col0 < CZA) {
            const int c1 = col0 - CKV, slot = c1 >> 8, g = (c1 >> 7) & 1, d = c1 & 127;
            if (row < NTP) {
                const int b = row >> 11, t = row & 2047;
                if (slot < 2) {
                    *reinterpret_cast<u32x2*>(KV6 + ((((slot * 4 + b) * 2 + g) * 2048 + t) * 128 + d)) = pk4(v);
                } else {
                    const int which = slot == 4 ? 1 : 0;
                    *reinterpret_cast<u32x2*>(KF + ((((which * 4 + b) * 2 + g) * 64 + (t >> 5)) * 4096 + (d >> 4) * 512 + (((d >> 3) & 1) * 32 + (t & 31)) * 8 + (d & 7))) = pk4(v);
                }
                if (c1 < 1024) *reinterpret_cast<f32x4*>(out + O_KVP + row * 1024 + c1) = v;
                else if (t >= 1536) *reinterpret_cast<f32x4*>(out + O_WINP + (b * 512 + t - 1536) * 512 + (c1 - 1024)) = v;
            } else {
                const int rr = row - NTP, b = rr >> 2, t = rr & 3;
                if (c1 < 1024) *reinterpret_cast<f32x4*>(out + O_KVS + rr * 1024 + c1) = v;
                else *reinterpret_cast<f32x4*>(out + O_WINS + (b * 512 + 508 + t) * 512 + (c1 - 1024)) = v;
                *reinterpret_cast<f32x4*>(proj + (long)row * NAP + col0) = v;
            }
        } else {
            *reinterpret_cast<f32x4*>(proj + (long)row * NAP + col0) = v;
        }
    }
    DI void col4(int row0, int col, f32x4 v) const {
        const int c1 = col - CKV, slot = c1 >> 8, g = (c1 >> 7) & 1, d = c1 & 127;
        const int b = row0 >> 11, t = row0 & 2047;
        {
            const int which = slot == 5 ? 1 : 0, r = t & 31, kk = r & 15;
            *reinterpret_cast<u32x2*>(VT + (((((which * 4 + b) * 2 + g) * 64 + (t >> 5)) * 8 + (r >> 4) * 4 + (d >> 5)) * 512 + (((kk >> 2) & 1) * 32 + (d & 31)) * 8 + (kk >> 3) * 4)) = pk4(v);
        }
        if (c1 < 1024) {
#pragma unroll
            for (int j = 0; j < 4; ++j) out[O_KVP + (row0 + j) * 1024 + c1] = v[j];
        } else if (t >= 1536) {
#pragma unroll
            for (int j = 0; j < 4; ++j) out[O_WINP + (b * 512 + t + j - 1536) * 512 + (c1 - 1024)] = v[j];
        }
    }
};
struct EpiCmp1 {
    const float* hc; u16* A2;
    DI bool tilemode(int, int) const { return false; }
    DI void tile(const float*, int, int, int) const {}
    DI bool colmode(int, int) const { return false; }
    DI void col4(int, int, f32x4) const {}
    DI void row4(int row, int col0, f32x4 v) const {
        const f32x4 h0 = *reinterpret_cast<const f32x4*>(hc + col0);
        f32x4 o;
#pragma unroll
        for (int j = 0; j < 4; ++j) o[j] = ((row & 127) == 127) ? 0.f : gelu_tanh(v[j] + h0[j]);
        *reinterpret_cast<u32x2*>(A2 + row * 256 + col0) = pk4(o);
    }
};
struct EpiCmp2S {
    float* dst;
    DI bool tilemode(int, int) const { return false; }
    DI void tile(const float*, int, int, int) const {}
    DI bool colmode(int, int) const { return false; }
    DI void col4(int, int, f32x4) const {}
    DI void row4(int row, int col0, f32x4 v) const { if (col0 < 128) *reinterpret_cast<f32x4*>(dst + row * 128 + col0) = v; }
};
struct EpiCmp2P {
    u16* kc; u16* vct; int slot;
    DI bool tilemode(int, int) const { return false; }
    DI void tile(const float*, int, int, int) const {}
    DI bool colmode(int, int) const { return slot == 1; }
    DI void row4(int row, int col0, f32x4 v) const { if (col0 < 128) *reinterpret_cast<u32x2*>(kc + row * 128 + col0) = pk4(v); }
    DI void col4(int row0, int col, f32x4 v) const {
        if (col < 128) { const int bg = row0 >> 7, c = row0 & 127; *reinterpret_cast<u32x2*>(vct + (bg * 128 + col) * 128 + c) = pk4(v); }
    }
};
struct EpiRes {
    const float* rp; const float* rs; float* dst;
    DI bool tilemode(int, int) const { return false; }
    DI void tile(const float*, int, int, int) const {}
    DI bool colmode(int, int) const { return false; }
    DI void col4(int, int, f32x4) const {}
    DI void row4(int row, int col0, f32x4 v) const {
        const f32x4 r = row < NTP ? *reinterpret_cast<const f32x4*>(rp + row * DM + col0) : *reinterpret_cast<const f32x4*>(rs + (row - NTP) * DM + col0);
        *reinterpret_cast<f32x4*>(dst + row * DM + col0) = v + r;
    }
};
struct EpiStore {
    float* dst; int ld;
    DI bool tilemode(int, int) const { return false; }
    DI void tile(const float*, int, int, int) const {}
    DI bool colmode(int, int) const { return false; }
    DI void col4(int, int, f32x4) const {}
    DI void row4(int row, int col0, f32x4 v) const { *reinterpret_cast<f32x4*>(dst + (long)row * ld + col0) = v; }
};

struct EpiInC {
    u16 *QT, *KA, *KST, *VT, *ZB, *DC; float *PCS; const float* lbl;
    DI bool colmode(int, int) const { return false; }
    DI void col4(int, int, f32x4) const {}
    DI bool tilemode(int brow, int) const { return brow < NTP; }
    DI void row4(int row, int col0, f32x4 v) const {
        const int T = col0 >> 8, cc = col0 & 255;
        *reinterpret_cast<f32x4*>(PCS + (long)(row - NTP) * NC + (cc >> 6) * 2048 + 64 * T + (cc & 63)) = v;
    }
    DI void tile(const float* Cs, int row0, int bcol, int tid) const {
        const int ck = tid >> 6, ch = tid & 63, T = bcol >> 8;
        const int gc = 64 * T + ch, h = T >> 1, kch = gc & 127;
        const int tok0 = row0 + ck * 16, b = tok0 >> 11, chunk = (tok0 & 2047) >> 4, bh = b * 16 + h;
        const float* cs = Cs + (ck * 16) * 256 + ch;
        const float lb = sigmoidf_(lbl[2048 + gc] - lbl[gc]);
        float bc[16], kk[16]; float bs = 0.f;
#pragma unroll
        for (int t = 0; t < 16; ++t) {
            const float fr = cs[t * 256 + 64];
            const float sg = 1.f / (1.f + __expf(-fr)), sn = 1.f / (1.f + __expf(fr));
            bs += __logf(lb + (1.f - lb) * sg);
            bc[t] = bs;
            kk[t] = (1.f - lb) * sn;
        }
        u32 kw[8], vw[8];
#pragma unroll
        for (int t = 0; t < 16; t += 2) {
            float ks[2];
#pragma unroll
            for (int u = 0; u < 2; ++u) {
                const float qv = siluf_(cs[(t + u) * 256]);
                const int fo = ((bh * 128 + chunk) * 4 + ((kch >> 3) & 3)) * 512 + ((kch >> 5) * 16 + t + u) * 8 + (kch & 7);
                QT[fo] = f2bf(qv * __expf(bc[t + u]));
                KA[fo] = f2bf(kk[t + u] * __expf(-bc[t + u]));
                ZB[(tok0 + t + u) * DM + gc] = f2bf(cs[(t + u) * 256 + 192]);
                ks[u] = kk[t + u] * __expf(bs - bc[t + u]);
            }
            kw[t >> 1] = cvt_pk(ks[0], ks[1]);
            vw[t >> 1] = cvt_pk(cs[t * 256 + 128], cs[(t + 1) * 256 + 128]);
        }
        const int o16 = ((bh * 128 + chunk) * 128 + kch) * 16;
        {
            u16* kd = KST + (((bh * 128 + chunk) * 4 + ((kch & 7) >> 1)) * 64 + (kch >> 3)) * 8 + (kch & 1) * 4;
#pragma unroll
            for (int qq = 0; qq < 4; ++qq) { u32x2 w2 = {kw[2 * qq], kw[2 * qq + 1]}; *reinterpret_cast<u32x2*>(kd + qq * 128) = w2; }
        }
        u32x4 a0 = {vw[0], vw[1], vw[2], vw[3]}, a1 = {vw[4], vw[5], vw[6], vw[7]};
        reinterpret_cast<u32x4*>(VT + o16)[0] = a0; reinterpret_cast<u32x4*>(VT + o16)[1] = a1;
        DC[(bh * 128 + chunk) * 128 + kch] = f2bf(__expf(bs));
    }
};

DI int mapA(int n) {
    if (n < 2560) return n;
    if (n < 3584) return n - 2560 + 2584;
    if (n < 4096) return n - 3584 + 3608;
    if (n < 4608) return n - 4096 + 4120;
    if (n < 5632) return n - 4608 + 4632;
    if (n < 6656) return n - 5632 + 5672;
    if (n < 6680) return n - 6656 + 2560;
    if (n < 6696) return n - 6680 + 5656;
    return -1;
}
template <int MODE>
DI void tr_tile(const float* __restrict__ src, int lds_, u16* __restrict__ dst, int ldd, int n0, int k0) {
    float* t = reinterpret_cast<float*>(smem);
    int tid = threadIdx.x; asm volatile("" : "+v"(tid));
    {
        const int nn = tid & 63, n = n0 + nn;
        int sc = n;
        if (MODE == 1) sc = mapA(n);
        if (MODE == 2) sc = n < 128 ? n : -1;
        if (MODE == 3) sc = ((n & 255) >> 6) * 2048 + 64 * (n >> 8) + (n & 63);
        float v[32];
#pragma unroll
        for (int i = 0; i < 32; ++i) v[i] = sc >= 0 ? src[(long)(k0 + i * 8 + (tid >> 6)) * lds_ + sc] : 0.f;
#pragma unroll
        for (int i = 0; i < 32; ++i) t[nn * 257 + i * 8 + (tid >> 6)] = v[i];
    }
    __syncthreads();
#pragma unroll
    for (int j = 0; j < 4; ++j) {
        const int nn = tid >> 3, k8 = (tid & 7) * 8 + j * 64;
        const float* r = t + nn * 257 + k8;
        u32x4 w = {cvt_pk(r[0], r[1]), cvt_pk(r[2], r[3]), cvt_pk(r[4], r[5]), cvt_pk(r[6], r[7])};
        *reinterpret_cast<u32x4*>(dst + (long)(n0 + nn) * ldd + k0 + k8) = w;
    }
    __syncthreads();
}

DI void rmsnorm_rows_bf16(const float* __restrict__ xa, const float* __restrict__ xb, int nsplit, int nrows,
                          const float* __restrict__ w, u16* __restrict__ dst, int rank, int count) {
    const int lane = threadIdx.x & 63, wid = threadIdx.x >> 6;
    for (int row = rank * 8 + wid; row < nrows; row += count * 8) {
        const float4* x = reinterpret_cast<const float4*>(row < nsplit ? xa + (long)row * DM : xb + (long)(row - nsplit) * DM);
        float4 v[8]; float ss = 0.f;
#pragma unroll
        for (int i = 0; i < 8; ++i) { v[i] = x[lane + 64 * i]; ss += v[i].x * v[i].x + v[i].y * v[i].y + v[i].z * v[i].z + v[i].w * v[i].w; }
        ss = wave_sum(ss);
        const float inv = rsqrtf(ss * (1.f / DM) + 1e-6f);
#pragma unroll
        for (int i = 0; i < 8; ++i) {
            const float4 g = reinterpret_cast<const float4*>(w)[lane + 64 * i];
            u32x2 o = {cvt_pk(v[i].x * inv * g.x, v[i].y * inv * g.y), cvt_pk(v[i].z * inv * g.z, v[i].w * inv * g.w)};
            *reinterpret_cast<u32x2*>(dst + (long)row * DM + (lane + 64 * i) * 4) = o;
        }
    }
}

constexpr int TRD1 = 32 * 8, TRD2 = TRD1 + 128 * 8, TRD3 = TRD2 + 32 * 8;
DI void tr_deferred(const Params& p, int t) {
    char* ws = p.ws;
    if (t < TRD1)      { tr_tile<0>(p.a_w_out, DM, (u16*)(ws + WS_WOUTA), DM, (t >> 3) * 64, (t & 7) * 256); }
    else if (t < TRD2) { const int u = t - TRD1; tr_tile<3>(p.c_w_in, NC, (u16*)(ws + WS_WINC), DM, (u >> 3) * 64, (u & 7) * 256); }
    else               { const int u = t - TRD2; tr_tile<0>(p.c_w_out, DM, (u16*)(ws + WS_WOUTC), DM, (u >> 3) * 64, (u & 7) * 256); }
}

DI void phase0(const Params& p) {
    const int tid = threadIdx.x, bid = blockIdx.x, nb = gridDim.x;
    char* ws = p.ws;
    {
        constexpr int T0 = (NAP / 64) * 8, T4 = T0 + 2 * 4 * 16, T5 = T4 + 2 * 4;
        for (int t = bid; t < T5; t += nb) {
            if (t < T0)      { tr_tile<1>(p.a_w_in, NA, (u16*)(ws + WS_WINA), DM, (t >> 3) * 64, (t & 7) * 256); }
            else if (t < T4) { const int u = t - T0, s = u >> 6, v = u & 63;
                               tr_tile<0>(p.a_cmp_w1 + (long)s * 4096 * 256, 256, (u16*)(ws + WS_W1T) + (long)s * 256 * 4096, 4096, (v >> 4) * 64, (v & 15) * 256); }
            else             { const int u = t - T4, s = u >> 2, v = u & 3;
                               tr_tile<2>(p.a_cmp_w2 + (long)s * 256 * 128, 128, (u16*)(ws + WS_W2T) + (long)s * 256 * 256, 256, v * 64, 0); }
        }
    }
    rmsnorm_rows_bf16(p.x_prompt, p.x_sample, NTP, NT, p.a_norm, (u16*)(ws + WS_H), blockIdx.x, gridDim.x);
    for (int it = bid; it < 8; it += nb) {
        const int slot = it >> 2, e4 = (it & 3) * 64 + (tid & 15) * 4, kg = tid >> 4;
        const float* w1 = p.a_cmp_w1 + (long)slot * 4096 * 256 + e4;
        const float* pe = p.a_cmp_pe + slot * 4096;
        f32x4 s = {0.f, 0.f, 0.f, 0.f};
        for (int k0 = kg; k0 < 4096; k0 += 32 * 8) {
            f32x4 wv[8]; float pv[8];
#pragma unroll
            for (int u = 0; u < 8; ++u) { wv[u] = *reinterpret_cast<const f32x4*>(w1 + (long)(k0 + 32 * u) * 256); pv[u] = pe[k0 + 32 * u]; }
#pragma unroll
            for (int u = 0; u < 8; ++u) s += wv[u] * pv[u];
        }
        f32x4* red = reinterpret_cast<f32x4*>(smem);
        red[tid] = s;
        __syncthreads();
        if (tid < 16) {
            f32x4 a = {0.f, 0.f, 0.f, 0.f};
            for (int j = 0; j < 32; ++j) a += red[j * 16 + tid];
            const f32x4 b1 = *reinterpret_cast<const f32x4*>(p.a_cmp_b1 + slot * 256 + e4);
            *reinterpret_cast<f32x4*>(reinterpret_cast<float*>(ws + WS_HCONST) + slot * 256 + e4) = a + b1;
        }
        __syncthreads();
    }
}

template <int KS> DI int lds_byte_ks(int r, int c) {
    int st = (r >> 4) * KS + (c >> 5), ob = (r & 15) * 64 + (c & 31) * 2;
    return st * 1024 + (ob ^ (((ob >> 9) & 1) << 5));
}
DI void cmp_gemm_tile(const Params& p, int slot, int bg) {
    char* ws = p.ws;
    constexpr int TA = 128 * 32 * 4, TB = 512 * 32 * 2, NA = 5, B_OFF = NA * TA;
    int tid = threadIdx.x; asm volatile("" : "+v"(tid));
    const int wid = __builtin_amdgcn_readfirstlane(tid >> 6), lane = tid & 63, wr = wid >> 2, wc = wid & 3, fr = lane & 15, fq = lane >> 4;
    const int b = bg >> 1, g = bg & 1;
    const bool awave = wid < 4;
    const int t4 = tid & 255;
    int aoff[4];
#pragma unroll
    for (int i = 0; i < 4; ++i) {
        const int n = 32 * i + (t4 >> 3), sl = (t4 & 7) ^ (((n & 1) << 1) | ((n >> 1) & 1) | (n & 4));
        aoff[i] = (p.page_table[b * 16 + (n >> 3)] * 128 + 16 * (n & 7)) * 1024 + slot * 256 + g * 128 + sl * 4;
    }
    const u16* Bb = (const u16*)(ws + WS_W1T) + (long)slot * 256 * 4096;
    int boff[8];
#pragma unroll
    for (int i = 0; i < 8; ++i) {
        const int bb = (wid & 3) * 1024 + i * 4096 + lane * 16, st = bb >> 10, sb = bb & 1023, swz = sb ^ (((sb >> 9) & 1) << 5);
        const int R = st * 16 + swz / 64, C = (swz % 64) / 2;
        boff[i] = (R & 255) * 4096 + (R >> 8) * 2048 + C;
    }
    auto issue_a = [&](int kt) {
        char* l = smem + (kt % NA) * TA;
        const int o = (kt >> 2) * 1024 + (kt & 3) * 32;
#pragma unroll
        for (int i = 0; i < 4; ++i) __builtin_amdgcn_global_load_lds((const unsigned*)(p.cache_kv + aoff[i] + o), (unsigned*)(l + (i * 256 + t4) * 16), 16, 0, 0);
    };
    auto issue_b = [&](int kt) {
        char* l = smem + B_OFF + (kt & 1) * TB;
#pragma unroll
        for (int i = 0; i < 8; ++i) __builtin_amdgcn_global_load_lds((const unsigned*)(Bb + boff[i] + kt * 32), (unsigned*)(l + (wid & 3) * 1024 + i * 4096 + lane * 16), 16, 0, 0);
    };
    f32x4 acc[4][8];
#pragma unroll
    for (int m = 0; m < 4; ++m)
#pragma unroll
        for (int n = 0; n < 8; ++n) acc[m][n] = (f32x4){0.f, 0.f, 0.f, 0.f};
    constexpr int nt = 64;
    if (awave) { issue_a(0); issue_a(1); issue_a(2); issue_a(3); } else { issue_b(0); }
    for (int t = 0; t < nt; ++t) {
        if (awave) {
            const int rem = nt - t;
            if (rem >= 4) asm volatile("s_waitcnt vmcnt(12)" ::: "memory");
            else if (rem == 3) asm volatile("s_waitcnt vmcnt(8)" ::: "memory");
            else if (rem == 2) asm volatile("s_waitcnt vmcnt(4)" ::: "memory");
            else asm volatile("s_waitcnt vmcnt(0)" ::: "memory");
        } else {
            asm volatile("s_waitcnt vmcnt(0)" ::: "memory");
        }
        __builtin_amdgcn_s_barrier();
        if (awave) { if (t + 4 < nt) issue_a(t + 4); } else { if (t + 1 < nt) issue_b(t + 1); }
        const char* sA = smem + (t % NA) * TA; const char* sB = smem + B_OFF + (t & 1) * TB;
        bf16x8 At[4];
#pragma unroll
        for (int m = 0; m < 4; ++m) {
            const char* ra = sA + (wr * 64 + m * 16 + fr) * 128;
            const int sg = ((fr & 1) << 1) | ((fr >> 1) & 1) | (fr & 4);
            const f32x4 x0 = *reinterpret_cast<const f32x4*>(ra + (((2 * fq) ^ sg) << 4));
            const f32x4 x1 = *reinterpret_cast<const f32x4*>(ra + (((2 * fq + 1) ^ sg) << 4));
            At[m] = mk8(cvt_pk(x0[0], x0[1]), cvt_pk(x0[2], x0[3]), cvt_pk(x1[0], x1[1]), cvt_pk(x1[2], x1[3]));
        }
#pragma unroll
        for (int nh = 0; nh < 2; ++nh) {
            bf16x8 Bf[4];
#pragma unroll
            for (int n = 0; n < 4; ++n) Bf[n] = *reinterpret_cast<const bf16x8*>(sB + lds_byte_ks<1>(wc * 128 + (nh * 4 + n) * 16 + fr, fq * 8));
#pragma unroll
            for (int m = 0; m < 4; ++m)
#pragma unroll
                for (int n = 0; n < 4; ++n) acc[m][nh * 4 + n] = mfma16(At[m], Bf[n], acc[m][nh * 4 + n]);
        }
    }
    __syncthreads();
    float* Cs = reinterpret_cast<float*>(smem);
    if (wc >= 2) {
#pragma unroll
        for (int m = 0; m < 4; ++m)
#pragma unroll
            for (int n = 0; n < 8; ++n)
#pragma unroll
                for (int j = 0; j < 4; ++j) Cs[(wr * 64 + m * 16 + fq * 4 + j) * 256 + (wc - 2) * 128 + n * 16 + fr] = acc[m][n][j];
    }
    __syncthreads();
    if (wc < 2) {
        const float* hc = reinterpret_cast<const float*>(ws + WS_HCONST) + slot * 256;
        u16* A2 = (u16*)(ws + WS_A2S) + ((long)slot * 32768 + bg * 128) * 256;
#pragma unroll
        for (int n = 0; n < 8; ++n) {
            const int col = wc * 128 + n * 16 + fr;
            const float h0 = hc[col];
#pragma unroll
            for (int m = 0; m < 4; ++m)
#pragma unroll
                for (int j = 0; j < 4; ++j) {
                    const int row = wr * 64 + m * 16 + fq * 4 + j;
                    const float u1 = Cs[min(row + 1, 127) * 256 + col];
                    A2[row * 256 + col] = (row == 127) ? (u16)0 : f2bf(gelu_tanh(acc[m][n][j] + u1 + h0));
                    asm volatile("" ::: "memory");
                }
        }
    }
    asm volatile("s_waitcnt vmcnt(0)" ::: "memory");
    __syncthreads();
}
DI void phase1(const Params& p) {
    char* ws = p.ws;
    const int nb = gridDim.x, bid = blockIdx.x;
    const int n_full = (34 * 27 - 1 - bid) / nb + 1;
    const int n_cmp = bid < 256 ? (256 - 1 - bid) / nb + 1 : 0;
    const int cmp_at = (bid & 1) ? n_full : 0;
    int n_in = 0, n_c = 0;
#if defined(DBG_DUP1A) || defined(DBG_DUP1B) || defined(DBG_DUP1C)
    for (int rep = 0; rep < 2; ++rep) { n_in = 0; n_c = 0;
#endif
    for (int k = 0; k < n_full + n_cmp; ++k) {
        const bool is_cmp = (k >= cmp_at) && (n_c < n_cmp);
#ifdef DBG_DUP1A
        if (rep == 1 && is_cmp) { ++n_c; continue; }
#endif
#if defined(DBG_DUP1B) || defined(DBG_DUP1C)
        if (rep == 1 && !is_cmp) { ++n_in; continue; }
#endif
        if (is_cmp) {
            const int t = bid + n_c * nb, slot = t >> 7, rt = t & 127;
            cmp_gemm_tile(p, slot, 2 * rt);
            cmp_gemm_tile(p, slot, 2 * rt + 1);
            EpiCmp2S e{(float*)(ws + WS_KCS) + (long)slot * 32768 * 128};
            gemm_tile((const u16*)(ws + WS_A2S) + (long)slot * 32768 * 256, 256, (const u16*)(ws + WS_W2T) + (long)slot * 256 * 256, 256, 256, rt * 256, 0, e);
            ++n_c;
        } else {
            const int u = bid + n_in * nb, pm = u % 34, pn = u / 34;
            EpiInA e{(float*)(ws + WS_PROJ), (u16*)(ws + WS_Q), (u16*)(ws + WS_KV6), (u16*)(ws + WS_VT), (u16*)(ws + WS_KF), p.out};
            gemm_tile((const u16*)(ws + WS_H), DM, (const u16*)(ws + WS_WINA), DM, DM, pm * 256, pn * 256, e);
            ++n_in;
        }
    }
#if defined(DBG_DUP1A) || defined(DBG_DUP1B) || defined(DBG_DUP1C)
    }
#endif
    {
        const int rem = (34 * 27) % nb;
        const int sidx = rem == 0 ? bid : bid - rem, scount = rem == 0 ? nb : nb - rem;
        if (sidx >= 0) for (int t = sidx; t < TRD3; t += scount) tr_deferred(p, t);
    }
}

template <int NVT>
DI void rec_prep2(const u16* __restrict__ QT, const u16* __restrict__ KA, const u16* __restrict__ VTc,
                  float* __restrict__ OI, int chunk) {
    const int lane = threadIdx.x & 63, c = lane & 15, q = lane >> 4;
    bf16x8 fa[4], fb[4];
#pragma unroll
    for (int m = 0; m < 4; ++m) { const int o = ((chunk * 4 + q) * 64 + m * 16 + c) * 8; fa[m] = ld8(KA + o); fb[m] = ld8(QT + o); }
    u32x2 w[NVT];
#pragma unroll
    for (int vt = 0; vt < NVT; ++vt) w[vt] = *reinterpret_cast<const u32x2*>(VTc + ((chunk * NVT + vt) * 16 + c) * 16 + 4 * q);
    f32x4 att = {0.f, 0.f, 0.f, 0.f};
#pragma unroll
    for (int m = 0; m < 4; ++m) att = mfma16(fa[m], fb[m], att);
#pragma unroll
    for (int jj = 0; jj < 4; ++jj) if (4 * q + jj > c) att[jj] = 0.f;
    const bf16x8 Pa = mk8(cvt_pk(att[0], att[1]), cvt_pk(att[2], att[3]), 0u, 0u);
#pragma unroll
    for (int vt = 0; vt < NVT; ++vt) {
        const f32x4 zero4 = {0.f, 0.f, 0.f, 0.f};
        const f32x4 o = mfma16(Pa, mk8(w[vt].x, w[vt].y, 0u, 0u), zero4);
        *reinterpret_cast<f32x4*>(OI + ((chunk * NVT + vt) * 64 + lane) * 4) = o;
    }
}

using bf16x4 = __attribute__((ext_vector_type(4))) short;
DI bf16x4 ld4(const u16* p) { return *reinterpret_cast<const bf16x4*>(p); }
DI f32x4 mfma16k16(bf16x4 a, bf16x4 b, f32x4 c) { return __builtin_amdgcn_mfma_f32_16x16x16bf16_1k(a, b, c, 0, 0, 0); }
struct RecOps { bf16x8 Aq[4]; bf16x8 Ak[4]; u32x4 dv[4]; bf16x4 Bu; f32x4 oi; };
template <int NVT>
DI void rec_load(RecOps& R, const u16* __restrict__ QT, const u16* __restrict__ KST, const u16* __restrict__ VTc,
                 const u16* __restrict__ DC, const float* __restrict__ OI, int vt, int ch, int lane) {
    const int c = lane & 15, q = lane >> 4;
    const u16* qt = QT + ch * 2048 + lane * 8;
#pragma unroll
    for (int pp = 0; pp < 4; ++pp) R.Aq[pp] = ld8(qt + pp * 512);
    const u16* ks = KST + ch * 2048 + lane * 8;
#pragma unroll
    for (int r2 = 0; r2 < 4; ++r2) R.Ak[r2] = ld8(ks + r2 * 512);
    const u16* dc = DC + ch * 128 + 32 * q;
#pragma unroll
    for (int i = 0; i < 4; ++i) R.dv[i] = *reinterpret_cast<const u32x4*>(dc + 8 * i);
    R.Bu = ld4(VTc + ((ch * NVT + vt) * 16 + c) * 16 + 4 * q);
    R.oi = *reinterpret_cast<const f32x4*>(OI + ((ch * NVT + vt) * 64 + lane) * 4);
}
DI void rec_step(const RecOps& R, f32x4 (&S)[8], float* __restrict__ Orow, int ldo) {
    f32x4 o = R.oi;
#pragma unroll
    for (int pp = 0; pp < 4; ++pp) {
        const bf16x8 Bs = mk8(cvt_pk(S[0][pp], S[1][pp]), cvt_pk(S[2][pp], S[3][pp]), cvt_pk(S[4][pp], S[5][pp]), cvt_pk(S[6][pp], S[7][pp]));
        o = mfma16(R.Aq[pp], Bs, o);
    }
#pragma unroll
    for (int jj = 0; jj < 4; ++jj) Orow[jj * ldo] = o[jj];
#pragma unroll
    for (int rt = 0; rt < 8; ++rt) {
        f32x4 d;
#pragma unroll
        for (int jj = 0; jj < 4; ++jj) d[jj] = (rt & 1) ? bfhi(R.dv[jj][rt >> 1]) : bflo(R.dv[jj][rt >> 1]);
        const bf16x4 ak = (rt & 1) ? __builtin_shufflevector(R.Ak[rt >> 1], R.Ak[rt >> 1], 4, 5, 6, 7) : __builtin_shufflevector(R.Ak[rt >> 1], R.Ak[rt >> 1], 0, 1, 2, 3);
        S[rt] = mfma16k16(ak, R.Bu, S[rt] * d);
    }
}
template <int NVT>
DI void rec_walker(const u16* __restrict__ QT, const u16* __restrict__ KST, const u16* __restrict__ VTc,
                   const u16* __restrict__ DC, const float* __restrict__ OI, int vt,
                   float* __restrict__ O, int ldo, float* __restrict__ Sout, int DV) {
    int lane = threadIdx.x & 63; asm volatile("" : "+v"(lane));
    const int c = lane & 15, q = lane >> 4;
    f32x4 S[8];
#pragma unroll
    for (int rt = 0; rt < 8; ++rt) S[rt] = (f32x4){0.f, 0.f, 0.f, 0.f};
    float* o0 = O + (4 * q) * ldo + 16 * vt + c;
    RecOps A, B, C;
    rec_load<NVT>(A, QT, KST, VTc, DC, OI, vt, 0, lane);
    rec_load<NVT>(B, QT, KST, VTc, DC, OI, vt, 1, lane);
    rec_load<NVT>(C, QT, KST, VTc, DC, OI, vt, 2, lane);
    for (int ch = 0; ch < 126; ch += 3) {
        __builtin_amdgcn_sched_barrier(0);
        rec_step(A, S, o0 + (ch * 16) * ldo, ldo);
        __builtin_amdgcn_sched_barrier(0);
        rec_load<NVT>(A, QT, KST, VTc, DC, OI, vt, ch + 3, lane);
        __builtin_amdgcn_sched_barrier(0);
        rec_step(B, S, o0 + ((ch + 1) * 16) * ldo, ldo);
        __builtin_amdgcn_sched_barrier(0);
        rec_load<NVT>(B, QT, KST, VTc, DC, OI, vt, ch + 4, lane);
        __builtin_amdgcn_sched_barrier(0);
        rec_step(C, S, o0 + ((ch + 2) * 16) * ldo, ldo);
        __builtin_amdgcn_sched_barrier(0);
        rec_load<NVT>(C, QT, KST, VTc, DC, OI, vt, min(ch + 5, 127), lane);
    }
    __builtin_amdgcn_sched_barrier(0);
    rec_step(A, S, o0 + (126 * 16) * ldo, ldo);
    rec_step(B, S, o0 + (127 * 16) * ldo, ldo);
#pragma unroll
    for (int rt = 0; rt < 8; ++rt)
#pragma unroll
        for (int jj = 0; jj < 4; ++jj) Sout[(32 * q + 8 * jj + rt) * DV + 16 * vt + c] = S[rt][jj];
}

constexpr int RW_SLOTS = 8, RW_PAIR_BYTES = RW_SLOTS * 4096 + 64, RW_OFF = 32768;
DI void rw_wait_gt(volatile LAS int* f, int v) { while (*f <= v) __builtin_amdgcn_s_sleep(1); asm volatile("" ::: "memory"); }
struct RecSt { bf16x8 Ak[4]; u32x4 dv[4]; bf16x4 Bu; };
template <int NVT>
DI void rs_load(RecSt& R, const u16* __restrict__ KST, const u16* __restrict__ VTc, const u16* __restrict__ DC, int vt, int ch, int lane) {
    const int c = lane & 15, q = lane >> 4;
    const u16* ks = KST + ch * 2048 + lane * 8;
#pragma unroll
    for (int r2 = 0; r2 < 4; ++r2) R.Ak[r2] = ld8(ks + r2 * 512);
    const u16* dc = DC + ch * 128 + 32 * q;
#pragma unroll
    for (int i = 0; i < 4; ++i) R.dv[i] = *reinterpret_cast<const u32x4*>(dc + 8 * i);
    R.Bu = ld4(VTc + ((ch * NVT + vt) * 16 + c) * 16 + 4 * q);
}
DI void rs_step(const RecSt& R, f32x4 (&S)[8], char* __restrict__ slot, volatile LAS int* prod, volatile LAS int* cons, int s, int lane) {
    rw_wait_gt(cons, s - RW_SLOTS);
#pragma unroll
    for (int pp = 0; pp < 4; ++pp) {
        const bf16x8 Bs = mk8(cvt_pk(S[0][pp], S[1][pp]), cvt_pk(S[2][pp], S[3][pp]), cvt_pk(S[4][pp], S[5][pp]), cvt_pk(S[6][pp], S[7][pp]));
        *reinterpret_cast<bf16x8*>(slot + pp * 1024 + lane * 16) = Bs;
    }
    asm volatile("" ::: "memory");
    *prod = s + 1;
#pragma unroll
    for (int rt = 0; rt < 8; ++rt) {
        f32x4 d;
#pragma unroll
        for (int jj = 0; jj < 4; ++jj) d[jj] = (rt & 1) ? bfhi(R.dv[jj][rt >> 1]) : bflo(R.dv[jj][rt >> 1]);
        const bf16x4 ak = (rt & 1) ? __builtin_shufflevector(R.Ak[rt >> 1], R.Ak[rt >> 1], 4, 5, 6, 7) : __builtin_shufflevector(R.Ak[rt >> 1], R.Ak[rt >> 1], 0, 1, 2, 3);
        S[rt] = mfma16k16(ak, R.Bu, S[rt] * d);
    }
}
template <int NVT>
DI void rec_state_wave(const u16* __restrict__ KST, const u16* __restrict__ VTc, const u16* __restrict__ DC, int vt,
                       float* __restrict__ Sout, int DV, int ring_off) {
    char* ring = smem + ring_off;
    int lane = threadIdx.x & 63; asm volatile("" : "+v"(lane));
    const int c = lane & 15, q = lane >> 4;
    volatile LAS int* prod = (volatile LAS int*)(ring + RW_SLOTS * 4096);
    volatile LAS int* cons = prod + 1;
    f32x4 S[8];
#pragma unroll
    for (int rt = 0; rt < 8; ++rt) S[rt] = (f32x4){0.f, 0.f, 0.f, 0.f};
    RecSt R[4];
#pragma unroll
    for (int i = 0; i < 4; ++i) rs_load<NVT>(R[i], KST, VTc, DC, vt, i, lane);
    for (int ch = 0; ch < 128; ch += 4) {
#pragma unroll
        for (int i = 0; i < 4; ++i) {
            __builtin_amdgcn_sched_barrier(0);
            rs_step(R[i], S, ring + ((ch + i) & (RW_SLOTS - 1)) * 4096, prod, cons, ch + i, lane);
            __builtin_amdgcn_sched_barrier(0);
            rs_load<NVT>(R[i], KST, VTc, DC, vt, min(ch + i + 4, 127), lane);
        }
    }
#pragma unroll
    for (int rt = 0; rt < 8; ++rt)
#pragma unroll
        for (int jj = 0; jj < 4; ++jj) Sout[(32 * q + 8 * jj + rt) * DV + 16 * vt + c] = S[rt][jj];
}
struct RecOut { bf16x8 Aq[4]; f32x4 oi; };
template <int NVT>
DI void ro_load(RecOut& R, const u16* __restrict__ QT, const float* __restrict__ OI, int vt, int ch, int lane) {
    const u16* qt = QT + ch * 2048 + lane * 8;
#pragma unroll
    for (int pp = 0; pp < 4; ++pp) R.Aq[pp] = ld8(qt + pp * 512);
    R.oi = *reinterpret_cast<const f32x4*>(OI + ((ch * NVT + vt) * 64 + lane) * 4);
}
template <int NVT>
DI void rec_out_wave(const u16* __restrict__ QT, const float* __restrict__ OI, int vt, float* __restrict__ O, int ldo, int ring_off) {
    char* ring = smem + ring_off;
    int lane = threadIdx.x & 63; asm volatile("" : "+v"(lane));
    const int c = lane & 15, q = lane >> 4;
    volatile LAS int* prod = (volatile LAS int*)(ring + RW_SLOTS * 4096);
    volatile LAS int* cons = prod + 1;
    float* o0 = O + (4 * q) * ldo + 16 * vt + c;
    RecOut R[4];
#pragma unroll
    for (int i = 0; i < 4; ++i) ro_load<NVT>(R[i], QT, OI, vt, i, lane);
    for (int ch = 0; ch < 128; ch += 4) {
#pragma unroll
        for (int i = 0; i < 4; ++i) {
            const int s = ch + i;
            __builtin_amdgcn_sched_barrier(0);
            rw_wait_gt(prod, s);
            const char* slot = ring + (s & (RW_SLOTS - 1)) * 4096 + lane * 16;
            bf16x8 Bs[4];
#pragma unroll
            for (int pp = 0; pp < 4; ++pp) Bs[pp] = *reinterpret_cast<const bf16x8*>(slot + pp * 1024);
            f32x4 o = R[i].oi;
#pragma unroll
            for (int pp = 0; pp < 4; ++pp) o = mfma16(R[i].Aq[pp], Bs[pp], o);
            asm volatile("" ::: "memory");
            *cons = s + 1;
            float* orow = o0 + (s * 16) * ldo;
#pragma unroll
            for (int jj = 0; jj < 4; ++jj) orow[jj * ldo] = o[jj];
            __builtin_amdgcn_sched_barrier(0);
            ro_load<NVT>(R[i], QT, OI, vt, min(s + 4, 127), lane);
        }
    }
}

DI void gla_prep(const Params& p, int rank, int count) {
    char* ws = p.ws;
    const float* proj = (const float*)(ws + WS_PROJ);
    u16* QT = (u16*)(ws + WS_GQT); u16* KA = (u16*)(ws + WS_GKA); u16* KST = (u16*)(ws + WS_GKST); u16* VT = (u16*)(ws + WS_GVT);
    u16* DC = (u16*)(ws + WS_GDC);
    const int tid = threadIdx.x;
    for (int base = rank * 4; base < 2048; base += count * 4) {
        const int item = base + (tid >> 7), ch = tid & 127;
        const int b = item >> 9, h = (item >> 7) & 3, chunk = item & 127;
        const long tok0 = (long)b * 2048 + chunk * 16;
        float gw[16];
#pragma unroll
        for (int r = 0; r < 16; ++r) gw[r] = p.a_gla_w2[r * 512 + h * 128 + ch];
        const float gb = p.a_gla_b[h * 128 + ch];
        float bc[16]; float bs = 0.f;
#pragma unroll
        for (int t = 0; t < 16; ++t) {
            const float* lr = proj + (tok0 + t) * NAP + CLR;
            float z = gb;
#pragma unroll
            for (int r = 0; r < 16; ++r) z += lr[r] * gw[r];
            bs += logsigmoidf_(z) * (1.f / 16.f);
            bc[t] = bs;
        }
        u32 kw[8];
#pragma unroll
        for (int t = 0; t < 16; t += 2) {
            float kk[2];
#pragma unroll
            for (int u = 0; u < 2; ++u) {
                const float* pr = proj + (tok0 + t + u) * NAP;
                const float qv = pr[CQB + h * 128 + ch] * QSCALE, kv = pr[CKB + h * 128 + ch];
                const int fo = (((b * 4 + h) * 128 + chunk) * 4 + ((ch >> 3) & 3)) * 512 + ((ch >> 5) * 16 + t + u) * 8 + (ch & 7);
                QT[fo] = f2bf(qv * __expf(bc[t + u]));
                KA[fo] = f2bf(kv * __expf(-bc[t + u]));
                kk[u] = kv * __expf(bs - bc[t + u]);
            }
            kw[t >> 1] = cvt_pk(kk[0], kk[1]);
        }
        {
            u16* kd = KST + ((((long)(b * 4 + h) * 128 + chunk) * 4 + ((ch & 7) >> 1)) * 64 + (ch >> 3)) * 8 + (ch & 1) * 4;
#pragma unroll
            for (int qq = 0; qq < 4; ++qq) { u32x2 w2 = {kw[2 * qq], kw[2 * qq + 1]}; *reinterpret_cast<u32x2*>(kd + qq * 128) = w2; }
        }
        DC[((long)(b * 4 + h) * 128 + chunk) * 128 + ch] = f2bf(__expf(bs));
    }
    for (long i = (long)rank * 512 + tid; i < (long)16 * 128 * 256; i += (long)count * 512) {
        const int v = (int)(i & 255), chunk = (int)((i >> 8) & 127), bh = (int)(i >> 15), b = bh >> 2, h = bh & 3;
        const long tok0 = (long)b * 2048 + chunk * 16;
        u32 w[8];
#pragma unroll
        for (int t = 0; t < 16; t += 2)
            w[t >> 1] = cvt_pk(proj[(tok0 + t) * NAP + CVB + h * 256 + v], proj[(tok0 + t + 1) * NAP + CVB + h * 256 + v]);
        u32x4* d = reinterpret_cast<u32x4*>(VT + i * 16);
        u32x4 a0 = {w[0], w[1], w[2], w[3]}, a1 = {w[4], w[5], w[6], w[7]};
        d[0] = a0; d[1] = a1;
    }
}

DI void hgrn_prep(const Params& p) {
    char* ws = p.ws;
    const float* pc = (const float*)(ws + WS_PROJC);
    u16* QT = (u16*)(ws + WS_HQT); u16* KA = (u16*)(ws + WS_HKA); u16* KST = (u16*)(ws + WS_HKST); u16* VT = (u16*)(ws + WS_HVT);
    float* DC = (float*)(ws + WS_HDC);
    const int tid = threadIdx.x;
    for (int base = blockIdx.x * 4; base < 64 * 128; base += gridDim.x * 4) {
        const int item = base + (tid >> 7), ch = tid & 127;
        const int bh = item >> 7, b = bh >> 4, h = bh & 15, chunk = item & 127;
        const long tok0 = (long)b * 2048 + chunk * 16;
        const int gc = h * 128 + ch;
        const float lb = sigmoidf_(p.c_lb_logits[2048 + gc] - p.c_lb_logits[gc]);
        float bc[16], kk[16]; float bs = 0.f;
#pragma unroll
        for (int t = 0; t < 16; ++t) {
            const float fr = pc[(tok0 + t) * NC + 2048 + gc];
            const float sg = 1.f / (1.f + __expf(-fr)), sn = 1.f / (1.f + __expf(fr));
            bs += __logf(lb + (1.f - lb) * sg);
            bc[t] = bs;
            kk[t] = (1.f - lb) * sn;
        }
        u32 kw[8];
#pragma unroll
        for (int t = 0; t < 16; t += 2) {
            float ks[2];
#pragma unroll
            for (int u = 0; u < 2; ++u) {
                const float qv = siluf_(pc[(tok0 + t + u) * NC + gc]);
                QT[(tok0 + t + u) * DM + gc] = f2bf(qv * __expf(bc[t + u]));
                KA[(tok0 + t + u) * DM + gc] = f2bf(kk[t + u] * __expf(-bc[t + u]));
                ks[u] = kk[t + u] * __expf(bs - bc[t + u]);
            }
            kw[t >> 1] = cvt_pk(ks[0], ks[1]);
        }
        u32x4* kd = reinterpret_cast<u32x4*>(KST + (((long)bh * 128 + chunk) * 128 + ch) * 16);
        u32x4 k0 = {kw[0], kw[1], kw[2], kw[3]}, k1 = {kw[4], kw[5], kw[6], kw[7]};
        kd[0] = k0; kd[1] = k1;
        DC[((long)bh * 128 + chunk) * 128 + ch] = __expf(bs);
        u32 w[8];
#pragma unroll
        for (int t = 0; t < 16; t += 2) w[t >> 1] = cvt_pk(pc[(tok0 + t) * NC + 4096 + gc], pc[(tok0 + t + 1) * NC + 4096 + gc]);
        u32x4* d = reinterpret_cast<u32x4*>(VT + (((long)bh * 128 + chunk) * 128 + ch) * 16);
        u32x4 a0 = {w[0], w[1], w[2], w[3]}, a1 = {w[4], w[5], w[6], w[7]};
        d[0] = a0; d[1] = a1;
    }
}

DI void gla_sample_item(const Params& p, int b, int h) {
    char* ws = p.ws;
    const float* proj = (const float*)(ws + WS_PROJ);
    float* L = reinterpret_cast<float*>(smem);
    float* La = L; float* Lk = L + 512; float* Lq = L + 1024; float* Lv = L + 1536; float* Lp = L + 2560; float* Lr = L + 4608;
    int tid = threadIdx.x; asm volatile("" : "+v"(tid));
    {
        const int t = tid >> 7, ch = tid & 127;
        const float* pr = proj + (long)(NTP + b * 4 + t) * NAP;
        float z = p.a_gla_b[h * 128 + ch];
#pragma unroll
        for (int r = 0; r < 16; ++r) z += pr[CLR + r] * p.a_gla_w2[r * 512 + h * 128 + ch];
        La[tid] = __expf(logsigmoidf_(z) * (1.f / 16.f));
        Lk[tid] = pr[CKB + h * 128 + ch];
        Lq[tid] = pr[CQB + h * 128 + ch] * QSCALE;
        for (int i = tid; i < 1024; i += 512) Lv[i] = proj[(long)(NTP + b * 4 + (i >> 8)) * NAP + CVB + h * 256 + (i & 255)];
    }
    __syncthreads();
    {
        const int v = tid & 255, kh = tid >> 8;
        const float* S0 = p.state_gla + ((long)(b * 4 + h) * 128) * 256;
        float* S1 = p.out + O_GLAS + ((long)(b * 4 + h) * 128) * 256;
        const float v0 = Lv[v], v1 = Lv[256 + v], v2 = Lv[512 + v], v3 = Lv[768 + v];
        float o0 = 0.f, o1 = 0.f, o2 = 0.f, o3 = 0.f;
#pragma unroll 16
        for (int kk = 0; kk < 64; ++kk) {
            const int k = kh * 64 + kk;
            float s = S0[(long)k * 256 + v];
            s = La[k] * s + Lk[k] * v0;             o0 += Lq[k] * s;
            s = La[128 + k] * s + Lk[128 + k] * v1; o1 += Lq[128 + k] * s;
            s = La[256 + k] * s + Lk[256 + k] * v2; o2 += Lq[256 + k] * s;
            s = La[384 + k] * s + Lk[384 + k] * v3; o3 += Lq[384 + k] * s;
            S1[(long)k * 256 + v] = s;
        }
        Lp[(0 * 2 + kh) * 256 + v] = o0; Lp[(1 * 2 + kh) * 256 + v] = o1; Lp[(2 * 2 + kh) * 256 + v] = o2; Lp[(3 * 2 + kh) * 256 + v] = o3;
    }
    __syncthreads();
    {
        const int w = tid >> 6, lane = tid & 63, t = w >> 1, v = (w & 1) * 128 + lane * 2;
        const float a0 = Lp[(t * 2) * 256 + v] + Lp[(t * 2 + 1) * 256 + v], a1 = Lp[(t * 2) * 256 + v + 1] + Lp[(t * 2 + 1) * 256 + v + 1];
        const float ss = wave_sum(a0 * a0 + a1 * a1);
        if (lane == 0) Lr[w] = ss;
        __syncthreads();
        const float inv = rsqrtf((Lr[t * 2] + Lr[t * 2 + 1]) * (1.f / 256.f) + 1e-6f);
        const long tok = NTP + b * 4 + t;
        const float* zb = proj + tok * NAP + CZB + h * 256 + v;
        u16* oa = (u16*)(ws + WS_OA) + tok * DM + 1024 + h * 256 + v;
        *reinterpret_cast<u32*>(oa) = cvt_pk(a0 * inv * p.a_gla_gn[v] * siluf_(zb[0]), a1 * inv * p.a_gla_gn[v + 1] * siluf_(zb[1]));
    }
    __syncthreads();
}

DI void gla_sample_wave(const Params& p, int b, int h, float* __restrict__ Lw) {
    char* ws = p.ws;
    const float* proj = (const float*)(ws + WS_PROJ);
    int lane = threadIdx.x & 63; asm volatile("" : "+v"(lane));
    float* La = Lw; float* Lk = Lw + 512; float* Lq = Lw + 1024;
    const long tok0 = NTP + b * 4;
#pragma unroll
    for (int t = 0; t < 4; ++t) {
        const float* pr = proj + (tok0 + t) * NAP;
#pragma unroll
        for (int u = 0; u < 2; ++u) {
            const int ch = lane + 64 * u;
            float z = p.a_gla_b[h * 128 + ch];
#pragma unroll
            for (int r = 0; r < 16; ++r) z += pr[CLR + r] * p.a_gla_w2[r * 512 + h * 128 + ch];
            La[ch * 4 + t] = __expf(logsigmoidf_(z) * (1.f / 16.f));
            Lk[ch * 4 + t] = pr[CKB + h * 128 + ch];
            Lq[ch * 4 + t] = pr[CQB + h * 128 + ch] * QSCALE;
        }
    }
    f32x4 vv[4], o[4];
#pragma unroll
    for (int t = 0; t < 4; ++t) {
        vv[t] = *reinterpret_cast<const f32x4*>(proj + (tok0 + t) * NAP + CVB + h * 256 + lane * 4);
        o[t] = (f32x4){0.f, 0.f, 0.f, 0.f};
    }
    const float* S0 = p.state_gla + ((long)(b * 4 + h) * 128) * 256 + lane * 4;
    float* S1 = p.out + O_GLAS + ((long)(b * 4 + h) * 128) * 256 + lane * 4;
    for (int k0 = 0; k0 < 128; k0 += 16) {
        f32x4 s[16];
#pragma unroll
        for (int kk = 0; kk < 16; ++kk) s[kk] = *reinterpret_cast<const f32x4*>(S0 + (long)(k0 + kk) * 256);
#pragma unroll
        for (int kk = 0; kk < 16; ++kk) {
            const f32x4 a = *reinterpret_cast<const f32x4*>(La + (k0 + kk) * 4), kx = *reinterpret_cast<const f32x4*>(Lk + (k0 + kk) * 4),
                        qx = *reinterpret_cast<const f32x4*>(Lq + (k0 + kk) * 4);
#pragma unroll
            for (int t = 0; t < 4; ++t) { s[kk] = s[kk] * a[t] + vv[t] * kx[t]; o[t] += s[kk] * qx[t]; }
            *reinterpret_cast<f32x4*>(S1 + (long)(k0 + kk) * 256) = s[kk];
        }
    }
    const f32x4 gn = *reinterpret_cast<const f32x4*>(p.a_gla_gn + lane * 4);
#pragma unroll
    for (int t = 0; t < 4; ++t) {
        const float ss = wave_sum(o[t][0] * o[t][0] + o[t][1] * o[t][1] + o[t][2] * o[t][2] + o[t][3] * o[t][3]);
        const float inv = rsqrtf(ss * (1.f / 256.f) + 1e-6f);
        const f32x4 z = *reinterpret_cast<const f32x4*>(proj + (tok0 + t) * NAP + CZB + h * 256 + lane * 4);
        u32x2 w2 = {cvt_pk(o[t][0] * inv * gn[0] * siluf_(z[0]), o[t][1] * inv * gn[1] * siluf_(z[1])),
                    cvt_pk(o[t][2] * inv * gn[2] * siluf_(z[2]), o[t][3] * inv * gn[3] * siluf_(z[3]))};
        *reinterpret_cast<u32x2*>((u16*)(ws + WS_OA) + (tok0 + t) * DM + 1024 + h * 256 + lane * 4) = w2;
    }
}

DI void hgrn_sample_loop(const Params& p, int it0, int itN, int stride) {
    char* ws = p.ws;
    const float* pc = (const float*)(ws + WS_PCS);
    float* L = reinterpret_cast<float*>(smem);
    float* La = L; float* Lk = L + 512; float* Lq = L + 1024; float* Lv = L + 1536; float* Lp = L + 2048; float* Lr = L + 4096;
    int tid = threadIdx.x; asm volatile("" : "+v"(tid));
    const int t = tid >> 7, ch = tid & 127;
    const int v = tid & 127, kq = tid >> 7;
    const int w = tid >> 6, lane = tid & 63, tn = w >> 1, vn = (w & 1) * 64 + lane;
    float sreg[32], pf = 0.f, pq = 0.f, pv = 0.f, pz = 0.f, l0 = 0.f, l1 = 0.f;
    auto prefetch = [&](int it) {
        const int b = it >> 4, h = it & 15, gc = h * 128 + ch;
        const float* S0 = p.state_hgrn + ((long)it * 128 + kq * 32) * 128 + v;
#pragma unroll
        for (int kk = 0; kk < 32; ++kk) sreg[kk] = S0[kk * 128];
        const float* pr = pc + (long)(b * 4 + t) * NC;
        const float* pr2 = pr + (long)NTS * NC;
        pf = pr[2048 + gc] + pr2[2048 + gc]; pq = pr[gc] + pr2[gc]; pv = pr[4096 + gc] + pr2[4096 + gc];
        l0 = p.c_lb_logits[gc]; l1 = p.c_lb_logits[2048 + gc];
        pz = pc[(long)(b * 4 + tn) * NC + 6144 + h * 128 + vn] + pc[(long)(NTS + b * 4 + tn) * NC + 6144 + h * 128 + vn];
    };
    if (it0 < itN) prefetch(it0);
    for (int it = it0; it < itN; it += stride) {
        const int b = it >> 4, h = it & 15;
        {
            const float lb = sigmoidf_(l1 - l0);
            const float sg = 1.f / (1.f + __expf(-pf)), sn = 1.f / (1.f + __expf(pf));
            La[tid] = lb + (1.f - lb) * sg;
            Lk[tid] = (1.f - lb) * sn;
            Lq[tid] = siluf_(pq);
            Lv[tid] = pv;
        }
        const float zc = pz;
        __syncthreads();
        {
            float* S1 = p.out + O_HGS + ((long)it * 128 + kq * 32) * 128 + v;
            const float v0 = Lv[v], v1 = Lv[128 + v], v2 = Lv[256 + v], v3 = Lv[384 + v];
            float o0 = 0.f, o1 = 0.f, o2 = 0.f, o3 = 0.f;
#pragma unroll
            for (int kk = 0; kk < 32; ++kk) {
                const int k = kq * 32 + kk;
                float s = sreg[kk];
                s = La[k] * s + Lk[k] * v0;             o0 += Lq[k] * s;
                s = La[128 + k] * s + Lk[128 + k] * v1; o1 += Lq[128 + k] * s;
                s = La[256 + k] * s + Lk[256 + k] * v2; o2 += Lq[256 + k] * s;
                s = La[384 + k] * s + Lk[384 + k] * v3; o3 += Lq[384 + k] * s;
                S1[kk * 128] = s;
            }
            Lp[(0 * 4 + kq) * 128 + v] = o0; Lp[(1 * 4 + kq) * 128 + v] = o1; Lp[(2 * 4 + kq) * 128 + v] = o2; Lp[(3 * 4 + kq) * 128 + v] = o3;
        }
        if (it + stride < itN) prefetch(it + stride);
        __syncthreads();
        {
            const float a0 = Lp[(tn * 4) * 128 + vn] + Lp[(tn * 4 + 1) * 128 + vn] + Lp[(tn * 4 + 2) * 128 + vn] + Lp[(tn * 4 + 3) * 128 + vn];
            const float ss = wave_sum(a0 * a0);
            if (lane == 0) Lr[w] = ss;
            __syncthreads();
            const float inv = rsqrtf((Lr[tn * 2] + Lr[tn * 2 + 1]) * (1.f / 128.f) + 1e-6f);
            const long tok = NTP + b * 4 + tn;
            ((u16*)(ws + WS_OA))[tok * DM + h * 128 + vn] = f2bf(a0 * inv * p.c_gn[vn] * siluf_(zc));
        }
        __syncthreads();
    }
}

DI void hgrn_sample_wave(const Params& p, int it, float* __restrict__ Lw) {
    char* ws = p.ws;
    const float* pc = (const float*)(ws + WS_PCS);
    const long H2 = (long)NTS * NC;
    int lane = threadIdx.x & 63; asm volatile("" : "+v"(lane));
    const int b = it >> 4, h = it & 15, kp = lane >> 5, c4 = (lane & 31) * 4;
    float* La = Lw; float* Lk = Lw + 512; float* Lq = Lw + 1024;
#pragma unroll
    for (int u = 0; u < 2; ++u) {
        const int ch = lane + 64 * u, gc = h * 128 + ch;
        const float lb = sigmoidf_(p.c_lb_logits[2048 + gc] - p.c_lb_logits[gc]);
#pragma unroll
        for (int t = 0; t < 4; ++t) {
            const float* pr = pc + (long)(b * 4 + t) * NC;
            const float pf = pr[2048 + gc] + pr[H2 + 2048 + gc], pq = pr[gc] + pr[H2 + gc];
            const float sg = 1.f / (1.f + __expf(-pf)), sn = 1.f / (1.f + __expf(pf));
            La[ch * 4 + t] = lb + (1.f - lb) * sg;
            Lk[ch * 4 + t] = (1.f - lb) * sn;
            Lq[ch * 4 + t] = siluf_(pq);
        }
    }
    f32x4 vv[4], o[4];
#pragma unroll
    for (int t = 0; t < 4; ++t) {
        const float* pr = pc + (long)(b * 4 + t) * NC + 4096 + h * 128 + c4;
        vv[t] = *reinterpret_cast<const f32x4*>(pr) + *reinterpret_cast<const f32x4*>(pr + H2);
        o[t] = (f32x4){0.f, 0.f, 0.f, 0.f};
    }
    const float* S0 = p.state_hgrn + ((long)it * 128 + kp) * 128 + c4;
    float* S1 = p.out + O_HGS + ((long)it * 128 + kp) * 128 + c4;
    for (int i0 = 0; i0 < 64; i0 += 16) {
        f32x4 s[16];
#pragma unroll
        for (int ii = 0; ii < 16; ++ii) s[ii] = *reinterpret_cast<const f32x4*>(S0 + (long)(i0 + ii) * 256);
#pragma unroll
        for (int ii = 0; ii < 16; ++ii) {
            const int k = 2 * (i0 + ii) + kp;
            const f32x4 a = *reinterpret_cast<const f32x4*>(La + k * 4), kx = *reinterpret_cast<const f32x4*>(Lk + k * 4),
                        qx = *reinterpret_cast<const f32x4*>(Lq + k * 4);
#pragma unroll
            for (int t = 0; t < 4; ++t) { s[ii] = s[ii] * a[t] + vv[t] * kx[t]; o[t] += s[ii] * qx[t]; }
            *reinterpret_cast<f32x4*>(S1 + (long)(i0 + ii) * 256) = s[ii];
        }
    }
    const f32x4 gn = *reinterpret_cast<const f32x4*>(p.c_gn + c4);
#pragma unroll
    for (int t = 0; t < 4; ++t) {
#pragma unroll
        for (int j = 0; j < 4; ++j) o[t][j] += __shfl_xor(o[t][j], 32, 64);
        const float ss = 0.5f * wave_sum(o[t][0] * o[t][0] + o[t][1] * o[t][1] + o[t][2] * o[t][2] + o[t][3] * o[t][3]);
        const float inv = rsqrtf(ss * (1.f / 128.f) + 1e-6f);
        const float* zr = pc + (long)(b * 4 + t) * NC + 6144 + h * 128 + c4;
        const f32x4 z = *reinterpret_cast<const f32x4*>(zr) + *reinterpret_cast<const f32x4*>(zr + H2);
        u32x2 w2 = {cvt_pk(o[t][0] * inv * gn[0] * siluf_(z[0]), o[t][1] * inv * gn[1] * siluf_(z[1])),
                    cvt_pk(o[t][2] * inv * gn[2] * siluf_(z[2]), o[t][3] * inv * gn[3] * siluf_(z[3]))};
        if (kp == 0) *reinterpret_cast<u32x2*>((u16*)(ws + WS_OA) + (long)(NTP + b * 4 + t) * DM + h * 128 + c4) = w2;
    }
}

DI void gla_norm_gate(const Params& p, int rank, int count) {
    char* ws = p.ws;
    const float* ob = (const float*)(ws + WS_OB32);
    const float* proj = (const float*)(ws + WS_PROJ);
    u16* oa = (u16*)(ws + WS_OA);
    const int lane = threadIdx.x & 63, wid = threadIdx.x >> 6;
    const f32x4 g = reinterpret_cast<const f32x4*>(p.a_gla_gn)[lane];
    for (int it0 = (rank * 8 + wid) * 4; it0 < NTP * 4; it0 += count * 8 * 4) {
        f32x4 v[4], z[4];
#pragma unroll
        for (int u = 0; u < 4; ++u) {
            const int it = it0 + u; const long tok = it >> 2; const int h = it & 3;
            v[u] = reinterpret_cast<const f32x4*>(ob + tok * 1024 + h * 256)[lane];
            z[u] = reinterpret_cast<const f32x4*>(proj + tok * NAP + CZB + h * 256)[lane];
        }
#pragma unroll
        for (int u = 0; u < 4; ++u) {
            const int it = it0 + u; const long tok = it >> 2; const int h = it & 3;
            const float ss = wave_sum(v[u][0] * v[u][0] + v[u][1] * v[u][1] + v[u][2] * v[u][2] + v[u][3] * v[u][3]);
            const float inv = rsqrtf(ss * (1.f / 256.f) + 1e-6f);
            u32x2 o = {cvt_pk(v[u][0] * inv * g[0] * siluf_(z[u][0]), v[u][1] * inv * g[1] * siluf_(z[u][1])),
                       cvt_pk(v[u][2] * inv * g[2] * siluf_(z[u][2]), v[u][3] * inv * g[3] * siluf_(z[u][3]))};
            *reinterpret_cast<u32x2*>(oa + tok * DM + 1024 + h * 256 + lane * 4) = o;
        }
    }
}
DI void hgrn_norm_gate(const Params& p, int rank, int count) {
    char* ws = p.ws;
    const float* oc = (const float*)(ws + WS_OC32);
    const u16* zb = (const u16*)(ws + WS_ZB);
    u16* oa = (u16*)(ws + WS_OA);
    const int lane = threadIdx.x & 63, wid = threadIdx.x >> 6;
    const float2 g = reinterpret_cast<const float2*>(p.c_gn)[lane];
    for (int it0 = (rank * 8 + wid) * 8; it0 < NTP * 16; it0 += count * 8 * 8) {
        float2 v[8]; u32 zw[8];
#pragma unroll
        for (int u = 0; u < 8; ++u) {
            const int it = it0 + u; const long tok = it >> 4; const int h = it & 15;
            v[u] = reinterpret_cast<const float2*>(oc + tok * DM + h * 128)[lane];
            zw[u] = reinterpret_cast<const u32*>(zb + tok * DM + h * 128)[lane];
        }
#pragma unroll
        for (int u = 0; u < 8; ++u) {
            const int it = it0 + u; const long tok = it >> 4; const int h = it & 15;
            const float ss = wave_sum(v[u].x * v[u].x + v[u].y * v[u].y);
            const float inv = rsqrtf(ss * (1.f / 128.f) + 1e-6f);
            *reinterpret_cast<u32*>(oa + tok * DM + h * 128 + lane * 2) = cvt_pk(v[u].x * inv * g.x * siluf_(bflo(zw[u])), v[u].y * inv * g.y * siluf_(bfhi(zw[u])));
        }
    }
}

struct Acc16 { float m, l; f32x4 O[8]; };

DI f32x4 scores16(const float* __restrict__ kr, const bf16x8 (&Qb)[4], int q) {
    f32x4 s = {0.f, 0.f, 0.f, 0.f};
#pragma unroll
    for (int m = 0; m < 4; ++m) {
        const f32x4 a = *reinterpret_cast<const f32x4*>(kr + 32 * m + 4 * q);
        const f32x4 b = *reinterpret_cast<const f32x4*>(kr + 32 * m + 16 + 4 * q);
        s = mfma16(mk8(cvt_pk(a[0], a[1]), cvt_pk(a[2], a[3]), cvt_pk(b[0], b[1]), cvt_pk(b[2], b[3])), Qb[m], s);
    }
    return s;
}
template <class RV>
DI void pv16(int k0, const RV& rowv, const float (&pv)[8], f32x4 (&O)[8], int c, int q) {
    const bf16x8 P = mk8(cvt_pk(pv[0], pv[1]), cvt_pk(pv[2], pv[3]), cvt_pk(pv[4], pv[5]), cvt_pk(pv[6], pv[7]));
    f32x4 L[8], H[8];
#pragma unroll
    for (int e = 0; e < 8; ++e) {
        const int key = k0 + (e < 4 ? 4 * q + e : 16 + 4 * q + e - 4);
        const float* vr = rowv(key);
        L[e] = *reinterpret_cast<const f32x4*>(vr + 4 * c);
        H[e] = *reinterpret_cast<const f32x4*>(vr + 64 + 4 * c);
    }
#pragma unroll
    for (int dt = 0; dt < 4; ++dt) {
        O[dt] = mfma16(mk8(cvt_pk(L[0][dt], L[1][dt]), cvt_pk(L[2][dt], L[3][dt]), cvt_pk(L[4][dt], L[5][dt]), cvt_pk(L[6][dt], L[7][dt])), P, O[dt]);
        O[4 + dt] = mfma16(mk8(cvt_pk(H[0][dt], H[1][dt]), cvt_pk(H[2][dt], H[3][dt]), cvt_pk(H[4][dt], H[5][dt]), cvt_pk(H[6][dt], H[7][dt])), P, O[4 + dt]);
    }
}
template <class RK, class RV, class MK>
DI void attn16_group(int k0, const RK& rowk, const RV& rowv, const MK& valid, const bf16x8 (&Qb)[4], Acc16& A, int c, int q) {
    const f32x4 s0 = scores16(rowk(k0 + c), Qb, q), s1 = scores16(rowk(k0 + 16 + c), Qb, q);
    float sv[8];
#pragma unroll
    for (int jj = 0; jj < 4; ++jj) {
        sv[jj] = valid(k0 + 4 * q + jj) ? s0[jj] : -INFINITY;
        sv[4 + jj] = valid(k0 + 16 + 4 * q + jj) ? s1[jj] : -INFINITY;
    }
    float mx = sv[0];
#pragma unroll
    for (int i = 1; i < 8; ++i) mx = fmaxf(mx, sv[i]);
    mx = fmaxf(mx, __shfl_xor(mx, 16, 64)); mx = fmaxf(mx, __shfl_xor(mx, 32, 64));
    const float mnew = fmaxf(A.m, mx);
    const float muse = (mnew == -INFINITY) ? 0.f : mnew;
    const float alpha = exp2f_(A.m - muse);
    float pv[8]; float ps = 0.f;
#pragma unroll
    for (int i = 0; i < 8; ++i) { pv[i] = exp2f_(sv[i] - muse); ps += pv[i]; }
    ps += __shfl_xor(ps, 16, 64); ps += __shfl_xor(ps, 32, 64);
    A.l = A.l * alpha + ps; A.m = mnew;
#pragma unroll
    for (int dt = 0; dt < 8; ++dt) A.O[dt] *= alpha;
    pv16(k0, rowv, pv, A.O, c, q);
}

constexpr int AS_WAVE_BYTES = 9216;
constexpr int AS_OW_OFF = 8 * AS_WAVE_BYTES;
constexpr int AS_OW_LD = 132;

DI void attn_sample_item(const Params& p, int b, int g) {
    char* ws = p.ws;
    const float* proj = (const float*)(ws + WS_PROJ);
    int tid = threadIdx.x; asm volatile("" : "+v"(tid));
    const int w = tid >> 6, lane = tid & 63, c = lane & 15, q = lane >> 4;
    const int tokc = c >> 2, r = c & 3;
    float* Pl = reinterpret_cast<float*>(smem + w * AS_WAVE_BYTES);
    float* IMP = Pl + 16 * 128;
    float* Ow = reinterpret_cast<float*>(smem + AS_OW_OFF);
    float* ML = Ow + 8 * 16 * AS_OW_LD;
    bf16x8 Qb[4];
    {
        const u16* qb = (const u16*)(ws + WS_Q) + (long)(NTP + b * 4 + tokc) * 1024 + (g * 4 + r) * 128;
#pragma unroll
        for (int m = 0; m < 4; ++m) {
            const u32x2 w0 = *reinterpret_cast<const u32x2*>(qb + 32 * m + 4 * q), w1 = *reinterpret_cast<const u32x2*>(qb + 32 * m + 16 + 4 * q);
            Qb[m] = mk8(w0.x, w0.y, w1.x, w1.y);
        }
    }
    const int cq = tid >> 5, cd = (tid & 31) * 4;
    f32x4 acc = {0.f, 0.f, 0.f, 0.f};
    float gate[3];
    {
        const float* gp = proj + (long)(NTP + b * 4 + (cq >> 2)) * NAP + CGB + (g * 4 + (cq & 3)) * 3;
        gate[0] = sigmoidf_(gp[0]); gate[1] = sigmoidf_(gp[1]); gate[2] = sigmoidf_(gp[2]);
    }
    auto combine = [&](const Acc16& A, float gt) {
#pragma unroll
        for (int dt = 0; dt < 8; ++dt)
#pragma unroll
            for (int jj = 0; jj < 4; ++jj) Ow[(w * 16 + c) * AS_OW_LD + 4 * (4 * q + jj) + (dt & 3) + 64 * (dt >> 2)] = A.O[dt][jj];
        if (q == 0) { ML[(w * 16 + c) * 2] = A.m; ML[(w * 16 + c) * 2 + 1] = A.l; }
        __syncthreads();
        float M = -INFINITY;
#pragma unroll
        for (int ww = 0; ww < 8; ++ww) M = fmaxf(M, ML[(ww * 16 + cq) * 2]);
        float Lsum = 0.f; f32x4 o = {0.f, 0.f, 0.f, 0.f};
        if (M > -INFINITY) {
#pragma unroll
            for (int ww = 0; ww < 8; ++ww) {
                const float sc = exp2f_(ML[(ww * 16 + cq) * 2] - M);
                Lsum += ML[(ww * 16 + cq) * 2 + 1] * sc;
                o += *reinterpret_cast<const f32x4*>(Ow + (ww * 16 + cq) * AS_OW_LD + cd) * sc;
            }
        }
        if (Lsum > 0.f) acc += o * (gt / Lsum);
        __syncthreads();
    };

    const float* kcs = (const float*)(ws + WS_KCS) + ((long)(b * 2 + g) * 128) * 128;
    const float* vcs = kcs + (long)256 * 128 * 128;
    float pc[4][8];
    {
        float mx = -INFINITY;
#pragma unroll
        for (int gi = 0; gi < 4; ++gi) {
            const f32x4 s0 = scores16(kcs + (long)(32 * gi + c) * 128, Qb, q), s1 = scores16(kcs + (long)(32 * gi + 16 + c) * 128, Qb, q);
#pragma unroll
            for (int jj = 0; jj < 4; ++jj) {
                pc[gi][jj] = s0[jj];
                pc[gi][4 + jj] = (32 * gi + 16 + 4 * q + jj < 127) ? s1[jj] : -INFINITY;
                mx = fmaxf(mx, fmaxf(pc[gi][jj], pc[gi][4 + jj]));
            }
        }
        mx = fmaxf(mx, __shfl_xor(mx, 16, 64)); mx = fmaxf(mx, __shfl_xor(mx, 32, 64));
        float ls = 0.f;
#pragma unroll
        for (int gi = 0; gi < 4; ++gi)
#pragma unroll
            for (int i = 0; i < 8; ++i) { pc[gi][i] = exp2f_(pc[gi][i] - mx); ls += pc[gi][i]; }
        ls += __shfl_xor(ls, 16, 64); ls += __shfl_xor(ls, 32, 64);
        const float il = 1.f / ls;
#pragma unroll
        for (int gi = 0; gi < 4; ++gi)
#pragma unroll
            for (int jj = 0; jj < 4; ++jj) {
                pc[gi][jj] *= il; pc[gi][4 + jj] *= il;
                Pl[c * 128 + 32 * gi + 4 * q + jj] = pc[gi][jj];
                Pl[c * 128 + 32 * gi + 16 + 4 * q + jj] = pc[gi][4 + jj];
            }
    }
    __syncthreads();
#pragma unroll
    for (int n = 0; n < 2; ++n) {
        const int pi = lane + 64 * n, tk = pi >> 5, u = pi & 31;
        float s = 0.f;
#pragma unroll
        for (int rr = 0; rr < 4; ++rr) {
            const float* pr = Pl + (tk * 4 + rr) * 128 + 4 * u;
            s += 2.f * (pr[0] + pr[1] + pr[2]) + pr[3] + (u > 0 ? pr[-1] : 0.f);
        }
        IMP[pi] = s;
    }
    __syncthreads();
    u32 mymask;
    {
        u64 bal[2];
#pragma unroll
        for (int n = 0; n < 2; ++n) {
            const int pi = lane + 64 * n, tk = pi >> 5, u = pi & 31;
            bool sel;
            if (u == 0 || u == 31) sel = true;
            else {
                const float mine = IMP[pi];
                int rank = 0;
                for (int u2 = 1; u2 <= 30; ++u2) { const float o = IMP[tk * 32 + u2]; rank += (o > mine || (o == mine && u2 < u)) ? 1 : 0; }
                sel = rank < 13;
            }
            bal[n] = __ballot(sel);
        }
        mymask = tokc == 0 ? (u32)bal[0] : tokc == 1 ? (u32)(bal[0] >> 32) : tokc == 2 ? (u32)bal[1] : (u32)(bal[1] >> 32);
    }
    const u32 umask = (u32)__builtin_amdgcn_readfirstlane((int)(__shfl(mymask, 0, 64) | __shfl(mymask, 4, 64) | __shfl(mymask, 8, 64) | __shfl(mymask, 12, 64)));
    {
        Acc16 A; A.m = -INFINITY; A.l = 0.f;
#pragma unroll
        for (int dt = 0; dt < 8; ++dt) A.O[dt] = (f32x4){0.f, 0.f, 0.f, 0.f};
        if (w < 4) {
            float pvv[8]; float ps = 0.f;
#pragma unroll
            for (int i = 0; i < 8; ++i) { pvv[i] = w == 0 ? pc[0][i] : w == 1 ? pc[1][i] : w == 2 ? pc[2][i] : pc[3][i]; ps += pvv[i]; }
            ps += __shfl_xor(ps, 16, 64); ps += __shfl_xor(ps, 32, 64);
            A.m = 0.f; A.l = ps;
            pv16(32 * w, [&](int key) { return vcs + (long)key * 128; }, pvv, A.O, c, q);
        }
        combine(A, gate[0]);
    }
    {
        Acc16 A; A.m = -INFINITY; A.l = 0.f;
#pragma unroll
        for (int dt = 0; dt < 8; ++dt) A.O[dt] = (f32x4){0.f, 0.f, 0.f, 0.f};
        const int tpos = PAST + tokc;
        for (int gi = w; gi < 65; gi += 8) {
            const int j = gi >> 1;
            if (j < 32 && !((umask >> j) & 1u)) continue;
            const int k0 = 32 * gi;
            const float* pagep = p.cache_kv + (long)p.page_table[b * 16 + (k0 < PAST ? (k0 >> 7) : 15)] * 128 * 1024 + 512 + g * 128;
            const float* newp = proj + (long)(NTP + b * 4) * NAP + CKV + 512 + g * 128;
            auto rowk = [&](int key) { return key < PAST ? pagep + (long)(key & 127) * 1024 : newp + (long)min(key - PAST, 3) * NAP; };
            auto rowv = [&](int key) { return (key < PAST ? pagep + (long)(key & 127) * 1024 : newp + (long)min(key - PAST, 3) * NAP) + 256; };
            const bool selj = j >= 32 || ((mymask >> j) & 1u);
            auto valid = [&](int key) { return selj && key <= tpos; };
            attn16_group(k0, rowk, rowv, valid, Qb, A, c, q);
        }
        combine(A, gate[1]);
    }
    {
        Acc16 A; A.m = -INFINITY; A.l = 0.f;
#pragma unroll
        for (int dt = 0; dt < 8; ++dt) A.O[dt] = (f32x4){0.f, 0.f, 0.f, 0.f};
        const float* winp = p.cache_win + (long)b * 512 * 512 + g * 128;
        const float* newp = proj + (long)(NTP + b * 4) * NAP + CKV + 1024 + g * 128;
        for (int gi = w; gi < 17; gi += 8) {
            const int k0 = 32 * gi;
            auto rowk = [&](int key) { return key < 512 ? winp + (long)key * 512 : newp + (long)min(key - 512, 3) * NAP; };
            auto rowv = [&](int key) { return (key < 512 ? winp + (long)key * 512 : newp + (long)min(key - 512, 3) * NAP) + 256; };
            auto valid = [&](int key) { return key <= 512 + tokc && key > tokc; };
            attn16_group(k0, rowk, rowv, valid, Qb, A, c, q);
        }
        combine(A, gate[2]);
    }
    {
        const long tok = NTP + b * 4 + (cq >> 2); const int h = g * 4 + (cq & 3);
        const f32x4 z = *reinterpret_cast<const f32x4*>(proj + tok * NAP + CZA + h * 128 + cd);
        u32x2 o = {cvt_pk(acc[0] * siluf_(z[0]), acc[1] * siluf_(z[1])), cvt_pk(acc[2] * siluf_(z[2]), acc[3] * siluf_(z[3]))};
        *reinterpret_cast<u32x2*>((u16*)(ws + WS_OA) + tok * DM + h * 128 + cd) = o;
    }
}

DI f32x16 scores32(const u16* __restrict__ kr, const bf16x8 (&Qb)[8], int hh) {
    f32x16 s;
#pragma unroll
    for (int i = 0; i < 16; ++i) s[i] = 0.f;
#pragma unroll
    for (int ks = 0; ks < 8; ++ks) s = mfma32(ld8(kr + 16 * ks + 8 * hh), Qb[ks], s);
    return s;
}
DI void pv32(const u16* __restrict__ vt, int ldt, const float (&pr)[16], f32x16 (&O)[4], int c, int hh) {
#pragma unroll
    for (int s2 = 0; s2 < 2; ++s2) {
        const bf16x8 B = mk8(cvt_pk(pr[8 * s2 + 0], pr[8 * s2 + 1]), cvt_pk(pr[8 * s2 + 2], pr[8 * s2 + 3]),
                             cvt_pk(pr[8 * s2 + 4], pr[8 * s2 + 5]), cvt_pk(pr[8 * s2 + 6], pr[8 * s2 + 7]));
#pragma unroll
        for (int mt = 0; mt < 4; ++mt) {
            const u16* a = vt + (long)(32 * mt + c) * ldt + 16 * s2 + 4 * hh;
            const u32x2 w0 = *reinterpret_cast<const u32x2*>(a), w1 = *reinterpret_cast<const u32x2*>(a + 8);
            O[mt] = mfma32(mk8(w0.x, w0.y, w1.x, w1.y), B, O[mt]);
        }
    }
}
struct Acc32 { float m, l; f32x16 O[4]; };
DI void acc32_init(Acc32& A) {
    A.m = -INFINITY; A.l = 0.f;
#pragma unroll
    for (int mt = 0; mt < 4; ++mt)
#pragma unroll
        for (int i = 0; i < 16; ++i) A.O[mt][i] = 0.f;
}
DI void load_kf(bf16x8 (&kf)[8], const u16* __restrict__ kt, int koff) {
#pragma unroll
    for (int ks = 0; ks < 8; ++ks) kf[ks] = ld8(kt + koff + 16 * ks);
}
DI void load_vf(u32x2 (&vf)[2][4][2], const u16* __restrict__ vt, int ldt, int voff) {
#pragma unroll
    for (int mt = 0; mt < 4; ++mt) {
        const u16* a = vt + 32 * mt * ldt;
#pragma unroll
        for (int s2 = 0; s2 < 2; ++s2) {
            vf[s2][mt][0] = *reinterpret_cast<const u32x2*>(a + voff + 16 * s2);
            vf[s2][mt][1] = *reinterpret_cast<const u32x2*>(a + voff + 16 * s2 + 8);
        }
    }
}
DI void load_kff(bf16x8 (&kf)[8], const u16* __restrict__ kt, int l8) {
#pragma unroll
    for (int ks = 0; ks < 8; ++ks) kf[ks] = ld8(kt + ks * 512 + l8);
}
DI void load_vff(bf16x8 (&vf)[2][4], const u16* __restrict__ vt, int l8) {
#pragma unroll
    for (int s2 = 0; s2 < 2; ++s2)
#pragma unroll
        for (int mt = 0; mt < 4; ++mt) vf[s2][mt] = ld8(vt + (s2 * 4 + mt) * 512 + l8);
}
DI void pv32ff(const bf16x8 (&vf)[2][4], const float (&pr)[16], f32x16 (&O)[4]) {
#pragma unroll
    for (int s2 = 0; s2 < 2; ++s2) {
        const bf16x8 B = mk8(cvt_pk(pr[8 * s2 + 0], pr[8 * s2 + 1]), cvt_pk(pr[8 * s2 + 2], pr[8 * s2 + 3]),
                             cvt_pk(pr[8 * s2 + 4], pr[8 * s2 + 5]), cvt_pk(pr[8 * s2 + 6], pr[8 * s2 + 7]));
#pragma unroll
        for (int mt = 0; mt < 4; ++mt) O[mt] = mfma32(vf[s2][mt], B, O[mt]);
    }
}
DI void pv32f(const u32x2 (&vf)[2][4][2], const float (&pr)[16], f32x16 (&O)[4]) {
#pragma unroll
    for (int s2 = 0; s2 < 2; ++s2) {
        const bf16x8 B = mk8(cvt_pk(pr[8 * s2 + 0], pr[8 * s2 + 1]), cvt_pk(pr[8 * s2 + 2], pr[8 * s2 + 3]),
                             cvt_pk(pr[8 * s2 + 4], pr[8 * s2 + 5]), cvt_pk(pr[8 * s2 + 6], pr[8 * s2 + 7]));
#pragma unroll
        for (int mt = 0; mt < 4; ++mt) O[mt] = mfma32(mk8(vf[s2][mt][0].x, vf[s2][mt][0].y, vf[s2][mt][1].x, vf[s2][mt][1].y), B, O[mt]);
    }
}
template <class LIM>
DI void attn32_run(u64 tmask, const u16* __restrict__ K, const u16* __restrict__ VT, const bf16x8 (&Qb)[8], Acc32& A, int c, int hh, const LIM& lim) {
    if (tmask == 0) return;
    int T = __builtin_ctzll(tmask); tmask &= tmask - 1;
    bf16x8 kf[8];
    const int l8 = (hh * 32 + c) * 8;
    load_kff(kf, K + T * 4096, l8);
    for (;;) {
        f32x16 s;
#pragma unroll
        for (int i = 0; i < 16; ++i) s[i] = 0.f;
#pragma unroll
        for (int ks = 0; ks < 8; ++ks) s = mfma32(kf[ks], Qb[ks], s);
        __builtin_amdgcn_sched_barrier(0);
        bf16x8 vf[2][4];
        load_vff(vf, VT + T * 4096, l8);
        const bool more = tmask != 0;
        const int Tn = more ? (int)__builtin_ctzll(tmask) : T;
        tmask &= tmask - 1;
        load_kff(kf, K + Tn * 4096, l8);
        int lo, hi; lim(T, lo, hi);
        float sv[16];
        float mx = -INFINITY;
#pragma unroll
        for (int i = 0; i < 16; ++i) {
            const int kc = (i & 3) + 8 * (i >> 2);
            sv[i] = (kc <= hi && kc > lo) ? s[i] : -INFINITY;
            mx = fmaxf(mx, sv[i]);
        }
        mx = fmaxf(mx, __shfl_xor(mx, 32, 64));
        const float mnew = fmaxf(A.m, mx);
        const float muse = (mnew == -INFINITY) ? 0.f : mnew;
        const float alpha = exp2f_(A.m - muse);
        float ps = 0.f;
#pragma unroll
        for (int i = 0; i < 16; ++i) { sv[i] = exp2f_(sv[i] - muse); ps += sv[i]; }
        ps += __shfl_xor(ps, 32, 64);
        A.l = A.l * alpha + ps; A.m = mnew;
#pragma unroll
        for (int mt = 0; mt < 4; ++mt) A.O[mt] *= alpha;
        pv32ff(vf, sv, A.O);
        if (!more) break;
        T = Tn;
    }
}

constexpr int AP_WAVE_BYTES = 17408;
constexpr int AP_UM_OFF = 8 * AP_WAVE_BYTES;
constexpr int AP_ST_LD = 132;
constexpr int AP_ST_BYTES = 32 * AP_ST_LD * 2;
constexpr int AP_RING_OFF = 69632;

template <class LIM, class USE>
DI void attn32_ring(u64 tmask, const u16* __restrict__ K, const u16* __restrict__ VT, int tid, int lane,
                    const bf16x8 (&Qb)[8], Acc32& A, const LIM& lim, const USE& use) {
    if (tmask == 0) return;
    int T0 = __builtin_ctzll(tmask); tmask &= tmask - 1;
    int T1 = -1; if (tmask) { T1 = __builtin_ctzll(tmask); tmask &= tmask - 1; }
    auto issue = [&](int T, int buf) {
        char* l = smem + AP_RING_OFF + buf * 16384 + tid * 16;
        __builtin_amdgcn_global_load_lds((const unsigned*)(K + T * 4096 + tid * 8), (unsigned*)l, 16, 0, 0);
        __builtin_amdgcn_global_load_lds((const unsigned*)(VT + T * 4096 + tid * 8), (unsigned*)(l + 8192), 16, 0, 0);
    };
    issue(T0, 0);
    if (T1 >= 0) issue(T1, 1);
    int buf = 0;
    for (;;) {
        int T2 = -1; if (tmask) { T2 = __builtin_ctzll(tmask); tmask &= tmask - 1; }
        if (T1 >= 0) asm volatile("s_waitcnt vmcnt(2)" ::: "memory"); else asm volatile("s_waitcnt vmcnt(0)" ::: "memory");
        __builtin_amdgcn_s_barrier();
        if (T2 >= 0) issue(T2, buf == 0 ? 2 : buf - 1);
        if (use(T0)) {
            const char* kb = smem + AP_RING_OFF + buf * 16384 + lane * 16;
            f32x16 s;
#pragma unroll
            for (int i = 0; i < 16; ++i) s[i] = 0.f;
#pragma unroll
            for (int ks = 0; ks < 8; ++ks) s = mfma32(*reinterpret_cast<const bf16x8*>(kb + ks * 1024), Qb[ks], s);
            int lo, hi; lim(T0, lo, hi);
            float sv[16];
            float mx = -INFINITY;
#pragma unroll
            for (int i = 0; i < 16; ++i) {
                const int kc = (i & 3) + 8 * (i >> 2);
                sv[i] = (kc <= hi && kc > lo) ? s[i] : -INFINITY;
                mx = fmaxf(mx, sv[i]);
            }
            mx = fmaxf(mx, __shfl_xor(mx, 32, 64));
            if (__any(mx > A.m)) {
                const float mnew = fmaxf(A.m, mx);
                const float alpha = exp2f_(A.m - ((mnew == -INFINITY) ? 0.f : mnew));
                A.l *= alpha; A.m = mnew;
#pragma unroll
                for (int mt = 0; mt < 4; ++mt) A.O[mt] *= alpha;
            }
            const float muse = (A.m == -INFINITY) ? 0.f : A.m;
            float ps = 0.f;
#pragma unroll
            for (int i = 0; i < 16; ++i) { sv[i] = exp2f_(sv[i] - muse); ps += sv[i]; }
            ps += __shfl_xor(ps, 32, 64);
            A.l += ps;
#pragma unroll
            for (int s2 = 0; s2 < 2; ++s2) {
                const bf16x8 B = mk8(cvt_pk(sv[8 * s2 + 0], sv[8 * s2 + 1]), cvt_pk(sv[8 * s2 + 2], sv[8 * s2 + 3]),
                                     cvt_pk(sv[8 * s2 + 4], sv[8 * s2 + 5]), cvt_pk(sv[8 * s2 + 6], sv[8 * s2 + 7]));
#pragma unroll
                for (int mt = 0; mt < 4; ++mt) A.O[mt] = mfma32(*reinterpret_cast<const bf16x8*>(kb + 8192 + (s2 * 4 + mt) * 1024), B, A.O[mt]);
            }
        }
        if (T1 < 0) break;
        T0 = T1; T1 = T2; buf = buf == 2 ? 0 : buf + 1;
    }
    __builtin_amdgcn_s_barrier();
}

DI void attn_prompt_item(const Params& p, int b, int g, int X) {
    char* ws = p.ws;
    const float* proj = (const float*)(ws + WS_PROJ);
    int tid = threadIdx.x; asm volatile("" : "+v"(tid));
    const int w = __builtin_amdgcn_readfirstlane(tid >> 6), lane = tid & 63, c = lane & 31, hh = lane >> 5;
    const int ti = c >> 2, r = c & 3;
    const int t0w = 64 * X + 8 * w;
    const int tpos = t0w + ti;
    const long tok = (long)b * 2048 + tpos;
    const int h = g * 4 + r;
    float* OS = reinterpret_cast<float*>(smem + w * AP_WAVE_BYTES);
    float* IMP = OS + 128 * 32;
    int osl = 128 * hh + c;
    asm volatile("" : "+v"(osl));
    bf16x8 Qb[8];
    {
        const u16* qb = (const u16*)(ws + WS_Q) + tok * 1024 + h * 128;
#pragma unroll
        for (int ks = 0; ks < 8; ++ks) Qb[ks] = ld8(qb + 16 * ks + 8 * hh);
    }
    float gate[3];
    {
        const float* gp = proj + tok * NAP + CGB + h * 3;
        gate[0] = sigmoidf_(gp[0]); gate[1] = sigmoidf_(gp[1]); gate[2] = sigmoidf_(gp[2]);
    }
    const int bg = b * 2 + g;
    const int cur = X;
    u32 mymask, umask, bmask;
    u16* ST = reinterpret_cast<u16*>(smem + w * AP_ST_BYTES) + c * AP_ST_LD + 4 * hh;
    {
        const u16* kc = (const u16*)(ws + WS_KCP) + (long)bg * 128 * 128;
        const u16* vct = (const u16*)(ws + WS_VCTP) + (long)bg * 128 * 128;
        float pc[4][16];
        float mx = -INFINITY;
        const int lim2 = min((tpos - 31) >> 4, 126) - 4 * hh;
        bf16x8 kf[8];
        load_kf(kf, kc, c * 128 + 8 * hh);
#pragma unroll
        for (int tl = 0; tl < 4; ++tl) {
            f32x16 s;
#pragma unroll
            for (int i = 0; i < 16; ++i) s[i] = 0.f;
#pragma unroll
            for (int ks = 0; ks < 8; ++ks) s = mfma32(kf[ks], Qb[ks], s);
            if (tl < 3) load_kf(kf, kc + 32 * (tl + 1) * 128, c * 128 + 8 * hh);
#pragma unroll
            for (int i = 0; i < 16; ++i) {
                pc[tl][i] = (32 * tl + (i & 3) + 8 * (i >> 2) <= lim2) ? s[i] : -INFINITY;
                mx = fmaxf(mx, pc[tl][i]);
            }
        }
        mx = fmaxf(mx, __shfl_xor(mx, 32, 64));
        const float muse = (mx == -INFINITY) ? 0.f : mx;
        float ls = 0.f;
#pragma unroll
        for (int tl = 0; tl < 4; ++tl)
#pragma unroll
            for (int i = 0; i < 16; ++i) { pc[tl][i] = exp2f_(pc[tl][i] - muse); ls += pc[tl][i]; }
        ls += __shfl_xor(ls, 32, 64);
        const float il = ls > 0.f ? 1.f / ls : 0.f;
#pragma unroll
        for (int tl = 0; tl < 4; ++tl)
#pragma unroll
            for (int i = 0; i < 16; ++i) {
                pc[tl][i] *= il;
                OS[osl + ((32 * tl + (i & 3) + 8 * (i >> 2))) * 32] = pc[tl][i];
            }
        __syncthreads();
#pragma unroll
        for (int n = 0; n < 4; ++n) {
            const int pi = lane + 64 * n, tk = pi >> 5, u = pi & 31;
            float s = 0.f;
#pragma unroll
            for (int rr = 0; rr < 4; ++rr) {
                const float* pr = OS + (4 * u) * 32 + tk * 4 + rr;
                s += 2.f * (pr[0] + pr[32] + pr[64]) + pr[96] + (u > 0 ? pr[-32] : 0.f);
            }
            IMP[pi] = s;
        }
        __syncthreads();
        u64 bal[4];
#pragma unroll
        for (int n = 0; n < 4; ++n) {
            const int pi = lane + 64 * n, tk = pi >> 5, u = pi & 31;
            bool sel;
            const bool forced = (u == 0) || (u == cur) || (u == cur - 1);
            if (u > cur) sel = false;
            else if (forced) sel = true;
            else {
                const int nf = cur == 0 ? 1 : cur == 1 ? 2 : 3;
                const float mine = IMP[pi];
                int rank = 0;
                for (int u2 = 1; u2 < cur - 1; ++u2) { const float o = IMP[tk * 32 + u2]; rank += (o > mine || (o == mine && u2 < u)) ? 1 : 0; }
                sel = rank < 16 - nf;
            }
            bal[n] = __ballot(sel);
        }
        const u64 bsel = ti < 2 ? bal[0] : ti < 4 ? bal[1] : ti < 6 ? bal[2] : bal[3];
        mymask = (ti & 1) ? (u32)(bsel >> 32) : (u32)bsel;
        umask = (u32)(bal[0] | (bal[0] >> 32) | bal[1] | (bal[1] >> 32) | bal[2] | (bal[2] >> 32) | bal[3] | (bal[3] >> 32));
        if (lane == 0) reinterpret_cast<u32*>(smem + AP_UM_OFF)[w] = umask;
        f32x16 O[4];
#pragma unroll
        for (int mt = 0; mt < 4; ++mt)
#pragma unroll
            for (int i = 0; i < 16; ++i) O[mt][i] = 0.f;
#pragma unroll
        for (int tl = 0; tl < 4; ++tl) {
            u32x2 vf[2][4][2]; load_vf(vf, vct + 32 * tl, 128, c * 128 + 4 * hh);
            float pr[16];
#pragma unroll
            for (int i = 0; i < 16; ++i) pr[i] = OS[osl + ((32 * tl + (i & 3) + 8 * (i >> 2))) * 32];
            pv32f(vf, pr, O);
            __builtin_amdgcn_sched_barrier(0);
        }
        __syncthreads();
        {
            const u32* um = reinterpret_cast<const u32*>(smem + AP_UM_OFF);
            bmask = um[0] | um[1] | um[2] | um[3] | um[4] | um[5] | um[6] | um[7];
            bmask = (u32)__builtin_amdgcn_readfirstlane((int)bmask);
        }
#pragma unroll
        for (int mt = 0; mt < 4; ++mt)
#pragma unroll
            for (int rr = 0; rr < 4; ++rr) {
                u32x2 wv = {cvt_pk(gate[0] * O[mt][4 * rr], gate[0] * O[mt][4 * rr + 1]), cvt_pk(gate[0] * O[mt][4 * rr + 2], gate[0] * O[mt][4 * rr + 3])};
                *reinterpret_cast<u32x2*>(ST + 32 * mt + 8 * rr) = wv;
            }
    }
    const int tp4 = tpos - 4 * hh;
    {
        Acc32 A; acc32_init(A);
        const u16* K = (const u16*)(ws + WS_KF) + ((long)(0 * 4 + b) * 2 + g) * 64 * 4096;
        const u16* VT = (const u16*)(ws + WS_VT) + ((long)(0 * 4 + b) * 2 + g) * 64 * 4096;
        u64 tm = 0;
        for (int j = 0; j <= cur; ++j) if ((bmask >> j) & 1u) tm |= 3ull << (2 * j);
        attn32_ring(tm, K, VT, tid, lane, Qb, A,
                    [&](int T, int& lo, int& hi) { lo = -(1 << 30); hi = ((mymask >> (T >> 1)) & 1u) ? tp4 - 32 * T : -1; },
                    [&](int T) { return ((umask >> (T >> 1)) & 1u) && 32 * T <= t0w + 7; });
#ifdef DBG_DUPSEL
        {
            Acc32 A2; acc32_init(A2);
            attn32_ring(tm, K, VT, tid, lane, Qb, A2,
                        [&](int T, int& lo, int& hi) { lo = -(1 << 30); hi = ((mymask >> (T >> 1)) & 1u) ? tp4 - 32 * T : -1; },
                        [&](int T) { return ((umask >> (T >> 1)) & 1u) && 32 * T <= t0w + 7; });
            asm volatile("" :: "v"(A2.l), "v"(A2.O[0][0]), "v"(A2.O[1][0]), "v"(A2.O[2][0]), "v"(A2.O[3][0]));
        }
#endif
        const float cf = A.l > 0.f ? gate[1] / A.l : 0.f;
#pragma unroll
        for (int mt = 0; mt < 4; ++mt)
#pragma unroll
            for (int rr = 0; rr < 4; ++rr) {
                const u32x2 o = *reinterpret_cast<const u32x2*>(ST + 32 * mt + 8 * rr);
                u32x2 wv = {cvt_pk(bflo(o.x) + cf * A.O[mt][4 * rr], bfhi(o.x) + cf * A.O[mt][4 * rr + 1]),
                            cvt_pk(bflo(o.y) + cf * A.O[mt][4 * rr + 2], bfhi(o.y) + cf * A.O[mt][4 * rr + 3])};
                *reinterpret_cast<u32x2*>(ST + 32 * mt + 8 * rr) = wv;
            }
    }
    {
        Acc32 A; acc32_init(A);
        const u16* K = (const u16*)(ws + WS_KF) + ((long)(1 * 4 + b) * 2 + g) * 64 * 4096;
        const u16* VT = (const u16*)(ws + WS_VT) + ((long)(1 * 4 + b) * 2 + g) * 64 * 4096;
        const int Tlo = max(0, 64 * X - 511) >> 5, Tmax = 2 * X + 1;
        const u64 tm = ((2ull << Tmax) - 1ull) & ~((1ull << Tlo) - 1ull);
        attn32_ring(tm, K, VT, tid, lane, Qb, A,
                    [&](int T, int& lo, int& hi) { hi = tp4 - 32 * T; lo = hi - 512; },
                    [&](int T) { return 32 * T <= t0w + 7 && 32 * T + 31 > t0w - 512; });
        const float cf = A.l > 0.f ? gate[2] / A.l : 0.f;
        int h4 = 4 * hh; asm volatile("" : "+v"(h4));
        u16* oa = (u16*)(ws + WS_OA) + tok * DM + h * 128 + h4;
        const float* za = proj + tok * NAP + CZA + h * 128 + h4;
#pragma unroll
        for (int mt = 0; mt < 4; ++mt)
#pragma unroll
            for (int rr = 0; rr < 4; ++rr) {
                const int d0 = 32 * mt + 8 * rr;
                const f32x4 z = *reinterpret_cast<const f32x4*>(za + d0);
                const u32x2 o = *reinterpret_cast<const u32x2*>(ST + d0);
                u32x2 wv = {cvt_pk((bflo(o.x) + cf * A.O[mt][4 * rr]) * siluf_(z[0]), (bfhi(o.x) + cf * A.O[mt][4 * rr + 1]) * siluf_(z[1])),
                            cvt_pk((bflo(o.y) + cf * A.O[mt][4 * rr + 2]) * siluf_(z[2]), (bfhi(o.y) + cf * A.O[mt][4 * rr + 3]) * siluf_(z[3]))};
                *reinterpret_cast<u32x2*>(oa + d0) = wv;
                asm volatile("" ::: "memory");
            }
    }
    __syncthreads();
}

DI int gemm_tile_id(int i) {
    const int nb = gridDim.x, nx = nb >> 5;
    if ((nb & 31) != 0) return blockIdx.x + i * nb;
    return ((i * nx + (int)(blockIdx.x % nx)) << 5) + (int)(blockIdx.x / nx);
}
DI void gemm_tile_pos(int u, int ncol, int& pm, int& pn) {
    const int P = u / (2 * ncol), rem = u - P * 2 * ncol;
    pn = rem >> 1; pm = 2 * P + (rem & 1);
}
DI void phase2(const Params& p) {
    char* ws = p.ws;
    const int nb = gridDim.x, bid = blockIdx.x;
    const bool split = nb >= 32;
    if (!split || bid < 16) {
        for (int u = bid; u < 16; u += nb) {
            const int half = u >> 3, slot = (u >> 2) & 1, rt = u & 3;
            EpiStore e{(float*)(ws + WS_CPP) + (long)(half * 2 + slot) * 1024 * 256, 256};
            gemm_tile((const u16*)(ws + WS_KV6) + (long)slot * 1024 * 2048 + half * 2048, 2048,
                      (const u16*)(ws + WS_W1T) + (long)slot * 256 * 4096 + half * 2048, 4096, 2048, rt * 256, 0, e);
        }
    }
    if (!split || bid >= 16) {
        const int rank = split ? bid - 16 : bid, count = split ? nb - 16 : nb;
        gla_prep(p, rank, count);
    }
}
DI int first_item(int start) { const int nb = gridDim.x; return start + (int)((blockIdx.x + nb - start % nb) % nb); }
DI void phase3(const Params& p) {
    char* ws = p.ws;
    for (int it = first_item(0); it < 256; it += gridDim.x) {
        const int bh = it >> 4, b = bh >> 2, h = bh & 3, chunk = (it & 15) * 8 + (threadIdx.x >> 6);
        rec_prep2<16>((const u16*)(ws + WS_GQT) + (long)bh * 262144, (const u16*)(ws + WS_GKA) + (long)bh * 262144,
                      (const u16*)(ws + WS_GVT) + (long)bh * 128 * 256 * 16, (float*)(ws + WS_GOI) + (long)bh * 128 * 16 * 256, chunk);
    }
    for (int it = first_item(256); it < 512; it += gridDim.x) { const int u = it - 256; attn_sample_item(p, u >> 1, u & 1); }
    {
        const float* cp = (const float*)(ws + WS_CPP);
        const float* hc = (const float*)(ws + WS_HCONST);
        u16* a2 = (u16*)(ws + WS_A2P);
        for (int i = blockIdx.x * 512 + threadIdx.x; i < 2 * 1024 * 64; i += gridDim.x * 512) {
            const int slot = i >> 16, row = (i >> 6) & 1023, c4 = (i & 63) * 4;
            const f32x4 a = *reinterpret_cast<const f32x4*>(cp + ((long)slot * 1024 + row) * 256 + c4);
            const f32x4 b2 = *reinterpret_cast<const f32x4*>(cp + ((long)(2 + slot) * 1024 + row) * 256 + c4);
            const f32x4 h0 = *reinterpret_cast<const f32x4*>(hc + slot * 256 + c4);
            f32x4 o;
#pragma unroll
            for (int j = 0; j < 4; ++j) o[j] = ((row & 127) == 127) ? 0.f : gelu_tanh(a[j] + b2[j] + h0[j]);
            *reinterpret_cast<u32x2*>(a2 + ((long)slot * 1024 + row) * 256 + c4) = pk4(o);
        }
    }
}
DI void phase4(const Params& p) {
    char* ws = p.ws;
    const int w = __builtin_amdgcn_readfirstlane((int)(threadIdx.x >> 6));
    const bool pair = gridDim.x == 256;
    if (threadIdx.x < 2) reinterpret_cast<int*>(smem + RW_OFF + RW_SLOTS * 4096)[threadIdx.x] = 0;
    __syncthreads();
    if (w == 0 || (pair && w == 3)) {
        for (int t0 = blockIdx.x; t0 < 256; t0 += gridDim.x) {
            const int t = (gridDim.x == 256) ? (((t0 & 7) * 2 + (t0 >> 7)) << 4) + ((t0 >> 3) & 15) : t0;
            const int bh = t >> 4, b = bh >> 2, h = bh & 3, vt = t & 15;
            if (!pair)
                rec_walker<16>((const u16*)(ws + WS_GQT) + (long)bh * 262144, (const u16*)(ws + WS_GKST) + (long)bh * 128 * 2048,
                               (const u16*)(ws + WS_GVT) + (long)bh * 128 * 256 * 16, (const u16*)(ws + WS_GDC) + (long)bh * 128 * 128,
                               (const float*)(ws + WS_GOI) + (long)bh * 128 * 16 * 256, vt,
                               (float*)(ws + WS_OB32) + (long)b * 2048 * 1024 + h * 256, 1024, p.out + O_GLAP + (long)bh * 128 * 256, 256);
            else if (w == 0)
                rec_state_wave<16>((const u16*)(ws + WS_GKST) + (long)bh * 128 * 2048, (const u16*)(ws + WS_GVT) + (long)bh * 128 * 256 * 16,
                                   (const u16*)(ws + WS_GDC) + (long)bh * 128 * 128, vt, p.out + O_GLAP + (long)bh * 128 * 256, 256, RW_OFF);
            else
                rec_out_wave<16>((const u16*)(ws + WS_GQT) + (long)bh * 262144, (const float*)(ws + WS_GOI) + (long)bh * 128 * 16 * 256, vt,
                                 (float*)(ws + WS_OB32) + (long)b * 2048 * 1024 + h * 256, 1024, RW_OFF);
        }
    } else {
        if (!(pair && w >= 3))
            for (int it = blockIdx.x + gridDim.x * (w - 1); it < 512; it += gridDim.x * 7)
                gla_sample_wave(p, it >> 2, it & 3, reinterpret_cast<float*>(smem + w * 8192));
    }
    __syncthreads();
    for (int it = first_item(0); it < 8; it += gridDim.x) {
        const int slot = it >> 2, rt = it & 3;
        EpiCmp2P e{(u16*)(ws + WS_KCP), (u16*)(ws + WS_VCTP), slot};
        gemm_tile((const u16*)(ws + WS_A2P) + (long)slot * 1024 * 256, 256, (const u16*)(ws + WS_W2T) + (long)slot * 256 * 256, 256, 256, rt * 256, 0, e);
    }
}
DI void final_norm_rows(const Params& p, int r0, int r1, int parts) {
    const float* x2 = (const float*)(p.ws + (parts > 0 ? WS_X1 : WS_X2));
    const float* pp = (const float*)(p.ws + WS_PROJC);
    const int lane = threadIdx.x & 63, wid = threadIdx.x >> 6;
    for (int row = r0 + blockIdx.x * 8 + wid; row < r1; row += gridDim.x * 8) {
        const float4* x = reinterpret_cast<const float4*>(x2 + (long)row * DM);
        float4* y = reinterpret_cast<float4*>(row < NTP ? p.out + O_YP + (long)row * DM : p.out + O_YS + (long)(row - NTP) * DM);
        float4 v[8]; float ss = 0.f;
#pragma unroll
        for (int i = 0; i < 8; ++i) v[i] = x[lane + 64 * i];
        for (int q4 = 0; q4 < parts; ++q4) {
            const float4* xp = reinterpret_cast<const float4*>(pp + ((long)q4 * NTS + (row - NTP)) * DM);
#pragma unroll
            for (int i = 0; i < 8; ++i) { const float4 a = xp[lane + 64 * i]; v[i].x += a.x; v[i].y += a.y; v[i].z += a.z; v[i].w += a.w; }
        }
#pragma unroll
        for (int i = 0; i < 8; ++i) ss += v[i].x * v[i].x + v[i].y * v[i].y + v[i].z * v[i].z + v[i].w * v[i].w;
        ss = wave_sum(ss);
        const float inv = rsqrtf(ss * (1.f / DM) + 1e-6f);
#pragma unroll
        for (int i = 0; i < 8; ++i) {
            const float4 g = reinterpret_cast<const float4*>(p.final_norm)[lane + 64 * i];
            y[lane + 64 * i] = make_float4(v[i].x * inv * g.x, v[i].y * inv * g.y, v[i].z * inv * g.z, v[i].w * inv * g.w);
        }
    }
}
DI void win_copy_range(const Params& p, int i0, int i1) {
    const int n = 128 * 508 * 128;
    const f32x4* src = reinterpret_cast<const f32x4*>(p.cache_win);
    f32x4* dst = reinterpret_cast<f32x4*>(p.out + O_WINS);
    i1 = min(i1, n);
    for (int ib = i0 + (int)threadIdx.x; ib < i1; ib += 16 * 512) {
        f32x4 v[16];
#pragma unroll
        for (int u = 0; u < 16; ++u) { const int i = min(ib + u * 512, i1 - 1); const int b = i / (508 * 128), r = i - b * (508 * 128); v[u] = src[b * 512 * 128 + 4 * 128 + r]; }
#pragma unroll
        for (int u = 0; u < 16; ++u) { const int i = min(ib + u * 512, i1 - 1); const int b = i / (508 * 128), r = i - b * (508 * 128); dst[b * 512 * 128 + r] = v[u]; }
    }
}
DI int win_w(int x) { return x < 14 ? (int)((0x23345567788867ull >> (4 * x)) & 15) : 0; }
DI int win_wsum(int x) { int s = 0; for (int i = 0; i < x; ++i) s += win_w(i); return s; }
constexpr int WIN_U5 = 79, WIN_UT = 90;
DI void phase5(const Params& p) {
    char* ws = p.ws;
    for (int it = blockIdx.x; it < 256; it += gridDim.x) attn_prompt_item(p, it >> 6, (it >> 5) & 1, it & 31);
    for (int it = blockIdx.x; it < 256; it += gridDim.x) {
        const int x = it & 31;
        if (x >= 2) continue;
        const int j = (it >> 5) * 2 + x;
        EpiRes e{p.x_prompt, p.x_sample, (float*)(ws + WS_X1)};
        gemm_tile((const u16*)(ws + WS_OA), DM, (const u16*)(ws + WS_WOUTA), DM, DM, (32 + (j >> 3)) * 256, (j & 7) * 256, e);
    }
    if (gridDim.x == 256) {
        const int x = blockIdx.x & 31;
        if (x >= 2 && x < 16) gla_norm_gate(p, (blockIdx.x >> 5) * 14 + (x - 2), 112);
        if (win_w(x) > 0) {
            const long n = 128 * 508 * 128, units = 8 * WIN_UT;
            const long u0 = (blockIdx.x >> 5) * WIN_U5 + win_wsum(x), u1 = u0 + win_w(x);
            win_copy_range(p, (int)(n * u0 / units), (int)(n * u1 / units));
        }
    } else {
        gla_norm_gate(p, blockIdx.x, gridDim.x);
    }
}
DI void phase6(const Params& p) {
    char* ws = p.ws;
    for (int t = blockIdx.x; t < 32 * 8; t += gridDim.x) {
        EpiRes e{p.x_prompt, p.x_sample, (float*)(ws + WS_X1)};
        gemm_tile((const u16*)(ws + WS_OA), DM, (const u16*)(ws + WS_WOUTA), DM, DM, (t & 31) * 256, (t >> 5) * 256, e);
    }
    rmsnorm_rows_bf16((const float*)(ws + WS_X1) + (long)NTP * DM, (const float*)(ws + WS_X1) + (long)NTP * DM, NTS, NTS, p.c_norm, (u16*)(ws + WS_H) + (long)NTP * DM, blockIdx.x, gridDim.x);
}
DI EpiInC make_epi_c(const Params& p) {
    char* ws = p.ws;
    return EpiInC{(u16*)(ws + WS_HQT), (u16*)(ws + WS_HKA), (u16*)(ws + WS_HKST), (u16*)(ws + WS_HVT), (u16*)(ws + WS_ZB),
                  (u16*)(ws + WS_HDC), (float*)(ws + WS_PCS), p.c_lb_logits};
}
DI void phase7(const Params& p) {
    char* ws = p.ws;
    for (int t = blockIdx.x; t < 128; t += gridDim.x) {
        const int half = t >> 6, tile = t & 63;
        EpiInC e = make_epi_c(p);
        e.PCS += (long)half * NTS * NC;
        gemm_tile((const u16*)(ws + WS_H) + half * 1024, DM, (const u16*)(ws + WS_WINC) + half * 1024, DM, 1024, (32 + (tile & 1)) * 256, (tile >> 1) * 256, e);
    }
    {
        const int nb = gridDim.x, first = nb > 128 ? 128 : 0, cnt = nb - first;
        if ((int)blockIdx.x >= first) {
            const int rank = blockIdx.x - first;
            rmsnorm_rows_bf16((const float*)(ws + WS_X1), (const float*)(ws + WS_X1), NTP, NTP, p.c_norm, (u16*)(ws + WS_H), rank, cnt);
            const long n = 128 * 508 * 128;
            const long c0 = nb == 256 ? n * (8 * WIN_U5) / (8 * WIN_UT) : 0;
            win_copy_range(p, (int)(c0 + (n - c0) * rank / cnt), (int)(c0 + (n - c0) * (rank + 1) / cnt));
        }
    }
}
DI void phase8(const Params& p) {
    char* ws = p.ws;
    for (int t = blockIdx.x; t < 32 * 32; t += gridDim.x) {
        const EpiInC e = make_epi_c(p);
        gemm_tile((const u16*)(ws + WS_H), DM, (const u16*)(ws + WS_WINC), DM, DM, (t & 31) * 256, (t >> 5) * 256, e);
    }
}
DI void phase9(const Params& p) {
    char* ws = p.ws;
    for (int it = first_item(0); it < 1024; it += gridDim.x) {
        const int bh = it >> 4, b = bh >> 4, h = bh & 15, chunk = (it & 15) * 8 + (threadIdx.x >> 6);
        rec_prep2<8>((const u16*)(ws + WS_HQT) + (long)bh * 262144, (const u16*)(ws + WS_HKA) + (long)bh * 262144,
                     (const u16*)(ws + WS_HVT) + (long)bh * 128 * 128 * 16, (float*)(ws + WS_HOI) + (long)bh * 128 * 8 * 256, chunk);
    }
    if (gridDim.x != 256) hgrn_sample_loop(p, first_item(1024) - 1024, 2048, gridDim.x);
}
DI void phase10(const Params&) {}
DI void phase11(const Params& p) {
    char* ws = p.ws;
    const int nb = gridDim.x, w = __builtin_amdgcn_readfirstlane((int)(threadIdx.x >> 6));
    if (nb == 256) {
        if (threadIdx.x < 4) reinterpret_cast<int*>(smem + RW_OFF + (threadIdx.x >> 1) * RW_PAIR_BYTES + RW_SLOTS * 4096)[threadIdx.x & 1] = 0;
        __syncthreads();
        if (w >= 6) {
            for (int n = 0; n < 4; ++n) hgrn_sample_wave(p, (int)blockIdx.x * 2 + (w - 6) + 512 * n, reinterpret_cast<float*>(smem + (w - 6) * 8192));
        } else if (w != 2 && w != 5) {
            const int ww = w >= 3 ? w - 3 : w;
            const int j = blockIdx.x & 7, local = ((int)blockIdx.x >> 3) + 32 * ww;
            const int t = (j * 8 + (local >> 3)) * 8 + (local & 7);
            const int bh = t >> 3, b = bh >> 4, h = bh & 15, vt = t & 7;
            if (w < 3)
                rec_state_wave<8>((const u16*)(ws + WS_HKST) + (long)bh * 128 * 2048, (const u16*)(ws + WS_HVT) + (long)bh * 128 * 128 * 16,
                                  (const u16*)(ws + WS_HDC) + (long)bh * 128 * 128, vt, p.out + O_HGP + (long)bh * 128 * 128, 128,
                                  RW_OFF + ww * RW_PAIR_BYTES);
            else
                rec_out_wave<8>((const u16*)(ws + WS_HQT) + (long)bh * 262144, (const float*)(ws + WS_HOI) + (long)bh * 128 * 8 * 256, vt,
                                (float*)(ws + WS_OC32) + (long)b * 2048 * DM + h * 128, DM, RW_OFF + ww * RW_PAIR_BYTES);
        }
    } else if (nb >= 64) {
        if ((int)blockIdx.x < 16) {
            for (int t = blockIdx.x; t < 16; t += 16) {
                EpiRes e{(const float*)(ws + WS_X1), (const float*)(ws + WS_X1) + (long)NTP * DM, (float*)(ws + WS_X2)};
                gemm_tile((const u16*)(ws + WS_OA), DM, (const u16*)(ws + WS_WOUTC), DM, DM, (32 + (t >> 3)) * 256, (t & 7) * 256, e);
            }
        } else {
            const int nw = nb - 16;
            if (nb == 256) {
                if (threadIdx.x < 6) reinterpret_cast<int*>(smem + RW_OFF + (threadIdx.x >> 1) * RW_PAIR_BYTES + RW_SLOTS * 4096)[threadIdx.x & 1] = 0;
                __syncthreads();
                const int ww = w >= 3 ? w - 3 : w;
                const int j = blockIdx.x & 7, local = ((int)(blockIdx.x - 16) >> 3) + 30 * ww;
                if (w < 6 && local < 64) {
                    const int t = (j * 8 + (local >> 3)) * 8 + (local & 7);
                    const int bh = t >> 3, b = bh >> 4, h = bh & 15, vt = t & 7;
                    if (w < 3)
                        rec_state_wave<8>((const u16*)(ws + WS_HKST) + (long)bh * 128 * 2048, (const u16*)(ws + WS_HVT) + (long)bh * 128 * 128 * 16,
                                          (const u16*)(ws + WS_HDC) + (long)bh * 128 * 128, vt, p.out + O_HGP + (long)bh * 128 * 128, 128,
                                          RW_OFF + ww * RW_PAIR_BYTES);
                    else
                        rec_out_wave<8>((const u16*)(ws + WS_HQT) + (long)bh * 262144, (const float*)(ws + WS_HOI) + (long)bh * 128 * 8 * 256, vt,
                                        (float*)(ws + WS_OC32) + (long)b * 2048 * DM + h * 128, DM, RW_OFF + ww * RW_PAIR_BYTES);
                }
            } else {
                for (int t0 = (blockIdx.x - 16) + nw * w; t0 < 512; t0 += nw * 8) {
                    const int t = t0;
                    const int bh = t >> 3, b = bh >> 4, h = bh & 15, vt = t & 7;
                    rec_walker<8>((const u16*)(ws + WS_HQT) + (long)bh * 262144, (const u16*)(ws + WS_HKST) + (long)bh * 128 * 2048,
                                  (const u16*)(ws + WS_HVT) + (long)bh * 128 * 128 * 16, (const u16*)(ws + WS_HDC) + (long)bh * 128 * 128,
                                  (const float*)(ws + WS_HOI) + (long)bh * 128 * 8 * 256, vt,
                                  (float*)(ws + WS_OC32) + (long)b * 2048 * DM + h * 128, DM, p.out + O_HGP + (long)bh * 128 * 128, 128);
                }
            }
        }
    } else {
        for (int t = blockIdx.x; t < 16; t += nb) {
            EpiRes e{(const float*)(ws + WS_X1), (const float*)(ws + WS_X1) + (long)NTP * DM, (float*)(ws + WS_X2)};
            gemm_tile((const u16*)(ws + WS_OA), DM, (const u16*)(ws + WS_WOUTC), DM, DM, (32 + (t >> 3)) * 256, (t & 7) * 256, e);
        }
        for (int t = blockIdx.x + nb * w; t < 512; t += nb * 8) {
            const int bh = t >> 3, b = bh >> 4, h = bh & 15, vt = t & 7;
            rec_walker<8>((const u16*)(ws + WS_HQT) + (long)bh * 262144, (const u16*)(ws + WS_HKST) + (long)bh * 128 * 2048,
                          (const u16*)(ws + WS_HVT) + (long)bh * 128 * 128 * 16, (const u16*)(ws + WS_HDC) + (long)bh * 128 * 128,
                          (const float*)(ws + WS_HOI) + (long)bh * 128 * 8 * 256, vt,
                          (float*)(ws + WS_OC32) + (long)b * 2048 * DM + h * 128, DM, p.out + O_HGP + (long)bh * 128 * 128, 128);
        }
    }
}
DI void phase12(const Params& p) {
    char* ws = p.ws;
    if (gridDim.x == 256) {
        if (blockIdx.x < 64) {
            const int q4 = blockIdx.x >> 4, t = blockIdx.x & 15;
            EpiStore e{(float*)(ws + WS_PROJC) + ((long)q4 * NTS - NTP) * DM, DM};
            gemm_tile((const u16*)(ws + WS_OA) + q4 * 512, DM, (const u16*)(ws + WS_WOUTC) + q4 * 512, DM, 512, (32 + (t >> 3)) * 256, (t & 7) * 256, e);
        } else {
            hgrn_norm_gate(p, blockIdx.x - 64, 192);
        }
    } else {
        hgrn_norm_gate(p, blockIdx.x, gridDim.x);
    }
}
DI void phase13(const Params& p) {
    char* ws = p.ws;
    for (int t = blockIdx.x; t < 32 * 8; t += gridDim.x) {
        EpiRes e{(const float*)(ws + WS_X1), (const float*)(ws + WS_X1) + (long)NTP * DM, (float*)(ws + WS_X2)};
        gemm_tile((const u16*)(ws + WS_OA), DM, (const u16*)(ws + WS_WOUTC), DM, DM, (t & 31) * 256, (t >> 5) * 256, e);
    }
    final_norm_rows(p, NTP, NT, gridDim.x == 256 ? 4 : 0);
}
DI void phase14(const Params& p) { final_norm_rows(p, 0, NTP, 0); }

template <int PH> DI void run_phase(const Params& p) {
    if (PH == 0) phase0(p);
    if (PH == 1) phase1(p);
    if (PH == 2) phase2(p);
    if (PH == 3) phase3(p);
    if (PH == 4) phase4(p);
    if (PH == 5) phase5(p);
    if (PH == 6) phase6(p);
    if (PH == 7) phase7(p);
    if (PH == 8) phase8(p);
    if (PH == 9) phase9(p);
    if (PH == 10) phase10(p);
    if (PH == 11) phase11(p);
    if (PH == 12) phase12(p);
    if (PH == 13) phase13(p);
    if (PH == 14) phase14(p);
}

#ifndef MK_MULTI
#define MK_MULTI 0
#endif

#ifndef MK_DUMP_LO
#define MK_DUMP_LO 0
#define MK_DUMP_HI 4096
#endif
#if MK_MULTI
template <int PH> __global__ void __launch_bounds__(512, 2) k_phase(Params p) { run_phase<PH>(p); }
__global__ void k_dump(const float4* src, float4* dst, long n) {
    const u16* s = (const u16*)src; float* d = (float*)dst;
    for (long i = (long)blockIdx.x * blockDim.x + threadIdx.x; i < n; i += (long)gridDim.x * blockDim.x) { float v = bf2f(s[i]); const int col = (int)(i & 2047); if (col < MK_DUMP_LO || col >= MK_DUMP_HI) v = 0.f; d[i] = (fabsf(v) < 1e30f) ? v : 12345.f; } }
#else
__global__ void __launch_bounds__(512, 2) k_forward(Params p) {
    volatile LAS unsigned* xbw = (volatile LAS unsigned*)(smem + LDS_BYTES - 16);
    if (threadIdx.x == 0) { xbw[0] = 0u; xbw[1] = 0u; xbw[2] = 0u; xbw[3] = 0u; }
    __syncthreads();
    XcdBarrier bar = xcd_barrier_post(reinterpret_cast<unsigned*>(p.ws + WS_BAR), xbw);
#ifndef MK_DUP
#define MK_DUP -1
#endif
#define RUN_PH(PH) do { run_phase<PH>(p); if (MK_DUP == PH) { xcd_barrier(bar); run_phase<PH>(p); } } while (0)
    RUN_PH(0);  xcd_barrier(bar);
    RUN_PH(1);  xcd_barrier(bar);
    RUN_PH(2);  xcd_barrier(bar);
    RUN_PH(3);  xcd_barrier(bar);
    RUN_PH(4);  xcd_barrier(bar);
    RUN_PH(5);  xcd_barrier(bar);
    RUN_PH(6);  xcd_barrier(bar);
    RUN_PH(7);  xcd_barrier(bar);
    RUN_PH(8);  xcd_barrier(bar);
    RUN_PH(9);  xcd_barrier(bar);
#ifdef DBG_XBAR
    for (int i = 0; i < DBG_XBAR; ++i) xcd_barrier(bar);
#endif
    RUN_PH(11); xcd_barrier(bar);
    RUN_PH(12); xcd_barrier(bar);
    RUN_PH(13); xcd_barrier(bar);
    RUN_PH(14);
}
#endif

extern "C" void kernel_launch(void* const* d_in, const int* in_sizes, int n_in, void* d_out, int out_size, void* d_ws, size_t ws_size,
                              hipStream_t stream) {
    (void)in_sizes; (void)n_in; (void)out_size; (void)ws_size;
    Params p{};
    p.x_prompt = (const float*)d_in[0];  p.x_sample = (const float*)d_in[1];  p.cache_kv = (const float*)d_in[2];
    p.cache_win = (const float*)d_in[3]; p.state_gla = (const float*)d_in[4]; p.state_hgrn = (const float*)d_in[5];
    p.page_table = (const int*)d_in[6];
    p.a_norm = (const float*)d_in[7];    p.a_w_in = (const float*)d_in[8];    p.a_gla_w2 = (const float*)d_in[9];
    p.a_gla_b = (const float*)d_in[10];  p.a_gla_gn = (const float*)d_in[11]; p.a_cmp_pe = (const float*)d_in[12];
    p.a_cmp_w1 = (const float*)d_in[13]; p.a_cmp_b1 = (const float*)d_in[14]; p.a_cmp_w2 = (const float*)d_in[15];
    p.a_w_out = (const float*)d_in[16];  p.c_norm = (const float*)d_in[17];   p.c_w_in = (const float*)d_in[18];
    p.c_lb_logits = (const float*)d_in[19]; p.c_gn = (const float*)d_in[20];  p.c_w_out = (const float*)d_in[21];
    p.final_norm = (const float*)d_in[22];
    p.out = (float*)d_out; p.ws = (char*)d_ws;
    static int grid = 0;
#if MK_MULTI
    if (!grid) {
        int dev = 0, cus = 0; (void)hipGetDevice(&dev); (void)hipDeviceGetAttribute(&cus, hipDeviceAttributeMultiprocessorCount, dev);
        grid = cus > 0 ? cus : 256;
    }
#define LAUNCH_PH(PH) do { (void)hipFuncSetAttribute((const void*)k_phase<PH>, hipFuncAttributeMaxDynamicSharedMemorySize, LDS_BYTES); \
        hipLaunchKernelGGL(k_phase<PH>, dim3(grid), dim3(512), LDS_BYTES, stream, p); } while (0)
#ifndef MK_LAST
#define MK_LAST 14
#endif
#ifndef MK_SKIP
#define MK_SKIP 99
#endif
#define LAUNCH_IF(PH) do { if (PH <= MK_LAST && PH != MK_SKIP) LAUNCH_PH(PH); } while (0)
    LAUNCH_IF(0); LAUNCH_IF(1); LAUNCH_IF(2); LAUNCH_IF(3); LAUNCH_IF(4); LAUNCH_IF(5); LAUNCH_IF(6);
    LAUNCH_IF(7); LAUNCH_IF(8); LAUNCH_IF(9); LAUNCH_IF(10); LAUNCH_IF(11); LAUNCH_IF(12); LAUNCH_IF(13); LAUNCH_IF(14);
#ifdef MK_DUMP_OFF
    hipLaunchKernelGGL(k_dump, dim3(1024), dim3(256), 0, stream, (const float4*)(p.ws + MK_DUMP_OFF), (float4*)p.out, (long)MK_DUMP_N4);
#endif
#else
    if (!grid) {
        int dev = 0, cus = 0, per_cu = 0; (void)hipGetDevice(&dev); (void)hipDeviceGetAttribute(&cus, hipDeviceAttributeMultiprocessorCount, dev);
        (void)hipFuncSetAttribute((const void*)k_forward, hipFuncAttributeMaxDynamicSharedMemorySize, LDS_BYTES);
        (void)hipOccupancyMaxActiveBlocksPerMultiprocessor(&per_cu, (const void*)k_forward, 512, LDS_BYTES);
        if (cus <= 0) cus = 256;
        grid = cus * (per_cu < 1 ? 1 : 1);
    }
    (void)hipMemsetAsync(d_ws, 0, 65536, stream);
    hipLaunchKernelGGL(k_forward, dim3(grid), dim3(512), LDS_BYTES, stream, p);
#endif
}
```

```cpp
#include <hip/hip_runtime.h>
#include <stdint.h>

typedef unsigned short u16;
typedef unsigned int u32;
typedef unsigned long long u64;
using bf16x8 = __attribute__((ext_vector_type(8))) short;
using f32x4  = __attribute__((ext_vector_type(4))) float;
using f32x16 = __attribute__((ext_vector_type(16))) float;
using u32x4  = __attribute__((ext_vector_type(4))) unsigned;
using u32x2  = __attribute__((ext_vector_type(2))) unsigned;
#define DI __device__ __forceinline__

constexpr int DM = 2048, NTP = 8192, NTS = 512, NT = 8704;
constexpr int SEQ = 2048, NB = 4, DB = 128, DSEQ = 4, PAST = 2048;
constexpr int NA = 6696, NAP = 6912, NC = 8192;
constexpr int CQ = 0, CKV = 1024, CZA = 2560, CQB = 3584, CKB = 4096, CVB = 4608, CZB = 5632, CGB = 6656, CLR = 6680;
constexpr float QSCALE = 0.08838834764831845f;
constexpr float QSCALE_L2E = 0.08838834764831845f * 1.4426950408889634f;

constexpr long O_YP = 0, O_YS = 16777216, O_KVP = 17825792, O_KVS = 26214400, O_WINP = 26738688, O_WINS = 27787264,
               O_GLAP = 61341696, O_GLAS = 61865984, O_HGP = 78643200, O_HGS = 79691776;

constexpr size_t AL(size_t x) { return (x + 255) & ~(size_t)255; }
constexpr size_t WS_BAR   = 0;
constexpr size_t WS_WINA  = 65536;
constexpr size_t WS_WOUTA = WS_WINA  + AL((size_t)NAP * DM * 2);
constexpr size_t WS_WINC  = WS_WOUTA + AL((size_t)DM * DM * 2);
constexpr size_t WS_WOUTC = WS_WINC  + AL((size_t)NC * DM * 2);
constexpr size_t WS_W1T   = WS_WOUTC + AL((size_t)DM * DM * 2);
constexpr size_t WS_W2T   = WS_W1T   + AL((size_t)2 * 256 * 4096 * 2);
constexpr size_t WS_HCONST= WS_W2T   + AL((size_t)2 * 256 * 256 * 2);
constexpr size_t WS_H     = WS_HCONST+ AL(2 * 256 * 4);
constexpr size_t WS_XCS   = WS_H     + AL((size_t)NT * DM * 2);
constexpr size_t WS_KV6   = WS_XCS   + AL((size_t)2 * 128 * 2 * 2048 * 128 * 2 + 16384);
constexpr size_t WS_VT    = WS_KV6   + AL((size_t)6 * 4 * 2 * 2048 * 128 * 2 + 16384);
constexpr size_t WS_KF    = WS_VT    + AL((size_t)2 * 4 * 2 * 128 * 2048 * 2 + 16384);
constexpr size_t WS_A2S   = WS_KF    + AL((size_t)2 * 4 * 2 * 128 * 2048 * 2 + 16384);
constexpr size_t WS_A2P   = WS_A2S   + AL((size_t)2 * 32768 * 256 * 2);
constexpr size_t WS_KCS   = WS_A2P   + AL((size_t)2 * 1024 * 256 * 2);
constexpr size_t WS_KCP   = WS_KCS   + AL((size_t)2 * 256 * 128 * 128 * 4);
constexpr size_t WS_VCTP  = WS_KCP   + AL((size_t)8 * 128 * 128 * 2 + 4096);
constexpr size_t WS_PROJ  = WS_VCTP  + AL((size_t)8 * 128 * 128 * 2 + 4096);
constexpr size_t WS_Q     = WS_PROJ  + AL((size_t)NT * NAP * 4);
constexpr size_t WS_GQT   = WS_Q     + AL((size_t)NT * 1024 * 2);
constexpr size_t WS_GKA   = WS_GQT   + AL((size_t)NTP * 512 * 2);
constexpr size_t WS_GKST  = WS_GKA   + AL((size_t)NTP * 512 * 2);
constexpr size_t WS_GVT   = WS_GKST  + AL((size_t)NTP * 512 * 2);
constexpr size_t WS_GDC   = WS_GVT   + AL((size_t)NTP * 1024 * 2);
constexpr size_t WS_GOI   = WS_GDC   + AL((size_t)16 * 128 * 128 * 4);
constexpr size_t WS_OB32  = WS_GOI   + AL((size_t)16 * 128 * 16 * 256 * 4);
constexpr size_t WS_OA    = WS_OB32  + AL((size_t)NTP * 1024 * 4);
constexpr size_t WS_X1    = WS_OA    + AL((size_t)NT * DM * 2);
constexpr size_t WS_PROJC = WS_X1    + AL((size_t)NT * DM * 4);
constexpr size_t WS_HQT   = WS_PROJC + AL((size_t)NT * NC * 4);
constexpr size_t WS_HKA   = WS_HQT   + AL((size_t)NTP * DM * 2);
constexpr size_t WS_HKST  = WS_HKA   + AL((size_t)NTP * DM * 2);
constexpr size_t WS_HVT   = WS_HKST  + AL((size_t)NTP * DM * 2);
constexpr size_t WS_HDC   = WS_HVT   + AL((size_t)NTP * DM * 2);
constexpr size_t WS_HOI   = WS_HDC   + AL((size_t)64 * 128 * 128 * 4);
constexpr size_t WS_OC32  = WS_HOI   + AL((size_t)64 * 128 * 8 * 256 * 4);
constexpr size_t WS_X2    = WS_OC32  + AL((size_t)NTP * DM * 4);
constexpr size_t WS_ZB    = WS_X2    + AL((size_t)NT * DM * 4);
constexpr size_t WS_PCS   = WS_ZB    + AL((size_t)NTP * DM * 2);
constexpr size_t WS_CPP   = WS_PCS   + AL((size_t)2 * NTS * NC * 4);
constexpr size_t WS_END   = WS_CPP   + AL((size_t)4 * 1024 * 256 * 4);

struct Params {
    const float *x_prompt, *x_sample, *cache_kv, *cache_win, *state_gla, *state_hgrn;
    const int* page_table;
    const float *a_norm, *a_w_in, *a_gla_w2, *a_gla_b, *a_gla_gn, *a_cmp_pe, *a_cmp_w1, *a_cmp_b1, *a_cmp_w2, *a_w_out;
    const float *c_norm, *c_w_in, *c_lb_logits, *c_gn, *c_w_out, *final_norm;
    float* out;
    char* ws;
};

extern __shared__ __attribute__((aligned(16))) char smem[];
constexpr int LDS_BYTES = 148480;

typedef float f32x2_t __attribute__((ext_vector_type(2))); typedef __bf16 bf16x2_t __attribute__((ext_vector_type(2)));
DI u32 cvt_pk(float lo, float hi) { f32x2_t v = {lo, hi}; bf16x2_t b = __builtin_convertvector(v, bf16x2_t); return __builtin_bit_cast(u32, b); }
DI u16 f2bf(float x) { return (u16)(cvt_pk(x, 0.f) & 0xffffu); }
DI float bf2f(u16 x) { return __uint_as_float(((u32)x) << 16); }
DI float bflo(u32 w) { return __uint_as_float(w << 16); }
DI float bfhi(u32 w) { return __uint_as_float(w & 0xffff0000u); }
DI float wave_sum(float v) {
#pragma unroll
    for (int o = 32; o >= 1; o >>= 1) v += __shfl_xor(v, o, 64);
    return v;
}
DI float exp2f_(float x) { return __builtin_amdgcn_exp2f(x); }
using f16x2 = __attribute__((ext_vector_type(2))) _Float16;
DI u16 f2h(float x) { const _Float16 h = (_Float16)x; return __builtin_bit_cast(u16, h); }
DI float sigmoidf_(float x) { return 1.f / (1.f + __expf(-x)); }
DI float siluf_(float x) { return x / (1.f + __expf(-x)); }
DI float logsigmoidf_(float x) { return fminf(x, 0.f) - log1pf(__expf(-fabsf(x))); }
DI float gelu_tanh(float x) { const float u = 0.7978845608028654f * (x + 0.044715f * x * x * x); return x / (1.f + __expf(-2.f * u)); }
DI bf16x8 mk8(u32 a, u32 b, u32 c, u32 d) { u32x4 v = {a, b, c, d}; return __builtin_bit_cast(bf16x8, v); }
DI bf16x8 ld8(const u16* p) { return *reinterpret_cast<const bf16x8*>(p); }
DI f32x4 mfma16(bf16x8 a, bf16x8 b, f32x4 c) { return __builtin_amdgcn_mfma_f32_16x16x32_bf16(a, b, c, 0, 0, 0); }
DI f32x16 mfma32(bf16x8 a, bf16x8 b, f32x16 c) { return __builtin_amdgcn_mfma_f32_32x32x16_bf16(a, b, c, 0, 0, 0); }

#define XB_TMO      128
#define XB_XCNT(j)  (256  + 64 * (j))
#define XB_XSUB(j)  (1280 + 64 * (j))
#define XB_XGEN(j)  (2304 + 64 * (j))
#define XB_TOP      3328
#define XB_TOPGEN   3392
#define XCD_BAR_WORDS 3456
#define XB_SPIN_CAP (1u << 18)
#define LAS __attribute__((address_space(3)))

__device__ __forceinline__ unsigned xb_ld(unsigned* p)              { return __hip_atomic_load(p, __ATOMIC_RELAXED, __HIP_MEMORY_SCOPE_AGENT); }
__device__ __forceinline__ unsigned xb_add(unsigned* p, unsigned v) { return __hip_atomic_fetch_add(p, v, __ATOMIC_RELAXED, __HIP_MEMORY_SCOPE_AGENT); }
__device__ __forceinline__ unsigned xb_xcc_id() { return (unsigned)__builtin_amdgcn_s_getreg((3 << 11) | 20) & 0xFu; }
#define XB_SPIN(cond, bar) do { unsigned _sp = 0; while (cond) { __builtin_amdgcn_s_sleep(1); \
    if ((++_sp & 255u) == 0u) { if (xb_ld(&(bar)[XB_TMO])) break; if (_sp > XB_SPIN_CAP) { atomicAdd(&(bar)[XB_TMO], 1u); break; } } } } while (0)

struct XcdBarrier { unsigned* bar; unsigned x; volatile LAS unsigned* st; };

__device__ __forceinline__ XcdBarrier xcd_barrier_post(unsigned* bar, volatile LAS unsigned* st) {
    XcdBarrier b; b.bar = bar; b.x = xb_xcc_id(); b.st = st;
    if (threadIdx.x == 0) (void)xb_add(&bar[XB_XCNT(b.x)], 1u);
    return b;
}
__device__ __forceinline__ void xcd_barrier_complete(unsigned* bar, unsigned x, unsigned& nloc, unsigned& nx) {
    const unsigned G = gridDim.x * gridDim.y * gridDim.z;
    unsigned sum, cnt, mine, sp = 0u;
    for (;;) {
        sum = 0u; cnt = 0u; mine = 0u;
#pragma unroll
        for (unsigned j = 0; j < 16; ++j) { const unsigned c = xb_ld(&bar[XB_XCNT(j)]); sum += c; cnt += (c > 0u) ? 1u : 0u; mine = (j == x) ? c : mine; }
        if (sum == G) break;
        __builtin_amdgcn_s_sleep(1);
        if ((++sp & 255u) == 0u) { if (xb_ld(&bar[XB_TMO])) break; if (sp > XB_SPIN_CAP) { atomicAdd(&bar[XB_TMO], 1u); break; } }
    }
    nloc = mine > 0u ? mine : 1u; nx = cnt > 0u ? cnt : 1u;
}
__device__ __forceinline__ void xcd_barrier(const XcdBarrier& b) {
    asm volatile("s_waitcnt vmcnt(0)" ::: "memory");
    __syncthreads();
    if (threadIdx.x == 0) {
        unsigned* bar = b.bar;
        __builtin_amdgcn_s_waitcnt(0);
        unsigned nloc = b.st[0], nx = b.st[1];
        if (nloc == 0u) { xcd_barrier_complete(bar, b.x, nloc, nx); b.st[0] = nloc; b.st[1] = nx; }
        const unsigned old = xb_add(&bar[XB_XSUB(b.x)], 1u);
        const unsigned gen = old / nloc;
        if (old + 1u == (gen + 1u) * nloc) {
            __builtin_amdgcn_fence(__ATOMIC_RELEASE, "agent");
            asm volatile("s_waitcnt vmcnt(0)" ::: "memory");
            const unsigned og = xb_add(&bar[XB_TOP], 1u);
            const unsigned tg = og / nx;
            if (og + 1u == (tg + 1u) * nx) xb_add(&bar[XB_TOPGEN], 1u);
            else XB_SPIN(xb_ld(&bar[XB_TOPGEN]) == tg, bar);
            __builtin_amdgcn_fence(__ATOMIC_ACQUIRE, "agent");
            xb_add(&bar[XB_XGEN(b.x)], 1u);
            asm volatile("s_waitcnt vmcnt(0)" ::: "memory");
        } else {
            XB_SPIN(xb_ld(&bar[XB_XGEN(b.x)]) == gen, bar);
            __builtin_amdgcn_fence(__ATOMIC_ACQUIRE, "agent");
            asm volatile("s_waitcnt vmcnt(0)" ::: "memory");
        }
    }
    __syncthreads();
}

constexpr int G_BK = 64, G_HALF = 128, G_HT = G_HALF * G_BK;
DI int g_lds_byte(int r, int c) {
    int st = (r >> 4) * 2 + (c >> 5), rr = r & 15, cc = c & 31, ob = rr * 64 + cc * 2;
    return st * 1024 + (ob ^ (((ob >> 9) & 1) << 5));
}
DI void g_stage_rc(int b, int& R, int& C) {
    int st = b / 1024, sb = b % 1024, swz = sb ^ (((sb >> 9) & 1) << 5);
    R = (st >> 1) * 16 + swz / 64; C = (st & 1) * 32 + (swz % 64) / 2;
}

template <class Epi>
DI void gemm_tile(const u16* __restrict__ A, int lda, const u16* __restrict__ Bt, int ldb, int K, int brow, int bcol, const Epi& epi) {
    u16* shm = reinterpret_cast<u16*>(smem);
#define SA(b,h) (shm+((b)*2+(h))*G_HT)
#define SB(b,h) (shm+(4+(b)*2+(h))*G_HT)
#define STAGE_X(T,P,BASE,LD,br,kt,OFF) do{const u16* _gb=(BASE)+((long)(br)*(LD)+(long)(kt)*G_BK); \
    for(int _i=0;_i<2;++_i){int _b=(T)*16+_i*8192; \
      __builtin_amdgcn_global_load_lds((const unsigned*)(_gb+OFF[_i]), \
        (unsigned*)((char*)(P)+_b),16,0,0);}}while(0)
#define STAGEA(P,br,kt) STAGE_X(t0,P,A,lda,br,kt,offA)
#define STAGEB(P,br,kt) STAGE_X(t0,P,Bt,ldb,br,kt,offB)
#define MKOFF(T) do{for(int _i=0;_i<2;++_i){int _r,_c;g_stage_rc((T)*16+_i*8192,_r,_c);offA[_i]=_r*lda+_c;offB[_i]=_r*ldb+_c;}}while(0)
#define LDA(dst,b,h) for(int m=0;m<4;++m)for(int k=0;k<2;++k) \
    dst[m][k]=*reinterpret_cast<const bf16x8*>((char*)SA(b,h)+g_lds_byte(wr*64+m*16+fr,k*32+fq*8))
#define LDB(dst,b,h) for(int n=0;n<2;++n)for(int k=0;k<2;++k) \
    dst[n][k]=*reinterpret_cast<const bf16x8*>((char*)SB(b,h)+g_lds_byte(wc*32+n*16+fr,k*32+fq*8))
#define MMA(ai,bj,At,Bx) do{__builtin_amdgcn_s_setprio(1); \
    for(int m=0;m<4;++m)for(int n=0;n<2;++n)for(int k=0;k<2;++k) \
      acc[ai][bj][m][n]=__builtin_amdgcn_mfma_f32_16x16x32_bf16(At[m][k],Bx[n][k],acc[ai][bj][m][n],0,0,0); \
    __builtin_amdgcn_s_setprio(0);}while(0)
#define WAIT_V(n) asm volatile("s_waitcnt vmcnt(" #n ")":::"memory")
#define WAIT_L(n) asm volatile("s_waitcnt lgkmcnt(" #n ")":::"memory")
#define BAR __builtin_amdgcn_s_barrier()
#define SCHED __builtin_amdgcn_sched_barrier(0)
    int t0 = threadIdx.x; asm volatile("" : "+v"(t0));
    int wid = t0 >> 6, lane = t0 & 63, wr = wid >> 2, wc = wid & 3, fr = lane & 15, fq = lane >> 4;
    f32x4 acc[2][2][4][2] = {};
    bf16x8 At[4][2], B0[2][2], B1[2][2];
    const int nt = K / G_BK;
    int offA[2], offB[2];
    MKOFF(t0);
    WAIT_V(0);
    STAGEB(SB(0,0),bcol,0); STAGEA(SA(0,0),brow,0);
    STAGEB(SB(0,1),bcol+G_HALF,0); STAGEA(SA(0,1),brow+G_HALF,0);
    if(wr==1)BAR;
    WAIT_V(4); BAR;
    STAGEB(SB(1,0),bcol,1); STAGEA(SA(1,0),brow,1); STAGEB(SB(1,1),bcol+G_HALF,1);
    WAIT_V(6); BAR;
    for(int t=0;t<nt-2;t+=2){
      LDB(B0,0,0); SCHED; LDA(At,0,0); STAGEA(SA(1,1),brow+G_HALF,t+1);
      WAIT_L(8); BAR; WAIT_L(0); MMA(0,0,At,B0); BAR; SCHED;
      LDB(B1,0,1); STAGEB(SB(0,0),bcol,t+2);
      BAR; WAIT_L(0); MMA(0,1,At,B1); BAR;
      LDA(At,0,1); STAGEA(SA(0,0),brow,t+2);
      BAR; WAIT_L(0); MMA(1,0,At,B0); BAR; SCHED;
      STAGEB(SB(0,1),bcol+G_HALF,t+2);
      WAIT_V(6); BAR; MMA(1,1,At,B1); BAR;
      LDB(B0,1,0); SCHED; LDA(At,1,0); STAGEA(SA(0,1),brow+G_HALF,t+2);
      WAIT_L(8); BAR; WAIT_L(0); MMA(0,0,At,B0); BAR; SCHED;
      LDB(B1,1,1); STAGEB(SB(1,0),bcol,t+3);
      BAR; WAIT_L(0); MMA(0,1,At,B1); BAR;
      LDA(At,1,1); STAGEA(SA(1,0),brow,t+3);
      BAR; WAIT_L(0); MMA(1,0,At,B0); BAR; SCHED;
      STAGEB(SB(1,1),bcol+G_HALF,t+3);
      WAIT_V(6); BAR; MMA(1,1,At,B1); BAR;
    }
    int tz=t0; asm volatile("":"+v"(tz)); wid=tz>>6; lane=tz&63; wr=wid>>2; wc=wid&3; fr=lane&15; fq=lane>>4;
    MKOFF(tz);
    { LDB(B0,0,0); WAIT_V(0); LDA(At,0,0); STAGE_X(tz,SA(1,1),A,lda,brow+G_HALF,nt-1,offA);
      BAR; WAIT_L(0); MMA(0,0,At,B0); BAR;
      LDB(B1,0,1); BAR; WAIT_L(0); MMA(0,1,At,B1); BAR;
      LDA(At,0,1); WAIT_V(4); BAR; WAIT_L(0); MMA(1,0,At,B0); MMA(1,1,At,B1); BAR; }
    { LDB(B0,1,0); LDA(At,1,0); WAIT_V(2); BAR; WAIT_L(0); MMA(0,0,At,B0); BAR;
      LDB(B1,1,1); WAIT_V(0); BAR; WAIT_L(0); MMA(0,1,At,B1); BAR;
      LDA(At,1,1); BAR; WAIT_L(0); MMA(1,0,At,B0); MMA(1,1,At,B1); BAR; }
    if(wr==0)BAR;
    {
        float* Cs = reinterpret_cast<float*>(smem);
        const bool cm = epi.colmode(brow, bcol), tm = epi.tilemode(brow, bcol);
#pragma unroll
        for (int ai = 0; ai < 2; ++ai) {
#pragma unroll
            for (int bj = 0; bj < 2; ++bj)
#pragma unroll
                for (int m = 0; m < 4; ++m)
#pragma unroll
                    for (int n = 0; n < 2; ++n)
#pragma unroll
                        for (int j = 0; j < 4; ++j)
                            Cs[(wr * 64 + m * 16 + fq * 4 + j) * 256 + bj * G_HALF + wc * 32 + n * 16 + fr] = acc[ai][bj][m][n][j];
            __syncthreads();
            if (tm) {
                epi.tile(Cs, brow + ai * G_HALF, bcol, tz);
            } else if (cm) {
#pragma unroll 4
                for (int i = 0; i < 16; ++i) {
                    const int idx = i * 512 + tz, col = idx & 255, rg = idx >> 8;
                    f32x4 v;
                    v[0] = Cs[(rg * 4 + 0) * 256 + col]; v[1] = Cs[(rg * 4 + 1) * 256 + col]; v[2] = Cs[(rg * 4 + 2) * 256 + col]; v[3] = Cs[(rg * 4 + 3) * 256 + col];
                    epi.col4(brow + ai * G_HALF + rg * 4, bcol + col, v);
                }
            } else {
#pragma unroll 4
                for (int i = 0; i < 16; ++i) {
                    const int idx = i * 512 + tz, row = idx >> 6, c4 = (idx & 63) * 4;
                    epi.row4(brow + ai * G_HALF + row, bcol + c4, *reinterpret_cast<const f32x4*>(Cs + row * 256 + c4));
                }
            }
            __syncthreads();
        }
    }
#undef SA
#undef SB
#undef STAGE_X
#undef STAGEA
#undef STAGEB
#undef MKOFF
#undef LDA
#undef LDB
#undef MMA
}

DI u32x2 pk4(f32x4 v) { u32x2 w = {cvt_pk(v[0], v[1]), cvt_pk(v[2], v[3])}; return w; }
struct EpiInA {
    float* proj; u16* Q; u16* KV6; u16* VT; u16* KF; float* out;
    DI bool tilemode(int, int) const { return false; }
    DI void tile(const float*, int, int, int) const {}
    DI bool colmode(int brow, int bcol) const { const int slot = (bcol - CKV) >> 8; return brow < NTP && bcol >= CKV && (slot == 3 || slot == 5); }
    DI void row4(int row, int col0, f32x4 v) const {
        if (col0 < CKV) {
            *reinterpret_cast<u32x2*>(Q + row * 1024 + col0) = pk4(v * QSCALE_L2E);
        } else if (col0 < CZA) {
            const int c1 = col0 - CKV, slot = c1 >> 8, g = (c1 >> 7) & 1, d = c1 & 127;
            if (row < NTP) {
                const int b = row >> 11, t = row & 2047;
                if (slot < 2) {
                    *reinterpret_cast<u32x2*>(KV6 + ((((slot * 4 + b) * 2 + g) * 2048 + t) * 128 + d)) = pk4(v);
                } else {
                    const int which = slot == 4 ? 1 : 0;
                    *reinterpret_cast<u32x2*>(KF + ((((which * 4 + b) * 2 + g) * 64 + (t >> 5)) * 4096 + (d >> 4) * 512 + (((d >> 3) & 1) * 32 + (t & 31)) * 8 + (d & 7))) = pk4(v);
                }
                if (c1 < 1024) *reinterpret_cast<f32x4*>(out + O_KVP + row * 1024 + c1) = v;
                else if (t >= 1536) *reinterpret_cast<f32x4*>(out + O_WINP + (b * 512 + t - 1536) * 512 + (c1 - 1024)) = v;
            } else {
                const int rr = row - NTP, b = rr >> 2, t = rr & 3;
                if (c1 < 1024) *reinterpret_cast<f32x4*>(out + O_KVS + rr * 1024 + c1) = v;
                else *reinterpret_cast<f32x4*>(out + O_WINS + (b * 512 + 508 + t) * 512 + (c1 - 1024)) = v;
                *reinterpret_cast<f32x4*>(proj + (long)row * NAP + col0) = v;
            }
        } else {
            *reinterpret_cast<f32x4*>(proj + (long)row * NAP + col0) = v;
        }
    }
    DI void col4(int row0, int col, f32x4 v) const {
        const int c1 = col - CKV, slot = c1 >> 8, g = (c1 >> 7) & 1, d = c1 & 127;
        const int b = row0 >> 11, t = row0 & 2047;
        {
            const int which = slot == 5 ? 1 : 0, r = t & 31, kk = r & 15;
            *reinterpret_cast<u32x2*>(VT + (((((which * 4 + b) * 2 + g) * 64 + (t >> 5)) * 8 + (r >> 4) * 4 + (d >> 5)) * 512 + (((kk >> 2) & 1) * 32 + (d & 31)) * 8 + (kk >> 3) * 4)) = pk4(v);
        }
        if (c1 < 1024) {
#pragma unroll
            for (int j = 0; j < 4; ++j) out[O_KVP + (row0 + j) * 1024 + c1] = v[j];
        } else if (t >= 1536) {
#pragma unroll
            for (int j = 0; j < 4; ++j) out[O_WINP + (b * 512 + t + j - 1536) * 512 + (c1 - 1024)] = v[j];
        }
    }
};
struct EpiCmp1 {
    const float* hc; u16* A2;
    DI bool tilemode(int, int) const { return false; }
    DI void tile(const float*, int, int, int) const {}
    DI bool colmode(int, int) const { return false; }
    DI void col4(int, int, f32x4) const {}
    DI void row4(int row, int col0, f32x4 v) const {
        const f32x4 h0 = *reinterpret_cast<const f32x4*>(hc + col0);
        f32x4 o;
#pragma unroll
        for (int j = 0; j < 4; ++j) o[j] = ((row & 127) == 127) ? 0.f : gelu_tanh(v[j] + h0[j]);
        *reinterpret_cast<u32x2*>(A2 + row * 256 + col0) = pk4(o);
    }
};
struct EpiCmp2S {
    float* dst;
    DI bool tilemode(int, int) const { return false; }
    DI void tile(const float*, int, int, int) const {}
    DI bool colmode(int, int) const { return false; }
    DI void col4(int, int, f32x4) const {}
    DI void row4(int row, int col0, f32x4 v) const { if (col0 < 128) *reinterpret_cast<f32x4*>(dst + row * 128 + col0) = v; }
};
struct EpiCmp2P {
    u16* kc; u16* vct; int slot;
    DI bool tilemode(int, int) const { return false; }
    DI void tile(const float*, int, int, int) const {}
    DI bool colmode(int, int) const { return slot == 1; }
    DI void row4(int row, int col0, f32x4 v) const { if (col0 < 128) *reinterpret_cast<u32x2*>(kc + row * 128 + col0) = pk4(v); }
    DI void col4(int row0, int col, f32x4 v) const {
        if (col < 128) { const int bg = row0 >> 7, c = row0 & 127; *reinterpret_cast<u32x2*>(vct + (bg * 128 + col) * 128 + c) = pk4(v); }
    }
};
struct EpiRes {
    const float* rp; const float* rs; float* dst;
    DI bool tilemode(int, int) const { return false; }
    DI void tile(const float*, int, int, int) const {}
    DI bool colmode(int, int) const { return false; }
    DI void col4(int, int, f32x4) const {}
    DI void row4(int row, int col0, f32x4 v) const {
        const f32x4 r = row < NTP ? *reinterpret_cast<const f32x4*>(rp + row * DM + col0) : *reinterpret_cast<const f32x4*>(rs + (row - NTP) * DM + col0);
        *reinterpret_cast<f32x4*>(dst + row * DM + col0) = v + r;
    }
};
struct EpiStore {
    float* dst; int ld;
    DI bool tilemode(int, int) const { return false; }
    DI void tile(const float*, int, int, int) const {}
    DI bool colmode(int, int) const { return false; }
    DI void col4(int, int, f32x4) const {}
    DI void row4(int row, int col0, f32x4 v) const { *reinterpret_cast<f32x4*>(dst + (long)row * ld + col0) = v; }
};

struct EpiInC {
    u16 *QT, *KA, *KST, *VT, *ZB, *DC; float *PCS; const float* lbl;
    DI bool colmode(int, int) const { return false; }
    DI void col4(int, int, f32x4) const {}
    DI bool tilemode(int brow, int) const { return brow < NTP; }
    DI void row4(int row, int col0, f32x4 v) const {
        const int T = col0 >> 8, cc = col0 & 255;
        *reinterpret_cast<f32x4*>(PCS + (long)(row - NTP) * NC + (cc >> 6) * 2048 + 64 * T + (cc & 63)) = v;
    }
    DI void tile(const float* Cs, int row0, int bcol, int tid) const {
        const int ck = tid >> 6, ch = tid & 63, T = bcol >> 8;
        const int gc = 64 * T + ch, h = T >> 1, kch = gc & 127;
        const int tok0 = row0 + ck * 16, b = tok0 >> 11, chunk = (tok0 & 2047) >> 4, bh = b * 16 + h;
        const float* cs = Cs + (ck * 16) * 256 + ch;
        const float lb = sigmoidf_(lbl[2048 + gc] - lbl[gc]);
        float bc[16], kk[16]; float bs = 0.f;
#pragma unroll
        for (int t = 0; t < 16; ++t) {
            const float fr = cs[t * 256 + 64];
            const float sg = 1.f / (1.f + __expf(-fr)), sn = 1.f / (1.f + __expf(fr));
            bs += __logf(lb + (1.f - lb) * sg);
            bc[t] = bs;
            kk[t] = (1.f - lb) * sn;
        }
        u32 kw[8], vw[8];
#pragma unroll
        for (int t = 0; t < 16; t += 2) {
            float ks[2];
#pragma unroll
            for (int u = 0; u < 2; ++u) {
                const float qv = siluf_(cs[(t + u) * 256]);
                const int fo = ((bh * 128 + chunk) * 4 + ((kch >> 3) & 3)) * 512 + ((kch >> 5) * 16 + t + u) * 8 + (kch & 7);
                QT[fo] = f2bf(qv * __expf(bc[t + u]));
                KA[fo] = f2bf(kk[t + u] * __expf(-bc[t + u]));
                ZB[(tok0 + t + u) * DM + gc] = f2bf(cs[(t + u) * 256 + 192]);
                ks[u] = kk[t + u] * __expf(bs - bc[t + u]);
            }
            kw[t >> 1] = cvt_pk(ks[0], ks[1]);
            vw[t >> 1] = cvt_pk(cs[t * 256 + 128], cs[(t + 1) * 256 + 128]);
        }
        const int o16 = ((bh * 128 + chunk) * 128 + kch) * 16;
        {
            u16* kd = KST + (((bh * 128 + chunk) * 4 + ((kch & 7) >> 1)) * 64 + (kch >> 3)) * 8 + (kch & 1) * 4;
#pragma unroll
            for (int qq = 0; qq < 4; ++qq) { u32x2 w2 = {kw[2 * qq], kw[2 * qq + 1]}; *reinterpret_cast<u32x2*>(kd + qq * 128) = w2; }
        }
        u32x4 a0 = {vw[0], vw[1], vw[2], vw[3]}, a1 = {vw[4], vw[5], vw[6], vw[7]};
        reinterpret_cast<u32x4*>(VT + o16)[0] = a0; reinterpret_cast<u32x4*>(VT + o16)[1] = a1;
        DC[(bh * 128 + chunk) * 128 + kch] = f2bf(__expf(bs));
    }
};

DI int mapA(int n) {
    if (n < 2560) return n;
    if (n < 3584) return n - 2560 + 2584;
    if (n < 4096) return n - 3584 + 3608;
    if (n < 4608) return n - 4096 + 4120;
    if (n < 5632) return n - 4608 + 4632;
    if (n < 6656) return n - 5632 + 5672;
    if (n < 6680) return n - 6656 + 2560;
    if (n < 6696) return n - 6680 + 5656;
    return -1;
}
template <int MODE>
DI void tr_tile(const float* __restrict__ src, int lds_, u16* __restrict__ dst, int ldd, int n0, int k0) {
    float* t = reinterpret_cast<float*>(smem);
    int tid = threadIdx.x; asm volatile("" : "+v"(tid));
    {
        const int nn = tid & 63, n = n0 + nn;
        int sc = n;
        if (MODE == 1) sc = mapA(n);
        if (MODE == 2) sc = n < 128 ? n : -1;
        if (MODE == 3) sc = ((n & 255) >> 6) * 2048 + 64 * (n >> 8) + (n & 63);
        float v[32];
#pragma unroll
        for (int i = 0; i < 32; ++i) v[i] = sc >= 0 ? src[(long)(k0 + i * 8 + (tid >> 6)) * lds_ + sc] : 0.f;
#pragma unroll
        for (int i = 0; i < 32; ++i) t[nn * 257 + i * 8 + (tid >> 6)] = v[i];
    }
    __syncthreads();
#pragma unroll
    for (int j = 0; j < 4; ++j) {
        const int nn = tid >> 3, k8 = (tid & 7) * 8 + j * 64;
        const float* r = t + nn * 257 + k8;
        u32x4 w = {cvt_pk(r[0], r[1]), cvt_pk(r[2], r[3]), cvt_pk(r[4], r[5]), cvt_pk(r[6], r[7])};
        *reinterpret_cast<u32x4*>(dst + (long)(n0 + nn) * ldd + k0 + k8) = w;
    }
    __syncthreads();
}

DI void rmsnorm_rows_bf16(const float* __restrict__ xa, const float* __restrict__ xb, int nsplit, int nrows,
                          const float* __restrict__ w, u16* __restrict__ dst, int rank, int count) {
    const int lane = threadIdx.x & 63, wid = threadIdx.x >> 6;
    for (int row = rank * 8 + wid; row < nrows; row += count * 8) {
        const float4* x = reinterpret_cast<const float4*>(row < nsplit ? xa + (long)row * DM : xb + (long)(row - nsplit) * DM);
        float4 v[8]; float ss = 0.f;
#pragma unroll
        for (int i = 0; i < 8; ++i) { v[i] = x[lane + 64 * i]; ss += v[i].x * v[i].x + v[i].y * v[i].y + v[i].z * v[i].z + v[i].w * v[i].w; }
        ss = wave_sum(ss);
        const float inv = rsqrtf(ss * (1.f / DM) + 1e-6f);
#pragma unroll
        for (int i = 0; i < 8; ++i) {
            const float4 g = reinterpret_cast<const float4*>(w)[lane + 64 * i];
            u32x2 o = {cvt_pk(v[i].x * inv * g.x, v[i].y * inv * g.y), cvt_pk(v[i].z * inv * g.z, v[i].w * inv * g.w)};
            *reinterpret_cast<u32x2*>(dst + (long)row * DM + (lane + 64 * i) * 4) = o;
        }
    }
}

constexpr int TRD1 = 32 * 8, TRD2 = TRD1 + 128 * 8, TRD3 = TRD2 + 32 * 8;
DI void tr_deferred(const Params& p, int t) {
    char* ws = p.ws;
    if (t < TRD1)      { tr_tile<0>(p.a_w_out, DM, (u16*)(ws + WS_WOUTA), DM, (t >> 3) * 64, (t & 7) * 256); }
    else if (t < TRD2) { const int u = t - TRD1; tr_tile<3>(p.c_w_in, NC, (u16*)(ws + WS_WINC), DM, (u >> 3) * 64, (u & 7) * 256); }
    else               { const int u = t - TRD2; tr_tile<0>(p.c_w_out, DM, (u16*)(ws + WS_WOUTC), DM, (u >> 3) * 64, (u & 7) * 256); }
}

DI void phase0(const Params& p) {
    const int tid = threadIdx.x, bid = blockIdx.x, nb = gridDim.x;
    char* ws = p.ws;
    {
        constexpr int T0 = (NAP / 64) * 8, T4 = T0 + 2 * 4 * 16, T5 = T4 + 2 * 4;
        for (int t = bid; t < T5; t += nb) {
            if (t < T0)      { tr_tile<1>(p.a_w_in, NA, (u16*)(ws + WS_WINA), DM, (t >> 3) * 64, (t & 7) * 256); }
            else if (t < T4) { const int u = t - T0, s = u >> 6, v = u & 63;
                               tr_tile<0>(p.a_cmp_w1 + (long)s * 4096 * 256, 256, (u16*)(ws + WS_W1T) + (long)s * 256 * 4096, 4096, (v >> 4) * 64, (v & 15) * 256); }
            else             { const int u = t - T4, s = u >> 2, v = u & 3;
                               tr_tile<2>(p.a_cmp_w2 + (long)s * 256 * 128, 128, (u16*)(ws + WS_W2T) + (long)s * 256 * 256, 256, v * 64, 0); }
        }
    }
    rmsnorm_rows_bf16(p.x_prompt, p.x_sample, NTP, NT, p.a_norm, (u16*)(ws + WS_H), blockIdx.x, gridDim.x);
    for (int it = bid; it < 8; it += nb) {
        const int slot = it >> 2, e4 = (it & 3) * 64 + (tid & 15) * 4, kg = tid >> 4;
        const float* w1 = p.a_cmp_w1 + (long)slot * 4096 * 256 + e4;
        const float* pe = p.a_cmp_pe + slot * 4096;
        f32x4 s = {0.f, 0.f, 0.f, 0.f};
        for (int k0 = kg; k0 < 4096; k0 += 32 * 8) {
            f32x4 wv[8]; float pv[8];
#pragma unroll
            for (int u = 0; u < 8; ++u) { wv[u] = *reinterpret_cast<const f32x4*>(w1 + (long)(k0 + 32 * u) * 256); pv[u] = pe[k0 + 32 * u]; }
#pragma unroll
            for (int u = 0; u < 8; ++u) s += wv[u] * pv[u];
        }
        f32x4* red = reinterpret_cast<f32x4*>(smem);
        red[tid] = s;
        __syncthreads();
        if (tid < 16) {
            f32x4 a = {0.f, 0.f, 0.f, 0.f};
            for (int j = 0; j < 32; ++j) a += red[j * 16 + tid];
            const f32x4 b1 = *reinterpret_cast<const f32x4*>(p.a_cmp_b1 + slot * 256 + e4);
            *reinterpret_cast<f32x4*>(reinterpret_cast<float*>(ws + WS_HCONST) + slot * 256 + e4) = a + b1;
        }
        __syncthreads();
    }
}

template <int KS> DI int lds_byte_ks(int r, int c) {
    int st = (r >> 4) * KS + (c >> 5), ob = (r & 15) * 64 + (c & 31) * 2;
    return st * 1024 + (ob ^ (((ob >> 9) & 1) << 5));
}
DI void cmp_gemm_tile(const Params& p, int slot, int bg) {
    char* ws = p.ws;
    constexpr int TA = 128 * 32 * 4, TB = 512 * 32 * 2, NA = 5, B_OFF = NA * TA;
    int tid = threadIdx.x; asm volatile("" : "+v"(tid));
    const int wid = __builtin_amdgcn_readfirstlane(tid >> 6), lane = tid & 63, wr = wid >> 2, wc = wid & 3, fr = lane & 15, fq = lane >> 4;
    const int b = bg >> 1, g = bg & 1;
    const bool awave = wid < 4;
    const int t4 = tid & 255;
    int aoff[4];
#pragma unroll
    for (int i = 0; i < 4; ++i) {
        const int n = 32 * i + (t4 >> 3), sl = (t4 & 7) ^ (((n & 1) << 1) | ((n >> 1) & 1) | (n & 4));
        aoff[i] = (p.page_table[b * 16 + (n >> 3)] * 128 + 16 * (n & 7)) * 1024 + slot * 256 + g * 128 + sl * 4;
    }
    const u16* Bb = (const u16*)(ws + WS_W1T) + (long)slot * 256 * 4096;
    int boff[8];
#pragma unroll
    for (int i = 0; i < 8; ++i) {
        const int bb = (wid & 3) * 1024 + i * 4096 + lane * 16, st = bb >> 10, sb = bb & 1023, swz = sb ^ (((sb >> 9) & 1) << 5);
        const int R = st * 16 + swz / 64, C = (swz % 64) / 2;
        boff[i] = (R & 255) * 4096 + (R >> 8) * 2048 + C;
    }
    auto issue_a = [&](int kt) {
        char* l = smem + (kt % NA) * TA;
        const int o = (kt >> 2) * 1024 + (kt & 3) * 32;
#pragma unroll
        for (int i = 0; i < 4; ++i) __builtin_amdgcn_global_load_lds((const unsigned*)(p.cache_kv + aoff[i] + o), (unsigned*)(l + (i * 256 + t4) * 16), 16, 0, 0);
    };
    auto issue_b = [&](int kt) {
        char* l = smem + B_OFF + (kt & 1) * TB;
#pragma unroll
        for (int i = 0; i < 8; ++i) __builtin_amdgcn_global_load_lds((const unsigned*)(Bb + boff[i] + kt * 32), (unsigned*)(l + (wid & 3) * 1024 + i * 4096 + lane * 16), 16, 0, 0);
    };
    f32x4 acc[4][8];
#pragma unroll
    for (int m = 0; m < 4; ++m)
#pragma unroll
        for (int n = 0; n < 8; ++n) acc[m][n] = (f32x4){0.f, 0.f, 0.f, 0.f};
    constexpr int nt = 64;
    if (awave) { issue_a(0); issue_a(1); issue_a(2); issue_a(3); } else { issue_b(0); }
    for (int t = 0; t < nt; ++t) {
        if (awave) {
            const int rem = nt - t;
            if (rem >= 4) asm volatile("s_waitcnt vmcnt(12)" ::: "memory");
            else if (rem == 3) asm volatile("s_waitcnt vmcnt(8)" ::: "memory");
            else if (rem == 2) asm volatile("s_waitcnt vmcnt(4)" ::: "memory");
            else asm volatile("s_waitcnt vmcnt(0)" ::: "memory");
        } else {
            asm volatile("s_waitcnt vmcnt(0)" ::: "memory");
        }
        __builtin_amdgcn_s_barrier();
        if (awave) { if (t + 4 < nt) issue_a(t + 4); } else { if (t + 1 < nt) issue_b(t + 1); }
        const char* sA = smem + (t % NA) * TA; const char* sB = smem + B_OFF + (t & 1) * TB;
        bf16x8 At[4];
#pragma unroll
        for (int m = 0; m < 4; ++m) {
            const char* ra = sA + (wr * 64 + m * 16 + fr) * 128;
            const int sg = ((fr & 1) << 1) | ((fr >> 1) & 1) | (fr & 4);
            const f32x4 x0 = *reinterpret_cast<const f32x4*>(ra + (((2 * fq) ^ sg) << 4));
            const f32x4 x1 = *reinterpret_cast<const f32x4*>(ra + (((2 * fq + 1) ^ sg) << 4));
            At[m] = mk8(cvt_pk(x0[0], x0[1]), cvt_pk(x0[2], x0[3]), cvt_pk(x1[0], x1[1]), cvt_pk(x1[2], x1[3]));
        }
#pragma unroll
        for (int nh = 0; nh < 2; ++nh) {
            bf16x8 Bf[4];
#pragma unroll
            for (int n = 0; n < 4; ++n) Bf[n] = *reinterpret_cast<const bf16x8*>(sB + lds_byte_ks<1>(wc * 128 + (nh * 4 + n) * 16 + fr, fq * 8));
#pragma unroll
            for (int m = 0; m < 4; ++m)
#pragma unroll
                for (int n = 0; n < 4; ++n) acc[m][nh * 4 + n] = mfma16(At[m], Bf[n], acc[m][nh * 4 + n]);
        }
    }
    __syncthreads();
    float* Cs = reinterpret_cast<float*>(smem);
    if (wc >= 2) {
#pragma unroll
        for (int m = 0; m < 4; ++m)
#pragma unroll
            for (int n = 0; n < 8; ++n)
#pragma unroll
                for (int j = 0; j < 4; ++j) Cs[(wr * 64 + m * 16 + fq * 4 + j) * 256 + (wc - 2) * 128 + n * 16 + fr] = acc[m][n][j];
    }
    __syncthreads();
    if (wc < 2) {
        const float* hc = reinterpret_cast<const float*>(ws + WS_HCONST) + slot * 256;
        u16* A2 = (u16*)(ws + WS_A2S) + ((long)slot * 32768 + bg * 128) * 256;
#pragma unroll
        for (int n = 0; n < 8; ++n) {
            const int col = wc * 128 + n * 16 + fr;
            const float h0 = hc[col];
#pragma unroll
            for (int m = 0; m < 4; ++m)
#pragma unroll
                for (int j = 0; j < 4; ++j) {
                    const int row = wr * 64 + m * 16 + fq * 4 + j;
                    const float u1 = Cs[min(row + 1, 127) * 256 + col];
                    A2[row * 256 + col] = (row == 127) ? (u16)0 : f2bf(gelu_tanh(acc[m][n][j] + u1 + h0));
                    asm volatile("" ::: "memory");
                }
        }
    }
    asm volatile("s_waitcnt vmcnt(0)" ::: "memory");
    __syncthreads();
}
DI void phase1(const Params& p) {
    char* ws = p.ws;
    const int nb = gridDim.x, bid = blockIdx.x;
    const int n_full = (34 * 27 - 1 - bid) / nb + 1;
    const int n_cmp = bid < 256 ? (256 - 1 - bid) / nb + 1 : 0;
    const int cmp_at = (bid & 1) ? n_full : 0;
    int n_in = 0, n_c = 0;
#if defined(DBG_DUP1A) || defined(DBG_DUP1B) || defined(DBG_DUP1C)
    for (int rep = 0; rep < 2; ++rep) { n_in = 0; n_c = 0;
#endif
    for (int k = 0; k < n_full + n_cmp; ++k) {
        const bool is_cmp = (k >= cmp_at) && (n_c < n_cmp);
#ifdef DBG_DUP1A
        if (rep == 1 && is_cmp) { ++n_c; continue; }
#endif
#if defined(DBG_DUP1B) || defined(DBG_DUP1C)
        if (rep == 1 && !is_cmp) { ++n_in; continue; }
#endif
        if (is_cmp) {
            const int t = bid + n_c * nb, slot = t >> 7, rt = t & 127;
            cmp_gemm_tile(p, slot, 2 * rt);
            cmp_gemm_tile(p, slot, 2 * rt + 1);
            EpiCmp2S e{(float*)(ws + WS_KCS) + (long)slot * 32768 * 128};
            gemm_tile((const u16*)(ws + WS_A2S) + (long)slot * 32768 * 256, 256, (const u16*)(ws + WS_W2T) + (long)slot * 256 * 256, 256, 256, rt * 256, 0, e);
            ++n_c;
        } else {
            const int u = bid + n_in * nb, pm = u % 34, pn = u / 34;
            EpiInA e{(float*)(ws + WS_PROJ), (u16*)(ws + WS_Q), (u16*)(ws + WS_KV6), (u16*)(ws + WS_VT), (u16*)(ws + WS_KF), p.out};
            gemm_tile((const u16*)(ws + WS_H), DM, (const u16*)(ws + WS_WINA), DM, DM, pm * 256, pn * 256, e);
            ++n_in;
        }
    }
#if defined(DBG_DUP1A) || defined(DBG_DUP1B) || defined(DBG_DUP1C)
    }
#endif
    {
        const int rem = (34 * 27) % nb;
        const int sidx = rem == 0 ? bid : bid - rem, scount = rem == 0 ? nb : nb - rem;
        if (sidx >= 0) for (int t = sidx; t < TRD3; t += scount) tr_deferred(p, t);
    }
}

template <int NVT>
DI void rec_prep2(const u16* __restrict__ QT, const u16* __restrict__ KA, const u16* __restrict__ VTc,
                  float* __restrict__ OI, int chunk) {
    const int lane = threadIdx.x & 63, c = lane & 15, q = lane >> 4;
    bf16x8 fa[4], fb[4];
#pragma unroll
    for (int m = 0; m < 4; ++m) { const int o = ((chunk * 4 + q) * 64 + m * 16 + c) * 8; fa[m] = ld8(KA + o); fb[m] = ld8(QT + o); }
    u32x2 w[NVT];
#pragma unroll
    for (int vt = 0; vt < NVT; ++vt) w[vt] = *reinterpret_cast<const u32x2*>(VTc + ((chunk * NVT + vt) * 16 + c) * 16 + 4 * q);
    f32x4 att = {0.f, 0.f, 0.f, 0.f};
#pragma unroll
    for (int m = 0; m < 4; ++m) att = mfma16(fa[m], fb[m], att);
#pragma unroll
    for (int jj = 0; jj < 4; ++jj) if (4 * q + jj > c) att[jj] = 0.f;
    const bf16x8 Pa = mk8(cvt_pk(att[0], att[1]), cvt_pk(att[2], att[3]), 0u, 0u);
#pragma unroll
    for (int vt = 0; vt < NVT; ++vt) {
        const f32x4 zero4 = {0.f, 0.f, 0.f, 0.f};
        const f32x4 o = mfma16(Pa, mk8(w[vt].x, w[vt].y, 0u, 0u), zero4);
        *reinterpret_cast<f32x4*>(OI + ((chunk * NVT + vt) * 64 + lane) * 4) = o;
    }
}

using bf16x4 = __attribute__((ext_vector_type(4))) short;
DI bf16x4 ld4(const u16* p) { return *reinterpret_cast<const bf16x4*>(p); }
DI f32x4 mfma16k16(bf16x4 a, bf16x4 b, f32x4 c) { return __builtin_amdgcn_mfma_f32_16x16x16bf16_1k(a, b, c, 0, 0, 0); }
struct RecOps { bf16x8 Aq[4]; bf16x8 Ak[4]; u32x4 dv[4]; bf16x4 Bu; f32x4 oi; };
template <int NVT>
DI void rec_load(RecOps& R, const u16* __restrict__ QT, const u16* __restrict__ KST, const u16* __restrict__ VTc,
                 const u16* __restrict__ DC, const float* __restrict__ OI, int vt, int ch, int lane) {
    const int c = lane & 15, q = lane >> 4;
    const u16* qt = QT + ch * 2048 + lane * 8;
#pragma unroll
    for (int pp = 0; pp < 4; ++pp) R.Aq[pp] = ld8(qt + pp * 512);
    const u16* ks = KST + ch * 2048 + lane * 8;
#pragma unroll
    for (int r2 = 0; r2 < 4; ++r2) R.Ak[r2] = ld8(ks + r2 * 512);
    const u16* dc = DC + ch * 128 + 32 * q;
#pragma unroll
    for (int i = 0; i < 4; ++i) R.dv[i] = *reinterpret_cast<const u32x4*>(dc + 8 * i);
    R.Bu = ld4(VTc + ((ch * NVT + vt) * 16 + c) * 16 + 4 * q);
    R.oi = *reinterpret_cast<const f32x4*>(OI + ((ch * NVT + vt) * 64 + lane) * 4);
}
DI void rec_step(const RecOps& R, f32x4 (&S)[8], float* __restrict__ Orow, int ldo) {
    f32x4 o = R.oi;
#pragma unroll
    for (int pp = 0; pp < 4; ++pp) {
        const bf16x8 Bs = mk8(cvt_pk(S[0][pp], S[1][pp]), cvt_pk(S[2][pp], S[3][pp]), cvt_pk(S[4][pp], S[5][pp]), cvt_pk(S[6][pp], S[7][pp]));
        o = mfma16(R.Aq[pp], Bs, o);
    }
#pragma unroll
    for (int jj = 0; jj < 4; ++jj) Orow[jj * ldo] = o[jj];
#pragma unroll
    for (int rt = 0; rt < 8; ++rt) {
        f32x4 d;
#pragma unroll
        for (int jj = 0; jj < 4; ++jj) d[jj] = (rt & 1) ? bfhi(R.dv[jj][rt >> 1]) : bflo(R.dv[jj][rt >> 1]);
        const bf16x4 ak = (rt & 1) ? __builtin_shufflevector(R.Ak[rt >> 1], R.Ak[rt >> 1], 4, 5, 6, 7) : __builtin_shufflevector(R.Ak[rt >> 1], R.Ak[rt >> 1], 0, 1, 2, 3);
        S[rt] = mfma16k16(ak, R.Bu, S[rt] * d);
    }
}
template <int NVT>
DI void rec_walker(const u16* __restrict__ QT, const u16* __restrict__ KST, const u16* __restrict__ VTc,
                   const u16* __restrict__ DC, const float* __restrict__ OI, int vt,
                   float* __restrict__ O, int ldo, float* __restrict__ Sout, int DV) {
    int lane = threadIdx.x & 63; asm volatile("" : "+v"(lane));
    const int c = lane & 15, q = lane >> 4;
    f32x4 S[8];
#pragma unroll
    for (int rt = 0; rt < 8; ++rt) S[rt] = (f32x4){0.f, 0.f, 0.f, 0.f};
    float* o0 = O + (4 * q) * ldo + 16 * vt + c;
    RecOps A, B, C;
    rec_load<NVT>(A, QT, KST, VTc, DC, OI, vt, 0, lane);
    rec_load<NVT>(B, QT, KST, VTc, DC, OI, vt, 1, lane);
    rec_load<NVT>(C, QT, KST, VTc, DC, OI, vt, 2, lane);
    for (int ch = 0; ch < 126; ch += 3) {
        __builtin_amdgcn_sched_barrier(0);
        rec_step(A, S, o0 + (ch * 16) * ldo, ldo);
        __builtin_amdgcn_sched_barrier(0);
        rec_load<NVT>(A, QT, KST, VTc, DC, OI, vt, ch + 3, lane);
        __builtin_amdgcn_sched_barrier(0);
        rec_step(B, S, o0 + ((ch + 1) * 16) * ldo, ldo);
        __builtin_amdgcn_sched_barrier(0);
        rec_load<NVT>(B, QT, KST, VTc, DC, OI, vt, ch + 4, lane);
        __builtin_amdgcn_sched_barrier(0);
        rec_step(C, S, o0 + ((ch + 2) * 16) * ldo, ldo);
        __builtin_amdgcn_sched_barrier(0);
        rec_load<NVT>(C, QT, KST, VTc, DC, OI, vt, min(ch + 5, 127), lane);
    }
    __builtin_amdgcn_sched_barrier(0);
    rec_step(A, S, o0 + (126 * 16) * ldo, ldo);
    rec_step(B, S, o0 + (127 * 16) * ldo, ldo);
#pragma unroll
    for (int rt = 0; rt < 8; ++rt)
#pragma unroll
        for (int jj = 0; jj < 4; ++jj) Sout[(32 * q + 8 * jj + rt) * DV + 16 * vt + c] = S[rt][jj];
}

constexpr int RW_SLOTS = 8, RW_PAIR_BYTES = RW_SLOTS * 4096 + 64, RW_OFF = 32768;
DI void rw_wait_gt(volatile LAS int* f, int v) { while (*f <= v) __builtin_amdgcn_s_sleep(1); asm volatile("" ::: "memory"); }
struct RecSt { bf16x8 Ak[4]; u32x4 dv[4]; bf16x4 Bu; };
template <int NVT>
DI void rs_load(RecSt& R, const u16* __restrict__ KST, const u16* __restrict__ VTc, const u16* __restrict__ DC, int vt, int ch, int lane) {
    const int c = lane & 15, q = lane >> 4;
    const u16* ks = KST + ch * 2048 + lane * 8;
#pragma unroll
    for (int r2 = 0; r2 < 4; ++r2) R.Ak[r2] = ld8(ks + r2 * 512);
    const u16* dc = DC + ch * 128 + 32 * q;
#pragma unroll
    for (int i = 0; i < 4; ++i) R.dv[i] = *reinterpret_cast<const u32x4*>(dc + 8 * i);
    R.Bu = ld4(VTc + ((ch * NVT + vt) * 16 + c) * 16 + 4 * q);
}
DI void rs_step(const RecSt& R, f32x4 (&S)[8], char* __restrict__ slot, volatile LAS int* prod, volatile LAS int* cons, int s, int lane) {
    rw_wait_gt(cons, s - RW_SLOTS);
#pragma unroll
    for (int pp = 0; pp < 4; ++pp) {
        const bf16x8 Bs = mk8(cvt_pk(S[0][pp], S[1][pp]), cvt_pk(S[2][pp], S[3][pp]), cvt_pk(S[4][pp], S[5][pp]), cvt_pk(S[6][pp], S[7][pp]));
        *reinterpret_cast<bf16x8*>(slot + pp * 1024 + lane * 16) = Bs;
    }
    asm volatile("" ::: "memory");
    *prod = s + 1;
#pragma unroll
    for (int rt = 0; rt < 8; ++rt) {
        f32x4 d;
#pragma unroll
        for (int jj = 0; jj < 4; ++jj) d[jj] = (rt & 1) ? bfhi(R.dv[jj][rt >> 1]) : bflo(R.dv[jj][rt >> 1]);
        const bf16x4 ak = (rt & 1) ? __builtin_shufflevector(R.Ak[rt >> 1], R.Ak[rt >> 1], 4, 5, 6, 7) : __builtin_shufflevector(R.Ak[rt >> 1], R.Ak[rt >> 1], 0, 1, 2, 3);
        S[rt] = mfma16k16(ak, R.Bu, S[rt] * d);
    }
}
template <int NVT>
DI void rec_state_wave(const u16* __restrict__ KST, const u16* __restrict__ VTc, const u16* __restrict__ DC, int vt,
                       float* __restrict__ Sout, int DV, int ring_off) {
    char* ring = smem + ring_off;
    int lane = threadIdx.x & 63; asm volatile("" : "+v"(lane));
    const int c = lane & 15, q = lane >> 4;
    volatile LAS int* prod = (volatile LAS int*)(ring + RW_SLOTS * 4096);
    volatile LAS int* cons = prod + 1;
    f32x4 S[8];
#pragma unroll
    for (int rt = 0; rt < 8; ++rt) S[rt] = (f32x4){0.f, 0.f, 0.f, 0.f};
    RecSt R[4];
#pragma unroll
    for (int i = 0; i < 4; ++i) rs_load<NVT>(R[i], KST, VTc, DC, vt, i, lane);
    for (int ch = 0; ch < 128; ch += 4) {
#pragma unroll
        for (int i = 0; i < 4; ++i) {
            __builtin_amdgcn_sched_barrier(0);
            rs_step(R[i], S, ring + ((ch + i) & (RW_SLOTS - 1)) * 4096, prod, cons, ch + i, lane);
            __builtin_amdgcn_sched_barrier(0);
            rs_load<NVT>(R[i], KST, VTc, DC, vt, min(ch + i + 4, 127), lane);
        }
    }
#pragma unroll
    for (int rt = 0; rt < 8; ++rt)
#pragma unroll
        for (int jj = 0; jj < 4; ++jj) Sout[(32 * q + 8 * jj + rt) * DV + 16 * vt + c] = S[rt][jj];
}
struct RecOut { bf16x8 Aq[4]; bf16x8 fa[4]; bf16x8 fb[4]; u32x2 w; };
template <int NVT>
DI void ro_load(RecOut& R, const u16* __restrict__ QT, const u16* __restrict__ KA, const u16* __restrict__ VTc, int vt, int ch, int lane) {
    const int c = lane & 15, q = lane >> 4;
    const u16* qt = QT + ch * 2048 + lane * 8;
#pragma unroll
    for (int pp = 0; pp < 4; ++pp) R.Aq[pp] = ld8(qt + pp * 512);
#pragma unroll
    for (int m = 0; m < 4; ++m) { const int o = ((ch * 4 + q) * 64 + m * 16 + c) * 8; R.fa[m] = ld8(KA + o); R.fb[m] = ld8(QT + o); }
    R.w = *reinterpret_cast<const u32x2*>(VTc + ((ch * NVT + vt) * 16 + c) * 16 + 4 * q);
}
template <int NVT>
DI void rec_out_wave(const u16* __restrict__ QT, const u16* __restrict__ KA, const u16* __restrict__ VTc, int vt,
                     float* __restrict__ O, int ldo, int ring_off) {
    char* ring = smem + ring_off;
    int lane = threadIdx.x & 63; asm volatile("" : "+v"(lane));
    const int c = lane & 15, q = lane >> 4;
    volatile LAS int* prod = (volatile LAS int*)(ring + RW_SLOTS * 4096);
    volatile LAS int* cons = prod + 1;
    float* o0 = O + (4 * q) * ldo + 16 * vt + c;
    RecOut R[4];
#pragma unroll
    for (int i = 0; i < 4; ++i) ro_load<NVT>(R[i], QT, KA, VTc, vt, i, lane);
    for (int ch = 0; ch < 128; ch += 4) {
#pragma unroll
        for (int i = 0; i < 4; ++i) {
            const int s = ch + i;
            __builtin_amdgcn_sched_barrier(0);
            f32x4 att = {0.f, 0.f, 0.f, 0.f};
#pragma unroll
            for (int m = 0; m < 4; ++m) att = mfma16(R[i].fa[m], R[i].fb[m], att);
#pragma unroll
            for (int jj = 0; jj < 4; ++jj) if (4 * q + jj > c) att[jj] = 0.f;
            const bf16x8 Pa = mk8(cvt_pk(att[0], att[1]), cvt_pk(att[2], att[3]), 0u, 0u);
            const f32x4 zero4 = {0.f, 0.f, 0.f, 0.f};
            f32x4 o = mfma16(Pa, mk8(R[i].w.x, R[i].w.y, 0u, 0u), zero4);
            rw_wait_gt(prod, s);
            const char* slot = ring + (s & (RW_SLOTS - 1)) * 4096 + lane * 16;
            bf16x8 Bs[4];
#pragma unroll
            for (int pp = 0; pp < 4; ++pp) Bs[pp] = *reinterpret_cast<const bf16x8*>(slot + pp * 1024);
#pragma unroll
            for (int pp = 0; pp < 4; ++pp) o = mfma16(R[i].Aq[pp], Bs[pp], o);
            asm volatile("" ::: "memory");
            *cons = s + 1;
            float* orow = o0 + (s * 16) * ldo;
#pragma unroll
            for (int jj = 0; jj < 4; ++jj) orow[jj * ldo] = o[jj];
            __builtin_amdgcn_sched_barrier(0);
            ro_load<NVT>(R[i], QT, KA, VTc, vt, min(s + 4, 127), lane);
        }
    }
}

DI void gla_prep(const Params& p, int rank, int count) {
    char* ws = p.ws;
    const float* proj = (const float*)(ws + WS_PROJ);
    u16* QT = (u16*)(ws + WS_GQT); u16* KA = (u16*)(ws + WS_GKA); u16* KST = (u16*)(ws + WS_GKST); u16* VT = (u16*)(ws + WS_GVT);
    u16* DC = (u16*)(ws + WS_GDC);
    const int tid = threadIdx.x;
    for (int base = rank * 4; base < 2048; base += count * 4) {
        const int item = base + (tid >> 7), ch = tid & 127;
        const int b = item >> 9, h = (item >> 7) & 3, chunk = item & 127;
        const long tok0 = (long)b * 2048 + chunk * 16;
        float gw[16];
#pragma unroll
        for (int r = 0; r < 16; ++r) gw[r] = p.a_gla_w2[r * 512 + h * 128 + ch];
        const float gb = p.a_gla_b[h * 128 + ch];
        float bc[16]; float bs = 0.f;
#pragma unroll
        for (int t = 0; t < 16; ++t) {
            const float* lr = proj + (tok0 + t) * NAP + CLR;
            float z = gb;
#pragma unroll
            for (int r = 0; r < 16; ++r) z += lr[r] * gw[r];
            bs += logsigmoidf_(z) * (1.f / 16.f);
            bc[t] = bs;
        }
        u32 kw[8];
#pragma unroll
        for (int t = 0; t < 16; t += 2) {
            float kk[2];
#pragma unroll
            for (int u = 0; u < 2; ++u) {
                const float* pr = proj + (tok0 + t + u) * NAP;
                const float qv = pr[CQB + h * 128 + ch] * QSCALE, kv = pr[CKB + h * 128 + ch];
                const int fo = (((b * 4 + h) * 128 + chunk) * 4 + ((ch >> 3) & 3)) * 512 + ((ch >> 5) * 16 + t + u) * 8 + (ch & 7);
                QT[fo] = f2bf(qv * __expf(bc[t + u]));
                KA[fo] = f2bf(kv * __expf(-bc[t + u]));
                kk[u] = kv * __expf(bs - bc[t + u]);
            }
            kw[t >> 1] = cvt_pk(kk[0], kk[1]);
        }
        {
            u16* kd = KST + ((((long)(b * 4 + h) * 128 + chunk) * 4 + ((ch & 7) >> 1)) * 64 + (ch >> 3)) * 8 + (ch & 1) * 4;
#pragma unroll
            for (int qq = 0; qq < 4; ++qq) { u32x2 w2 = {kw[2 * qq], kw[2 * qq + 1]}; *reinterpret_cast<u32x2*>(kd + qq * 128) = w2; }
        }
        DC[((long)(b * 4 + h) * 128 + chunk) * 128 + ch] = f2bf(__expf(bs));
    }
    for (long i = (long)rank * 512 + tid; i < (long)16 * 128 * 256; i += (long)count * 512) {
        const int v = (int)(i & 255), chunk = (int)((i >> 8) & 127), bh = (int)(i >> 15), b = bh >> 2, h = bh & 3;
        const long tok0 = (long)b * 2048 + chunk * 16;
        u32 w[8];
#pragma unroll
        for (int t = 0; t < 16; t += 2)
            w[t >> 1] = cvt_pk(proj[(tok0 + t) * NAP + CVB + h * 256 + v], proj[(tok0 + t + 1) * NAP + CVB + h * 256 + v]);
        u32x4* d = reinterpret_cast<u32x4*>(VT + i * 16);
        u32x4 a0 = {w[0], w[1], w[2], w[3]}, a1 = {w[4], w[5], w[6], w[7]};
        d[0] = a0; d[1] = a1;
    }
}

DI void hgrn_prep(const Params& p) {
    char* ws = p.ws;
    const float* pc = (const float*)(ws + WS_PROJC);
    u16* QT = (u16*)(ws + WS_HQT); u16* KA = (u16*)(ws + WS_HKA); u16* KST = (u16*)(ws + WS_HKST); u16* VT = (u16*)(ws + WS_HVT);
    float* DC = (float*)(ws + WS_HDC);
    const int tid = threadIdx.x;
    for (int base = blockIdx.x * 4; base < 64 * 128; base += gridDim.x * 4) {
        const int item = base + (tid >> 7), ch = tid & 127;
        const int bh = item >> 7, b = bh >> 4, h = bh & 15, chunk = item & 127;
        const long tok0 = (long)b * 2048 + chunk * 16;
        const int gc = h * 128 + ch;
        const float lb = sigmoidf_(p.c_lb_logits[2048 + gc] - p.c_lb_logits[gc]);
        float bc[16], kk[16]; float bs = 0.f;
#pragma unroll
        for (int t = 0; t < 16; ++t) {
            const float fr = pc[(tok0 + t) * NC + 2048 + gc];
            const float sg = 1.f / (1.f + __expf(-fr)), sn = 1.f / (1.f + __expf(fr));
            bs += __logf(lb + (1.f - lb) * sg);
            bc[t] = bs;
            kk[t] = (1.f - lb) * sn;
        }
        u32 kw[8];
#pragma unroll
        for (int t = 0; t < 16; t += 2) {
            float ks[2];
#pragma unroll
            for (int u = 0; u < 2; ++u) {
                const float qv = siluf_(pc[(tok0 + t + u) * NC + gc]);
                QT[(tok0 + t + u) * DM + gc] = f2bf(qv * __expf(bc[t + u]));
                KA[(tok0 + t + u) * DM + gc] = f2bf(kk[t + u] * __expf(-bc[t + u]));
                ks[u] = kk[t + u] * __expf(bs - bc[t + u]);
            }
            kw[t >> 1] = cvt_pk(ks[0], ks[1]);
        }
        u32x4* kd = reinterpret_cast<u32x4*>(KST + (((long)bh * 128 + chunk) * 128 + ch) * 16);
        u32x4 k0 = {kw[0], kw[1], kw[2], kw[3]}, k1 = {kw[4], kw[5], kw[6], kw[7]};
        kd[0] = k0; kd[1] = k1;
        DC[((long)bh * 128 + chunk) * 128 + ch] = __expf(bs);
        u32 w[8];
#pragma unroll
        for (int t = 0; t < 16; t += 2) w[t >> 1] = cvt_pk(pc[(tok0 + t) * NC + 4096 + gc], pc[(tok0 + t + 1) * NC + 4096 + gc]);
        u32x4* d = reinterpret_cast<u32x4*>(VT + (((long)bh * 128 + chunk) * 128 + ch) * 16);
        u32x4 a0 = {w[0], w[1], w[2], w[3]}, a1 = {w[4], w[5], w[6], w[7]};
        d[0] = a0; d[1] = a1;
    }
}

DI void gla_sample_item(const Params& p, int b, int h) {
    char* ws = p.ws;
    const float* proj = (const float*)(ws + WS_PROJ);
    float* L = reinterpret_cast<float*>(smem);
    float* La = L; float* Lk = L + 512; float* Lq = L + 1024; float* Lv = L + 1536; float* Lp = L + 2560; float* Lr = L + 4608;
    int tid = threadIdx.x; asm volatile("" : "+v"(tid));
    {
        const int t = tid >> 7, ch = tid & 127;
        const float* pr = proj + (long)(NTP + b * 4 + t) * NAP;
        float z = p.a_gla_b[h * 128 + ch];
#pragma unroll
        for (int r = 0; r < 16; ++r) z += pr[CLR + r] * p.a_gla_w2[r * 512 + h * 128 + ch];
        La[tid] = __expf(logsigmoidf_(z) * (1.f / 16.f));
        Lk[tid] = pr[CKB + h * 128 + ch];
        Lq[tid] = pr[CQB + h * 128 + ch] * QSCALE;
        for (int i = tid; i < 1024; i += 512) Lv[i] = proj[(long)(NTP + b * 4 + (i >> 8)) * NAP + CVB + h * 256 + (i & 255)];
    }
    __syncthreads();
    {
        const int v = tid & 255, kh = tid >> 8;
        const float* S0 = p.state_gla + ((long)(b * 4 + h) * 128) * 256;
        float* S1 = p.out + O_GLAS + ((long)(b * 4 + h) * 128) * 256;
        const float v0 = Lv[v], v1 = Lv[256 + v], v2 = Lv[512 + v], v3 = Lv[768 + v];
        float o0 = 0.f, o1 = 0.f, o2 = 0.f, o3 = 0.f;
#pragma unroll 16
        for (int kk = 0; kk < 64; ++kk) {
            const int k = kh * 64 + kk;
            float s = S0[(long)k * 256 + v];
            s = La[k] * s + Lk[k] * v0;             o0 += Lq[k] * s;
            s = La[128 + k] * s + Lk[128 + k] * v1; o1 += Lq[128 + k] * s;
            s = La[256 + k] * s + Lk[256 + k] * v2; o2 += Lq[256 + k] * s;
            s = La[384 + k] * s + Lk[384 + k] * v3; o3 += Lq[384 + k] * s;
            S1[(long)k * 256 + v] = s;
        }
        Lp[(0 * 2 + kh) * 256 + v] = o0; Lp[(1 * 2 + kh) * 256 + v] = o1; Lp[(2 * 2 + kh) * 256 + v] = o2; Lp[(3 * 2 + kh) * 256 + v] = o3;
    }
    __syncthreads();
    {
        const int w = tid >> 6, lane = tid & 63, t = w >> 1, v = (w & 1) * 128 + lane * 2;
        const float a0 = Lp[(t * 2) * 256 + v] + Lp[(t * 2 + 1) * 256 + v], a1 = Lp[(t * 2) * 256 + v + 1] + Lp[(t * 2 + 1) * 256 + v + 1];
        const float ss = wave_sum(a0 * a0 + a1 * a1);
        if (lane == 0) Lr[w] = ss;
        __syncthreads();
        const float inv = rsqrtf((Lr[t * 2] + Lr[t * 2 + 1]) * (1.f / 256.f) + 1e-6f);
        const long tok = NTP + b * 4 + t;
        const float* zb = proj + tok * NAP + CZB + h * 256 + v;
        u16* oa = (u16*)(ws + WS_OA) + tok * DM + 1024 + h * 256 + v;
        *reinterpret_cast<u32*>(oa) = cvt_pk(a0 * inv * p.a_gla_gn[v] * siluf_(zb[0]), a1 * inv * p.a_gla_gn[v + 1] * siluf_(zb[1]));
    }
    __syncthreads();
}

DI void gla_sample_wave(const Params& p, int b, int h, float* __restrict__ Lw) {
    char* ws = p.ws;
    const float* proj = (const float*)(ws + WS_PROJ);
    int lane = threadIdx.x & 63; asm volatile("" : "+v"(lane));
    float* La = Lw; float* Lk = Lw + 512; float* Lq = Lw + 1024;
    const long tok0 = NTP + b * 4;
#pragma unroll
    for (int t = 0; t < 4; ++t) {
        const float* pr = proj + (tok0 + t) * NAP;
#pragma unroll
        for (int u = 0; u < 2; ++u) {
            const int ch = lane + 64 * u;
            float z = p.a_gla_b[h * 128 + ch];
#pragma unroll
            for (int r = 0; r < 16; ++r) z += pr[CLR + r] * p.a_gla_w2[r * 512 + h * 128 + ch];
            La[ch * 4 + t] = __expf(logsigmoidf_(z) * (1.f / 16.f));
            Lk[ch * 4 + t] = pr[CKB + h * 128 + ch];
            Lq[ch * 4 + t] = pr[CQB + h * 128 + ch] * QSCALE;
        }
    }
    f32x4 vv[4], o[4];
#pragma unroll
    for (int t = 0; t < 4; ++t) {
        vv[t] = *reinterpret_cast<const f32x4*>(proj + (tok0 + t) * NAP + CVB + h * 256 + lane * 4);
        o[t] = (f32x4){0.f, 0.f, 0.f, 0.f};
    }
    const float* S0 = p.state_gla + ((long)(b * 4 + h) * 128) * 256 + lane * 4;
    float* S1 = p.out + O_GLAS + ((long)(b * 4 + h) * 128) * 256 + lane * 4;
    for (int k0 = 0; k0 < 128; k0 += 16) {
        f32x4 s[16];
#pragma unroll
        for (int kk = 0; kk < 16; ++kk) s[kk] = *reinterpret_cast<const f32x4*>(S0 + (long)(k0 + kk) * 256);
#pragma unroll
        for (int kk = 0; kk < 16; ++kk) {
            const f32x4 a = *reinterpret_cast<const f32x4*>(La + (k0 + kk) * 4), kx = *reinterpret_cast<const f32x4*>(Lk + (k0 + kk) * 4),
                        qx = *reinterpret_cast<const f32x4*>(Lq + (k0 + kk) * 4);
#pragma unroll
            for (int t = 0; t < 4; ++t) { s[kk] = s[kk] * a[t] + vv[t] * kx[t]; o[t] += s[kk] * qx[t]; }
            *reinterpret_cast<f32x4*>(S1 + (long)(k0 + kk) * 256) = s[kk];
        }
    }
    const f32x4 gn = *reinterpret_cast<const f32x4*>(p.a_gla_gn + lane * 4);
#pragma unroll
    for (int t = 0; t < 4; ++t) {
        const float ss = wave_sum(o[t][0] * o[t][0] + o[t][1] * o[t][1] + o[t][2] * o[t][2] + o[t][3] * o[t][3]);
        const float inv = rsqrtf(ss * (1.f / 256.f) + 1e-6f);
        const f32x4 z = *reinterpret_cast<const f32x4*>(proj + (tok0 + t) * NAP + CZB + h * 256 + lane * 4);
        u32x2 w2 = {cvt_pk(o[t][0] * inv * gn[0] * siluf_(z[0]), o[t][1] * inv * gn[1] * siluf_(z[1])),
                    cvt_pk(o[t][2] * inv * gn[2] * siluf_(z[2]), o[t][3] * inv * gn[3] * siluf_(z[3]))};
        *reinterpret_cast<u32x2*>((u16*)(ws + WS_OA) + (tok0 + t) * DM + 1024 + h * 256 + lane * 4) = w2;
    }
}

DI void hgrn_sample_loop(const Params& p, int it0, int itN, int stride) {
    char* ws = p.ws;
    const float* pc = (const float*)(ws + WS_PCS);
    float* L = reinterpret_cast<float*>(smem);
    float* La = L; float* Lk = L + 512; float* Lq = L + 1024; float* Lv = L + 1536; float* Lp = L + 2048; float* Lr = L + 4096;
    int tid = threadIdx.x; asm volatile("" : "+v"(tid));
    const int t = tid >> 7, ch = tid & 127;
    const int v = tid & 127, kq = tid >> 7;
    const int w = tid >> 6, lane = tid & 63, tn = w >> 1, vn = (w & 1) * 64 + lane;
    float sreg[32], pf = 0.f, pq = 0.f, pv = 0.f, pz = 0.f, l0 = 0.f, l1 = 0.f;
    auto prefetch = [&](int it) {
        const int b = it >> 4, h = it & 15, gc = h * 128 + ch;
        const float* S0 = p.state_hgrn + ((long)it * 128 + kq * 32) * 128 + v;
#pragma unroll
        for (int kk = 0; kk < 32; ++kk) sreg[kk] = S0[kk * 128];
        const float* pr = pc + (long)(b * 4 + t) * NC;
        const float* pr2 = pr + (long)NTS * NC;
        pf = pr[2048 + gc] + pr2[2048 + gc]; pq = pr[gc] + pr2[gc]; pv = pr[4096 + gc] + pr2[4096 + gc];
        l0 = p.c_lb_logits[gc]; l1 = p.c_lb_logits[2048 + gc];
        pz = pc[(long)(b * 4 + tn) * NC + 6144 + h * 128 + vn] + pc[(long)(NTS + b * 4 + tn) * NC + 6144 + h * 128 + vn];
    };
    if (it0 < itN) prefetch(it0);
    for (int it = it0; it < itN; it += stride) {
        const int b = it >> 4, h = it & 15;
        {
            const float lb = sigmoidf_(l1 - l0);
            const float sg = 1.f / (1.f + __expf(-pf)), sn = 1.f / (1.f + __expf(pf));
            La[tid] = lb + (1.f - lb) * sg;
            Lk[tid] = (1.f - lb) * sn;
            Lq[tid] = siluf_(pq);
            Lv[tid] = pv;
        }
        const float zc = pz;
        __syncthreads();
        {
            float* S1 = p.out + O_HGS + ((long)it * 128 + kq * 32) * 128 + v;
            const float v0 = Lv[v], v1 = Lv[128 + v], v2 = Lv[256 + v], v3 = Lv[384 + v];
            float o0 = 0.f, o1 = 0.f, o2 = 0.f, o3 = 0.f;
#pragma unroll
            for (int kk = 0; kk < 32; ++kk) {
                const int k = kq * 32 + kk;
                float s = sreg[kk];
                s = La[k] * s + Lk[k] * v0;             o0 += Lq[k] * s;
                s = La[128 + k] * s + Lk[128 + k] * v1; o1 += Lq[128 + k] * s;
                s = La[256 + k] * s + Lk[256 + k] * v2; o2 += Lq[256 + k] * s;
                s = La[384 + k] * s + Lk[384 + k] * v3; o3 += Lq[384 + k] * s;
                S1[kk * 128] = s;
            }
            Lp[(0 * 4 + kq) * 128 + v] = o0; Lp[(1 * 4 + kq) * 128 + v] = o1; Lp[(2 * 4 + kq) * 128 + v] = o2; Lp[(3 * 4 + kq) * 128 + v] = o3;
        }
        if (it + stride < itN) prefetch(it + stride);
        __syncthreads();
        {
            const float a0 = Lp[(tn * 4) * 128 + vn] + Lp[(tn * 4 + 1) * 128 + vn] + Lp[(tn * 4 + 2) * 128 + vn] + Lp[(tn * 4 + 3) * 128 + vn];
            const float ss = wave_sum(a0 * a0);
            if (lane == 0) Lr[w] = ss;
            __syncthreads();
            const float inv = rsqrtf((Lr[tn * 2] + Lr[tn * 2 + 1]) * (1.f / 128.f) + 1e-6f);
            const long tok = NTP + b * 4 + tn;
            ((u16*)(ws + WS_OA))[tok * DM + h * 128 + vn] = f2bf(a0 * inv * p.c_gn[vn] * siluf_(zc));
        }
        __syncthreads();
    }
}

DI void hgrn_sample_wave(const Params& p, int it, float* __restrict__ Lw) {
    char* ws = p.ws;
    const float* pc = (const float*)(ws + WS_PCS);
    const long H2 = (long)NTS * NC;
    int lane = threadIdx.x & 63; asm volatile("" : "+v"(lane));
    const int b = it >> 4, h = it & 15, kp = lane >> 5, c4 = (lane & 31) * 4;
    float* La = Lw; float* Lk = Lw + 512; float* Lq = Lw + 1024;
#pragma unroll
    for (int u = 0; u < 2; ++u) {
        const int ch = lane + 64 * u, gc = h * 128 + ch;
        const float lb = sigmoidf_(p.c_lb_logits[2048 + gc] - p.c_lb_logits[gc]);
#pragma unroll
        for (int t = 0; t < 4; ++t) {
            const float* pr = pc + (long)(b * 4 + t) * NC;
            const float pf = pr[2048 + gc] + pr[H2 + 2048 + gc], pq = pr[gc] + pr[H2 + gc];
            const float sg = 1.f / (1.f + __expf(-pf)), sn = 1.f / (1.f + __expf(pf));
            La[ch * 4 + t] = lb + (1.f - lb) * sg;
            Lk[ch * 4 + t] = (1.f - lb) * sn;
            Lq[ch * 4 + t] = siluf_(pq);
        }
    }
    f32x4 vv[4], o[4];
#pragma unroll
    for (int t = 0; t < 4; ++t) {
        const float* pr = pc + (long)(b * 4 + t) * NC + 4096 + h * 128 + c4;
        vv[t] = *reinterpret_cast<const f32x4*>(pr) + *reinterpret_cast<const f32x4*>(pr + H2);
        o[t] = (f32x4){0.f, 0.f, 0.f, 0.f};
    }
    const float* S0 = p.state_hgrn + ((long)it * 128 + kp) * 128 + c4;
    float* S1 = p.out + O_HGS + ((long)it * 128 + kp) * 128 + c4;
    for (int i0 = 0; i0 < 64; i0 += 16) {
        f32x4 s[16];
#pragma unroll
        for (int ii = 0; ii < 16; ++ii) s[ii] = *reinterpret_cast<const f32x4*>(S0 + (long)(i0 + ii) * 256);
#pragma unroll
        for (int ii = 0; ii < 16; ++ii) {
            const int k = 2 * (i0 + ii) + kp;
            const f32x4 a = *reinterpret_cast<const f32x4*>(La + k * 4), kx = *reinterpret_cast<const f32x4*>(Lk + k * 4),
                        qx = *reinterpret_cast<const f32x4*>(Lq + k * 4);
#pragma unroll
            for (int t = 0; t < 4; ++t) { s[ii] = s[ii] * a[t] + vv[t] * kx[t]; o[t] += s[ii] * qx[t]; }
            *reinterpret_cast<f32x4*>(S1 + (long)(i0 + ii) * 256) = s[ii];
        }
    }
    const f32x4 gn = *reinterpret_cast<const f32x4*>(p.c_gn + c4);
#pragma unroll
    for (int t = 0; t < 4; ++t) {
#pragma unroll
        for (int j = 0; j < 4; ++j) o[t][j] += __shfl_xor(o[t][j], 32, 64);
        const float ss = 0.5f * wave_sum(o[t][0] * o[t][0] + o[t][1] * o[t][1] + o[t][2] * o[t][2] + o[t][3] * o[t][3]);
        const float inv = rsqrtf(ss * (1.f / 128.f) + 1e-6f);
        const float* zr = pc + (long)(b * 4 + t) * NC + 6144 + h * 128 + c4;
        const f32x4 z = *reinterpret_cast<const f32x4*>(zr) + *reinterpret_cast<const f32x4*>(zr + H2);
        u32x2 w2 = {cvt_pk(o[t][0] * inv * gn[0] * siluf_(z[0]), o[t][1] * inv * gn[1] * siluf_(z[1])),
                    cvt_pk(o[t][2] * inv * gn[2] * siluf_(z[2]), o[t][3] * inv * gn[3] * siluf_(z[3]))};
        if (kp == 0) *reinterpret_cast<u32x2*>((u16*)(ws + WS_OA) + (long)(NTP + b * 4 + t) * DM + h * 128 + c4) = w2;
    }
}

DI void gla_norm_gate(const Params& p, int rank, int count) {
    char* ws = p.ws;
    const float* ob = (const float*)(ws + WS_OB32);
    const float* proj = (const float*)(ws + WS_PROJ);
    u16* oa = (u16*)(ws + WS_OA);
    const int lane = threadIdx.x & 63, wid = threadIdx.x >> 6;
    const f32x4 g = reinterpret_cast<const f32x4*>(p.a_gla_gn)[lane];
    for (int it0 = (rank * 8 + wid) * 4; it0 < NTP * 4; it0 += count * 8 * 4) {
        f32x4 v[4], z[4];
#pragma unroll
        for (int u = 0; u < 4; ++u) {
            const int it = it0 + u; const long tok = it >> 2; const int h = it & 3;
            v[u] = reinterpret_cast<const f32x4*>(ob + tok * 1024 + h * 256)[lane];
            z[u] = reinterpret_cast<const f32x4*>(proj + tok * NAP + CZB + h * 256)[lane];
        }
#pragma unroll
        for (int u = 0; u < 4; ++u) {
            const int it = it0 + u; const long tok = it >> 2; const int h = it & 3;
            const float ss = wave_sum(v[u][0] * v[u][0] + v[u][1] * v[u][1] + v[u][2] * v[u][2] + v[u][3] * v[u][3]);
            const float inv = rsqrtf(ss * (1.f / 256.f) + 1e-6f);
            u32x2 o = {cvt_pk(v[u][0] * inv * g[0] * siluf_(z[u][0]), v[u][1] * inv * g[1] * siluf_(z[u][1])),
                       cvt_pk(v[u][2] * inv * g[2] * siluf_(z[u][2]), v[u][3] * inv * g[3] * siluf_(z[u][3]))};
            *reinterpret_cast<u32x2*>(oa + tok * DM + 1024 + h * 256 + lane * 4) = o;
        }
    }
}
DI void hgrn_norm_gate(const Params& p, int rank, int count) {
    char* ws = p.ws;
    const float* oc = (const float*)(ws + WS_OC32);
    const u16* zb = (const u16*)(ws + WS_ZB);
    u16* oa = (u16*)(ws + WS_OA);
    const int lane = threadIdx.x & 63, wid = threadIdx.x >> 6;
    const float2 g = reinterpret_cast<const float2*>(p.c_gn)[lane];
    for (int it0 = (rank * 8 + wid) * 8; it0 < NTP * 16; it0 += count * 8 * 8) {
        float2 v[8]; u32 zw[8];
#pragma unroll
        for (int u = 0; u < 8; ++u) {
            const int it = it0 + u; const long tok = it >> 4; const int h = it & 15;
            v[u] = reinterpret_cast<const float2*>(oc + tok * DM + h * 128)[lane];
            zw[u] = reinterpret_cast<const u32*>(zb + tok * DM + h * 128)[lane];
        }
#pragma unroll
        for (int u = 0; u < 8; ++u) {
            const int it = it0 + u; const long tok = it >> 4; const int h = it & 15;
            const float ss = wave_sum(v[u].x * v[u].x + v[u].y * v[u].y);
            const float inv = rsqrtf(ss * (1.f / 128.f) + 1e-6f);
            *reinterpret_cast<u32*>(oa + tok * DM + h * 128 + lane * 2) = cvt_pk(v[u].x * inv * g.x * siluf_(bflo(zw[u])), v[u].y * inv * g.y * siluf_(bfhi(zw[u])));
        }
    }
}

struct Acc16 { float m, l; f32x4 O[8]; };

DI f32x4 scores16(const float* __restrict__ kr, const bf16x8 (&Qb)[4], int q) {
    f32x4 s = {0.f, 0.f, 0.f, 0.f};
#pragma unroll
    for (int m = 0; m < 4; ++m) {
        const f32x4 a = *reinterpret_cast<const f32x4*>(kr + 32 * m + 4 * q);
        const f32x4 b = *reinterpret_cast<const f32x4*>(kr + 32 * m + 16 + 4 * q);
        s = mfma16(mk8(cvt_pk(a[0], a[1]), cvt_pk(a[2], a[3]), cvt_pk(b[0], b[1]), cvt_pk(b[2], b[3])), Qb[m], s);
    }
    return s;
}
template <class RV>
DI void pv16(int k0, const RV& rowv, const float (&pv)[8], f32x4 (&O)[8], int c, int q) {
    const bf16x8 P = mk8(cvt_pk(pv[0], pv[1]), cvt_pk(pv[2], pv[3]), cvt_pk(pv[4], pv[5]), cvt_pk(pv[6], pv[7]));
    f32x4 L[8], H[8];
#pragma unroll
    for (int e = 0; e < 8; ++e) {
        const int key = k0 + (e < 4 ? 4 * q + e : 16 + 4 * q + e - 4);
        const float* vr = rowv(key);
        L[e] = *reinterpret_cast<const f32x4*>(vr + 4 * c);
        H[e] = *reinterpret_cast<const f32x4*>(vr + 64 + 4 * c);
    }
#pragma unroll
    for (int dt = 0; dt < 4; ++dt) {
        O[dt] = mfma16(mk8(cvt_pk(L[0][dt], L[1][dt]), cvt_pk(L[2][dt], L[3][dt]), cvt_pk(L[4][dt], L[5][dt]), cvt_pk(L[6][dt], L[7][dt])), P, O[dt]);
        O[4 + dt] = mfma16(mk8(cvt_pk(H[0][dt], H[1][dt]), cvt_pk(H[2][dt], H[3][dt]), cvt_pk(H[4][dt], H[5][dt]), cvt_pk(H[6][dt], H[7][dt])), P, O[4 + dt]);
    }
}
template <class RK, class RV, class MK>
DI void attn16_group(int k0, const RK& rowk, const RV& rowv, const MK& valid, const bf16x8 (&Qb)[4], Acc16& A, int c, int q) {
    const f32x4 s0 = scores16(rowk(k0 + c), Qb, q), s1 = scores16(rowk(k0 + 16 + c), Qb, q);
    float sv[8];
#pragma unroll
    for (int jj = 0; jj < 4; ++jj) {
        sv[jj] = valid(k0 + 4 * q + jj) ? s0[jj] : -INFINITY;
        sv[4 + jj] = valid(k0 + 16 + 4 * q + jj) ? s1[jj] : -INFINITY;
    }
    float mx = sv[0];
#pragma unroll
    for (int i = 1; i < 8; ++i) mx = fmaxf(mx, sv[i]);
    mx = fmaxf(mx, __shfl_xor(mx, 16, 64)); mx = fmaxf(mx, __shfl_xor(mx, 32, 64));
    const float mnew = fmaxf(A.m, mx);
    const float muse = (mnew == -INFINITY) ? 0.f : mnew;
    const float alpha = exp2f_(A.m - muse);
    float pv[8]; float ps = 0.f;
#pragma unroll
    for (int i = 0; i < 8; ++i) { pv[i] = exp2f_(sv[i] - muse); ps += pv[i]; }
    ps += __shfl_xor(ps, 16, 64); ps += __shfl_xor(ps, 32, 64);
    A.l = A.l * alpha + ps; A.m = mnew;
#pragma unroll
    for (int dt = 0; dt < 8; ++dt) A.O[dt] *= alpha;
    pv16(k0, rowv, pv, A.O, c, q);
}

constexpr int AS_WAVE_BYTES = 9216;
constexpr int AS_OW_OFF = 8 * AS_WAVE_BYTES;
constexpr int AS_OW_LD = 132;

DI void attn_sample_item(const Params& p, int b, int g) {
    char* ws = p.ws;
    const float* proj = (const float*)(ws + WS_PROJ);
    int tid = threadIdx.x; asm volatile("" : "+v"(tid));
    const int w = tid >> 6, lane = tid & 63, c = lane & 15, q = lane >> 4;
    const int tokc = c >> 2, r = c & 3;
    float* Pl = reinterpret_cast<float*>(smem + w * AS_WAVE_BYTES);
    float* IMP = Pl + 16 * 128;
    float* Ow = reinterpret_cast<float*>(smem + AS_OW_OFF);
    float* ML = Ow + 8 * 16 * AS_OW_LD;
    bf16x8 Qb[4];
    {
        const u16* qb = (const u16*)(ws + WS_Q) + (long)(NTP + b * 4 + tokc) * 1024 + (g * 4 + r) * 128;
#pragma unroll
        for (int m = 0; m < 4; ++m) {
            const u32x2 w0 = *reinterpret_cast<const u32x2*>(qb + 32 * m + 4 * q), w1 = *reinterpret_cast<const u32x2*>(qb + 32 * m + 16 + 4 * q);
            Qb[m] = mk8(w0.x, w0.y, w1.x, w1.y);
        }
    }
    const int cq = tid >> 5, cd = (tid & 31) * 4;
    f32x4 acc = {0.f, 0.f, 0.f, 0.f};
    float gate[3];
    {
        const float* gp = proj + (long)(NTP + b * 4 + (cq >> 2)) * NAP + CGB + (g * 4 + (cq & 3)) * 3;
        gate[0] = sigmoidf_(gp[0]); gate[1] = sigmoidf_(gp[1]); gate[2] = sigmoidf_(gp[2]);
    }
    auto combine = [&](const Acc16& A, float gt) {
#pragma unroll
        for (int dt = 0; dt < 8; ++dt)
#pragma unroll
            for (int jj = 0; jj < 4; ++jj) Ow[(w * 16 + c) * AS_OW_LD + 4 * (4 * q + jj) + (dt & 3) + 64 * (dt >> 2)] = A.O[dt][jj];
        if (q == 0) { ML[(w * 16 + c) * 2] = A.m; ML[(w * 16 + c) * 2 + 1] = A.l; }
        __syncthreads();
        float M = -INFINITY;
#pragma unroll
        for (int ww = 0; ww < 8; ++ww) M = fmaxf(M, ML[(ww * 16 + cq) * 2]);
        float Lsum = 0.f; f32x4 o = {0.f, 0.f, 0.f, 0.f};
        if (M > -INFINITY) {
#pragma unroll
            for (int ww = 0; ww < 8; ++ww) {
                const float sc = exp2f_(ML[(ww * 16 + cq) * 2] - M);
                Lsum += ML[(ww * 16 + cq) * 2 + 1] * sc;
                o += *reinterpret_cast<const f32x4*>(Ow + (ww * 16 + cq) * AS_OW_LD + cd) * sc;
            }
        }
        if (Lsum > 0.f) acc += o * (gt / Lsum);
        __syncthreads();
    };

    const float* kcs = (const float*)(ws + WS_KCS) + ((long)(b * 2 + g) * 128) * 128;
    const float* vcs = kcs + (long)256 * 128 * 128;
    float pc[4][8];
    {
        float mx = -INFINITY;
#pragma unroll
        for (int gi = 0; gi < 4; ++gi) {
            const f32x4 s0 = scores16(kcs + (long)(32 * gi + c) * 128, Qb, q), s1 = scores16(kcs + (long)(32 * gi + 16 + c) * 128, Qb, q);
#pragma unroll
            for (int jj = 0; jj < 4; ++jj) {
                pc[gi][jj] = s0[jj];
                pc[gi][4 + jj] = (32 * gi + 16 + 4 * q + jj < 127) ? s1[jj] : -INFINITY;
                mx = fmaxf(mx, fmaxf(pc[gi][jj], pc[gi][4 + jj]));
            }
        }
        mx = fmaxf(mx, __shfl_xor(mx, 16, 64)); mx = fmaxf(mx, __shfl_xor(mx, 32, 64));
        float ls = 0.f;
#pragma unroll
        for (int gi = 0; gi < 4; ++gi)
#pragma unroll
            for (int i = 0; i < 8; ++i) { pc[gi][i] = exp2f_(pc[gi][i] - mx); ls += pc[gi][i]; }
        ls += __shfl_xor(ls, 16, 64); ls += __shfl_xor(ls, 32, 64);
        const float il = 1.f / ls;
#pragma unroll
        for (int gi = 0; gi < 4; ++gi)
#pragma unroll
            for (int jj = 0; jj < 4; ++jj) {
                pc[gi][jj] *= il; pc[gi][4 + jj] *= il;
                Pl[c * 128 + 32 * gi + 4 * q + jj] = pc[gi][jj];
                Pl[c * 128 + 32 * gi + 16 + 4 * q + jj] = pc[gi][4 + jj];
            }
    }
    __syncthreads();
#pragma unroll
    for (int n = 0; n < 2; ++n) {
        const int pi = lane + 64 * n, tk = pi >> 5, u = pi & 31;
        float s = 0.f;
#pragma unroll
        for (int rr = 0; rr < 4; ++rr) {
            const float* pr = Pl + (tk * 4 + rr) * 128 + 4 * u;
            s += 2.f * (pr[0] + pr[1] + pr[2]) + pr[3] + (u > 0 ? pr[-1] : 0.f);
        }
        IMP[pi] = s;
    }
    __syncthreads();
    u32 mymask;
    {
        u64 bal[2];
#pragma unroll
        for (int n = 0; n < 2; ++n) {
            const int pi = lane + 64 * n, tk = pi >> 5, u = pi & 31;
            bool sel;
            if (u == 0 || u == 31) sel = true;
            else {
                const float mine = IMP[pi];
                int rank = 0;
                for (int u2 = 1; u2 <= 30; ++u2) { const float o = IMP[tk * 32 + u2]; rank += (o > mine || (o == mine && u2 < u)) ? 1 : 0; }
                sel = rank < 13;
            }
            bal[n] = __ballot(sel);
        }
        mymask = tokc == 0 ? (u32)bal[0] : tokc == 1 ? (u32)(bal[0] >> 32) : tokc == 2 ? (u32)bal[1] : (u32)(bal[1] >> 32);
    }
    const u32 umask = (u32)__builtin_amdgcn_readfirstlane((int)(__shfl(mymask, 0, 64) | __shfl(mymask, 4, 64) | __shfl(mymask, 8, 64) | __shfl(mymask, 12, 64)));
    {
        Acc16 A; A.m = -INFINITY; A.l = 0.f;
#pragma unroll
        for (int dt = 0; dt < 8; ++dt) A.O[dt] = (f32x4){0.f, 0.f, 0.f, 0.f};
        if (w < 4) {
            float pvv[8]; float ps = 0.f;
#pragma unroll
            for (int i = 0; i < 8; ++i) { pvv[i] = w == 0 ? pc[0][i] : w == 1 ? pc[1][i] : w == 2 ? pc[2][i] : pc[3][i]; ps += pvv[i]; }
            ps += __shfl_xor(ps, 16, 64); ps += __shfl_xor(ps, 32, 64);
            A.m = 0.f; A.l = ps;
            pv16(32 * w, [&](int key) { return vcs + (long)key * 128; }, pvv, A.O, c, q);
        }
        combine(A, gate[0]);
    }
    {
        Acc16 A; A.m = -INFINITY; A.l = 0.f;
#pragma unroll
        for (int dt = 0; dt < 8; ++dt) A.O[dt] = (f32x4){0.f, 0.f, 0.f, 0.f};
        const int tpos = PAST + tokc;
        for (int gi = w; gi < 65; gi += 8) {
            const int j = gi >> 1;
            if (j < 32 && !((umask >> j) & 1u)) continue;
            const int k0 = 32 * gi;
            const float* pagep = p.cache_kv + (long)p.page_table[b * 16 + (k0 < PAST ? (k0 >> 7) : 15)] * 128 * 1024 + 512 + g * 128;
            const float* newp = proj + (long)(NTP + b * 4) * NAP + CKV + 512 + g * 128;
            auto rowk = [&](int key) { return key < PAST ? pagep + (long)(key & 127) * 1024 : newp + (long)min(key - PAST, 3) * NAP; };
            auto rowv = [&](int key) { return (key < PAST ? pagep + (long)(key & 127) * 1024 : newp + (long)min(key - PAST, 3) * NAP) + 256; };
            const bool selj = j >= 32 || ((mymask >> j) & 1u);
            auto valid = [&](int key) { return selj && key <= tpos; };
            attn16_group(k0, rowk, rowv, valid, Qb, A, c, q);
        }
        combine(A, gate[1]);
    }
    {
        Acc16 A; A.m = -INFINITY; A.l = 0.f;
#pragma unroll
        for (int dt = 0; dt < 8; ++dt) A.O[dt] = (f32x4){0.f, 0.f, 0.f, 0.f};
        const float* winp = p.cache_win + (long)b * 512 * 512 + g * 128;
        const float* newp = proj + (long)(NTP + b * 4) * NAP + CKV + 1024 + g * 128;
        for (int gi = w; gi < 17; gi += 8) {
            const int k0 = 32 * gi;
            auto rowk = [&](int key) { return key < 512 ? winp + (long)key * 512 : newp + (long)min(key - 512, 3) * NAP; };
            auto rowv = [&](int key) { return (key < 512 ? winp + (long)key * 512 : newp + (long)min(key - 512, 3) * NAP) + 256; };
            auto valid = [&](int key) { return key <= 512 + tokc && key > tokc; };
            attn16_group(k0, rowk, rowv, valid, Qb, A, c, q);
        }
        combine(A, gate[2]);
    }
    {
        const long tok = NTP + b * 4 + (cq >> 2); const int h = g * 4 + (cq & 3);
        const f32x4 z = *reinterpret_cast<const f32x4*>(proj + tok * NAP + CZA + h * 128 + cd);
        u32x2 o = {cvt_pk(acc[0] * siluf_(z[0]), acc[1] * siluf_(z[1])), cvt_pk(acc[2] * siluf_(z[2]), acc[3] * siluf_(z[3]))};
        *reinterpret_cast<u32x2*>((u16*)(ws + WS_OA) + tok * DM + h * 128 + cd) = o;
    }
}

DI f32x16 scores32(const u16* __restrict__ kr, const bf16x8 (&Qb)[8], int hh) {
    f32x16 s;
#pragma unroll
    for (int i = 0; i < 16; ++i) s[i] = 0.f;
#pragma unroll
    for (int ks = 0; ks < 8; ++ks) s = mfma32(ld8(kr + 16 * ks + 8 * hh), Qb[ks], s);
    return s;
}
DI void pv32(const u16* __restrict__ vt, int ldt, const float (&pr)[16], f32x16 (&O)[4], int c, int hh) {
#pragma unroll
    for (int s2 = 0; s2 < 2; ++s2) {
        const bf16x8 B = mk8(cvt_pk(pr[8 * s2 + 0], pr[8 * s2 + 1]), cvt_pk(pr[8 * s2 + 2], pr[8 * s2 + 3]),
                             cvt_pk(pr[8 * s2 + 4], pr[8 * s2 + 5]), cvt_pk(pr[8 * s2 + 6], pr[8 * s2 + 7]));
#pragma unroll
        for (int mt = 0; mt < 4; ++mt) {
            const u16* a = vt + (long)(32 * mt + c) * ldt + 16 * s2 + 4 * hh;
            const u32x2 w0 = *reinterpret_cast<const u32x2*>(a), w1 = *reinterpret_cast<const u32x2*>(a + 8);
            O[mt] = mfma32(mk8(w0.x, w0.y, w1.x, w1.y), B, O[mt]);
        }
    }
}
struct Acc32 { float m, l; f32x16 O[4]; };
DI void acc32_init(Acc32& A) {
    A.m = -INFINITY; A.l = 0.f;
#pragma unroll
    for (int mt = 0; mt < 4; ++mt)
#pragma unroll
        for (int i = 0; i < 16; ++i) A.O[mt][i] = 0.f;
}
DI void load_kf(bf16x8 (&kf)[8], const u16* __restrict__ kt, int koff) {
#pragma unroll
    for (int ks = 0; ks < 8; ++ks) kf[ks] = ld8(kt + koff + 16 * ks);
}
DI void load_vf(u32x2 (&vf)[2][4][2], const u16* __restrict__ vt, int ldt, int voff) {
#pragma unroll
    for (int mt = 0; mt < 4; ++mt) {
        const u16* a = vt + 32 * mt * ldt;
#pragma unroll
        for (int s2 = 0; s2 < 2; ++s2) {
            vf[s2][mt][0] = *reinterpret_cast<const u32x2*>(a + voff + 16 * s2);
            vf[s2][mt][1] = *reinterpret_cast<const u32x2*>(a + voff + 16 * s2 + 8);
        }
    }
}
DI void load_kff(bf16x8 (&kf)[8], const u16* __restrict__ kt, int l8) {
#pragma unroll
    for (int ks = 0; ks < 8; ++ks) kf[ks] = ld8(kt + ks * 512 + l8);
}
DI void load_vff(bf16x8 (&vf)[2][4], const u16* __restrict__ vt, int l8) {
#pragma unroll
    for (int s2 = 0; s2 < 2; ++s2)
#pragma unroll
        for (int mt = 0; mt < 4; ++mt) vf[s2][mt] = ld8(vt + (s2 * 4 + mt) * 512 + l8);
}
DI void pv32ff(const bf16x8 (&vf)[2][4], const float (&pr)[16], f32x16 (&O)[4]) {
#pragma unroll
    for (int s2 = 0; s2 < 2; ++s2) {
        const bf16x8 B = mk8(cvt_pk(pr[8 * s2 + 0], pr[8 * s2 + 1]), cvt_pk(pr[8 * s2 + 2], pr[8 * s2 + 3]),
                             cvt_pk(pr[8 * s2 + 4], pr[8 * s2 + 5]), cvt_pk(pr[8 * s2 + 6], pr[8 * s2 + 7]));
#pragma unroll
        for (int mt = 0; mt < 4; ++mt) O[mt] = mfma32(vf[s2][mt], B, O[mt]);
    }
}
DI void pv32f(const u32x2 (&vf)[2][4][2], const float (&pr)[16], f32x16 (&O)[4]) {
#pragma unroll
    for (int s2 = 0; s2 < 2; ++s2) {
        const bf16x8 B = mk8(cvt_pk(pr[8 * s2 + 0], pr[8 * s2 + 1]), cvt_pk(pr[8 * s2 + 2], pr[8 * s2 + 3]),
                             cvt_pk(pr[8 * s2 + 4], pr[8 * s2 + 5]), cvt_pk(pr[8 * s2 + 6], pr[8 * s2 + 7]));
#pragma unroll
        for (int mt = 0; mt < 4; ++mt) O[mt] = mfma32(mk8(vf[s2][mt][0].x, vf[s2][mt][0].y, vf[s2][mt][1].x, vf[s2][mt][1].y), B, O[mt]);
    }
}
template <class LIM>
DI void attn32_run(u64 tmask, const u16* __restrict__ K, const u16* __restrict__ VT, const bf16x8 (&Qb)[8], Acc32& A, int c, int hh, const LIM& lim) {
    if (tmask == 0) return;
    int T = __builtin_ctzll(tmask); tmask &= tmask - 1;
    bf16x8 kf[8];
    const int l8 = (hh * 32 + c) * 8;
    load_kff(kf, K + T * 4096, l8);
    for (;;) {
        f32x16 s;
#pragma unroll
        for (int i = 0; i < 16; ++i) s[i] = 0.f;
#pragma unroll
        for (int ks = 0; ks < 8; ++ks) s = mfma32(kf[ks], Qb[ks], s);
        __builtin_amdgcn_sched_barrier(0);
        bf16x8 vf[2][4];
        load_vff(vf, VT + T * 4096, l8);
        const bool more = tmask != 0;
        const int Tn = more ? (int)__builtin_ctzll(tmask) : T;
        tmask &= tmask - 1;
        load_kff(kf, K + Tn * 4096, l8);
        int lo, hi; lim(T, lo, hi);
        float sv[16];
        float mx = -INFINITY;
#pragma unroll
        for (int i = 0; i < 16; ++i) {
            const int kc = (i & 3) + 8 * (i >> 2);
            sv[i] = (kc <= hi && kc > lo) ? s[i] : -INFINITY;
            mx = fmaxf(mx, sv[i]);
        }
        mx = fmaxf(mx, __shfl_xor(mx, 32, 64));
        const float mnew = fmaxf(A.m, mx);
        const float muse = (mnew == -INFINITY) ? 0.f : mnew;
        const float alpha = exp2f_(A.m - muse);
        float ps = 0.f;
#pragma unroll
        for (int i = 0; i < 16; ++i) { sv[i] = exp2f_(sv[i] - muse); ps += sv[i]; }
        ps += __shfl_xor(ps, 32, 64);
        A.l = A.l * alpha + ps; A.m = mnew;
#pragma unroll
        for (int mt = 0; mt < 4; ++mt) A.O[mt] *= alpha;
        pv32ff(vf, sv, A.O);
        if (!more) break;
        T = Tn;
    }
}

constexpr int AP_WAVE_BYTES = 17408;
constexpr int AP_UM_OFF = 8 * AP_WAVE_BYTES;
constexpr int AP_ST_LD = 132;
constexpr int AP_ST_BYTES = 32 * AP_ST_LD * 2;
constexpr int AP_RING_OFF = 69632;

template <class LIM, class USE>
DI void attn32_ring(u64 tmask, const u16* __restrict__ K, const u16* __restrict__ VT, int tid, int lane,
                    const bf16x8 (&Qb)[8], Acc32& A, const LIM& lim, const USE& use) {
    if (tmask == 0) return;
    int T0 = __builtin_ctzll(tmask); tmask &= tmask - 1;
    int T1 = -1; if (tmask) { T1 = __builtin_ctzll(tmask); tmask &= tmask - 1; }
    auto issue = [&](int T, int buf) {
        char* l = smem + AP_RING_OFF + buf * 16384 + tid * 16;
        __builtin_amdgcn_global_load_lds((const unsigned*)(K + T * 4096 + tid * 8), (unsigned*)l, 16, 0, 0);
        __builtin_amdgcn_global_load_lds((const unsigned*)(VT + T * 4096 + tid * 8), (unsigned*)(l + 8192), 16, 0, 0);
    };
    issue(T0, 0);
    if (T1 >= 0) issue(T1, 1);
    int buf = 0;
    for (;;) {
        int T2 = -1; if (tmask) { T2 = __builtin_ctzll(tmask); tmask &= tmask - 1; }
        if (T1 >= 0) asm volatile("s_waitcnt vmcnt(2)" ::: "memory"); else asm volatile("s_waitcnt vmcnt(0)" ::: "memory");
        __builtin_amdgcn_s_barrier();
        if (T2 >= 0) issue(T2, buf == 0 ? 2 : buf - 1);
        if (use(T0)) {
            const char* kb = smem + AP_RING_OFF + buf * 16384 + lane * 16;
            f32x16 s;
#pragma unroll
            for (int i = 0; i < 16; ++i) s[i] = 0.f;
#pragma unroll
            for (int ks = 0; ks < 8; ++ks) s = mfma32(*reinterpret_cast<const bf16x8*>(kb + ks * 1024), Qb[ks], s);
            int lo, hi; lim(T0, lo, hi);
            float sv[16];
            float mx = -INFINITY;
#pragma unroll
            for (int i = 0; i < 16; ++i) {
                const int kc = (i & 3) + 8 * (i >> 2);
                sv[i] = (kc <= hi && kc > lo) ? s[i] : -INFINITY;
                mx = fmaxf(mx, sv[i]);
            }
            mx = fmaxf(mx, __shfl_xor(mx, 32, 64));
            if (__any(mx > A.m)) {
                const float mnew = fmaxf(A.m, mx);
                const float alpha = exp2f_(A.m - ((mnew == -INFINITY) ? 0.f : mnew));
                A.l *= alpha; A.m = mnew;
#pragma unroll
                for (int mt = 0; mt < 4; ++mt) A.O[mt] *= alpha;
            }
            const float muse = (A.m == -INFINITY) ? 0.f : A.m;
            float ps = 0.f;
#pragma unroll
            for (int i = 0; i < 16; ++i) { sv[i] = exp2f_(sv[i] - muse); ps += sv[i]; }
            ps += __shfl_xor(ps, 32, 64);
            A.l += ps;
#pragma unroll
            for (int s2 = 0; s2 < 2; ++s2) {
                const bf16x8 B = mk8(cvt_pk(sv[8 * s2 + 0], sv[8 * s2 + 1]), cvt_pk(sv[8 * s2 + 2], sv[8 * s2 + 3]),
                                     cvt_pk(sv[8 * s2 + 4], sv[8 * s2 + 5]), cvt_pk(sv[8 * s2 + 6], sv[8 * s2 + 7]));
#pragma unroll
                for (int mt = 0; mt < 4; ++mt) A.O[mt] = mfma32(*reinterpret_cast<const bf16x8*>(kb + 8192 + (s2 * 4 + mt) * 1024), B, A.O[mt]);
            }
        }
        if (T1 < 0) break;
        T0 = T1; T1 = T2; buf = buf == 2 ? 0 : buf + 1;
    }
    __builtin_amdgcn_s_barrier();
}

DI void attn_prompt_item(const Params& p, int b, int g, int X) {
    char* ws = p.ws;
    const float* proj = (const float*)(ws + WS_PROJ);
    int tid = threadIdx.x; asm volatile("" : "+v"(tid));
    const int w = __builtin_amdgcn_readfirstlane(tid >> 6), lane = tid & 63, c = lane & 31, hh = lane >> 5;
    const int ti = c >> 2, r = c & 3;
    const int t0w = 64 * X + 8 * w;
    const int tpos = t0w + ti;
    const long tok = (long)b * 2048 + tpos;
    const int h = g * 4 + r;
    float* OS = reinterpret_cast<float*>(smem + w * AP_WAVE_BYTES);
    float* IMP = OS + 128 * 32;
    int osl = 128 * hh + c;
    asm volatile("" : "+v"(osl));
    bf16x8 Qb[8];
    {
        const u16* qb = (const u16*)(ws + WS_Q) + tok * 1024 + h * 128;
#pragma unroll
        for (int ks = 0; ks < 8; ++ks) Qb[ks] = ld8(qb + 16 * ks + 8 * hh);
    }
    float gate[3];
    {
        const float* gp = proj + tok * NAP + CGB + h * 3;
        gate[0] = sigmoidf_(gp[0]); gate[1] = sigmoidf_(gp[1]); gate[2] = sigmoidf_(gp[2]);
    }
    const int bg = b * 2 + g;
    const int cur = X;
    u32 mymask, umask, bmask;
    u16* ST = reinterpret_cast<u16*>(smem + w * AP_ST_BYTES) + c * AP_ST_LD + 4 * hh;
    {
        const u16* kc = (const u16*)(ws + WS_KCP) + (long)bg * 128 * 128;
        const u16* vct = (const u16*)(ws + WS_VCTP) + (long)bg * 128 * 128;
        float pc[4][16];
        float mx = -INFINITY;
        const int lim2 = min((tpos - 31) >> 4, 126) - 4 * hh;
        bf16x8 kf[8];
        load_kf(kf, kc, c * 128 + 8 * hh);
#pragma unroll
        for (int tl = 0; tl < 4; ++tl) {
            f32x16 s;
#pragma unroll
            for (int i = 0; i < 16; ++i) s[i] = 0.f;
#pragma unroll
            for (int ks = 0; ks < 8; ++ks) s = mfma32(kf[ks], Qb[ks], s);
            if (tl < 3) load_kf(kf, kc + 32 * (tl + 1) * 128, c * 128 + 8 * hh);
#pragma unroll
            for (int i = 0; i < 16; ++i) {
                pc[tl][i] = (32 * tl + (i & 3) + 8 * (i >> 2) <= lim2) ? s[i] : -INFINITY;
                mx = fmaxf(mx, pc[tl][i]);
            }
        }
        mx = fmaxf(mx, __shfl_xor(mx, 32, 64));
        const float muse = (mx == -INFINITY) ? 0.f : mx;
        float ls = 0.f;
#pragma unroll
        for (int tl = 0; tl < 4; ++tl)
#pragma unroll
            for (int i = 0; i < 16; ++i) { pc[tl][i] = exp2f_(pc[tl][i] - muse); ls += pc[tl][i]; }
        ls += __shfl_xor(ls, 32, 64);
        const float il = ls > 0.f ? 1.f / ls : 0.f;
#pragma unroll
        for (int tl = 0; tl < 4; ++tl)
#pragma unroll
            for (int i = 0; i < 16; ++i) {
                pc[tl][i] *= il;
                OS[osl + ((32 * tl + (i & 3) + 8 * (i >> 2))) * 32] = pc[tl][i];
            }
        __syncthreads();
#pragma unroll
        for (int n = 0; n < 4; ++n) {
            const int pi = lane + 64 * n, tk = pi >> 5, u = pi & 31;
            float s = 0.f;
#pragma unroll
            for (int rr = 0; rr < 4; ++rr) {
                const float* pr = OS + (4 * u) * 32 + tk * 4 + rr;
                s += 2.f * (pr[0] + pr[32] + pr[64]) + pr[96] + (u > 0 ? pr[-32] : 0.f);
            }
            IMP[pi] = s;
        }
        __syncthreads();
        u64 bal[4];
#pragma unroll
        for (int n = 0; n < 4; ++n) {
            const int pi = lane + 64 * n, tk = pi >> 5, u = pi & 31;
            bool sel;
            const bool forced = (u == 0) || (u == cur) || (u == cur - 1);
            if (u > cur) sel = false;
            else if (forced) sel = true;
            else {
                const int nf = cur == 0 ? 1 : cur == 1 ? 2 : 3;
                const float mine = IMP[pi];
                int rank = 0;
                for (int u2 = 1; u2 < cur - 1; ++u2) { const float o = IMP[tk * 32 + u2]; rank += (o > mine || (o == mine && u2 < u)) ? 1 : 0; }
                sel = rank < 16 - nf;
            }
            bal[n] = __ballot(sel);
        }
        const u64 bsel = ti < 2 ? bal[0] : ti < 4 ? bal[1] : ti < 6 ? bal[2] : bal[3];
        mymask = (ti & 1) ? (u32)(bsel >> 32) : (u32)bsel;
        umask = (u32)(bal[0] | (bal[0] >> 32) | bal[1] | (bal[1] >> 32) | bal[2] | (bal[2] >> 32) | bal[3] | (bal[3] >> 32));
        if (lane == 0) reinterpret_cast<u32*>(smem + AP_UM_OFF)[w] = umask;
        f32x16 O[4];
#pragma unroll
        for (int mt = 0; mt < 4; ++mt)
#pragma unroll
            for (int i = 0; i < 16; ++i) O[mt][i] = 0.f;
#pragma unroll
        for (int tl = 0; tl < 4; ++tl) {
            u32x2 vf[2][4][2]; load_vf(vf, vct + 32 * tl, 128, c * 128 + 4 * hh);
            float pr[16];
#pragma unroll
            for (int i = 0; i < 16; ++i) pr[i] = OS[osl + ((32 * tl + (i & 3) + 8 * (i >> 2))) * 32];
            pv32f(vf, pr, O);
            __builtin_amdgcn_sched_barrier(0);
        }
        __syncthreads();
        {
            const u32* um = reinterpret_cast<const u32*>(smem + AP_UM_OFF);
            bmask = um[0] | um[1] | um[2] | um[3] | um[4] | um[5] | um[6] | um[7];
            bmask = (u32)__builtin_amdgcn_readfirstlane((int)bmask);
        }
#pragma unroll
        for (int mt = 0; mt < 4; ++mt)
#pragma unroll
            for (int rr = 0; rr < 4; ++rr) {
                u32x2 wv = {cvt_pk(gate[0] * O[mt][4 * rr], gate[0] * O[mt][4 * rr + 1]), cvt_pk(gate[0] * O[mt][4 * rr + 2], gate[0] * O[mt][4 * rr + 3])};
                *reinterpret_cast<u32x2*>(ST + 32 * mt + 8 * rr) = wv;
            }
    }
    const int tp4 = tpos - 4 * hh;
    {
        Acc32 A; acc32_init(A);
        const u16* K = (const u16*)(ws + WS_KF) + ((long)(0 * 4 + b) * 2 + g) * 64 * 4096;
        const u16* VT = (const u16*)(ws + WS_VT) + ((long)(0 * 4 + b) * 2 + g) * 64 * 4096;
        u64 tm = 0;
        for (int j = 0; j <= cur; ++j) if ((bmask >> j) & 1u) tm |= 3ull << (2 * j);
        attn32_ring(tm, K, VT, tid, lane, Qb, A,
                    [&](int T, int& lo, int& hi) { lo = -(1 << 30); hi = ((mymask >> (T >> 1)) & 1u) ? tp4 - 32 * T : -1; },
                    [&](int T) { return ((umask >> (T >> 1)) & 1u) && 32 * T <= t0w + 7; });
#ifdef DBG_DUPSEL
        {
            Acc32 A2; acc32_init(A2);
            attn32_ring(tm, K, VT, tid, lane, Qb, A2,
                        [&](int T, int& lo, int& hi) { lo = -(1 << 30); hi = ((mymask >> (T >> 1)) & 1u) ? tp4 - 32 * T : -1; },
                        [&](int T) { return ((umask >> (T >> 1)) & 1u) && 32 * T <= t0w + 7; });
            asm volatile("" :: "v"(A2.l), "v"(A2.O[0][0]), "v"(A2.O[1][0]), "v"(A2.O[2][0]), "v"(A2.O[3][0]));
        }
#endif
        const float cf = A.l > 0.f ? gate[1] / A.l : 0.f;
#pragma unroll
        for (int mt = 0; mt < 4; ++mt)
#pragma unroll
            for (int rr = 0; rr < 4; ++rr) {
                const u32x2 o = *reinterpret_cast<const u32x2*>(ST + 32 * mt + 8 * rr);
                u32x2 wv = {cvt_pk(bflo(o.x) + cf * A.O[mt][4 * rr], bfhi(o.x) + cf * A.O[mt][4 * rr + 1]),
                            cvt_pk(bflo(o.y) + cf * A.O[mt][4 * rr + 2], bfhi(o.y) + cf * A.O[mt][4 * rr + 3])};
                *reinterpret_cast<u32x2*>(ST + 32 * mt + 8 * rr) = wv;
            }
    }
    {
        Acc32 A; acc32_init(A);
        const u16* K = (const u16*)(ws + WS_KF) + ((long)(1 * 4 + b) * 2 + g) * 64 * 4096;
        const u16* VT = (const u16*)(ws + WS_VT) + ((long)(1 * 4 + b) * 2 + g) * 64 * 4096;
        const int Tlo = max(0, 64 * X - 511) >> 5, Tmax = 2 * X + 1;
        const u64 tm = ((2ull << Tmax) - 1ull) & ~((1ull << Tlo) - 1ull);
        attn32_ring(tm, K, VT, tid, lane, Qb, A,
                    [&](int T, int& lo, int& hi) { hi = tp4 - 32 * T; lo = hi - 512; },
                    [&](int T) { return 32 * T <= t0w + 7 && 32 * T + 31 > t0w - 512; });
        const float cf = A.l > 0.f ? gate[2] / A.l : 0.f;
        int h4 = 4 * hh; asm volatile("" : "+v"(h4));
        u16* oa = (u16*)(ws + WS_OA) + tok * DM + h * 128 + h4;
        const float* za = proj + tok * NAP + CZA + h * 128 + h4;
#pragma unroll
        for (int mt = 0; mt < 4; ++mt)
#pragma unroll
            for (int rr = 0; rr < 4; ++rr) {
                const int d0 = 32 * mt + 8 * rr;
                const f32x4 z = *reinterpret_cast<const f32x4*>(za + d0);
                const u32x2 o = *reinterpret_cast<const u32x2*>(ST + d0);
                u32x2 wv = {cvt_pk((bflo(o.x) + cf * A.O[mt][4 * rr]) * siluf_(z[0]), (bfhi(o.x) + cf * A.O[mt][4 * rr + 1]) * siluf_(z[1])),
                            cvt_pk((bflo(o.y) + cf * A.O[mt][4 * rr + 2]) * siluf_(z[2]), (bfhi(o.y) + cf * A.O[mt][4 * rr + 3]) * siluf_(z[3]))};
                *reinterpret_cast<u32x2*>(oa + d0) = wv;
                asm volatile("" ::: "memory");
            }
    }
    __syncthreads();
}

DI int gemm_tile_id(int i) {
    const int nb = gridDim.x, nx = nb >> 5;
    if ((nb & 31) != 0) return blockIdx.x + i * nb;
    return ((i * nx + (int)(blockIdx.x % nx)) << 5) + (int)(blockIdx.x / nx);
}
DI void gemm_tile_pos(int u, int ncol, int& pm, int& pn) {
    const int P = u / (2 * ncol), rem = u - P * 2 * ncol;
    pn = rem >> 1; pm = 2 * P + (rem & 1);
}
DI void phase2(const Params& p) {
    char* ws = p.ws;
    const int nb = gridDim.x, bid = blockIdx.x;
    const bool split = nb >= 32;
    if (!split || bid < 16) {
        for (int u = bid; u < 16; u += nb) {
            const int half = u >> 3, slot = (u >> 2) & 1, rt = u & 3;
            EpiStore e{(float*)(ws + WS_CPP) + (long)(half * 2 + slot) * 1024 * 256, 256};
            gemm_tile((const u16*)(ws + WS_KV6) + (long)slot * 1024 * 2048 + half * 2048, 2048,
                      (const u16*)(ws + WS_W1T) + (long)slot * 256 * 4096 + half * 2048, 4096, 2048, rt * 256, 0, e);
        }
    }
    if (!split || bid >= 16) {
        const int rank = split ? bid - 16 : bid, count = split ? nb - 16 : nb;
        gla_prep(p, rank, count);
    }
}
DI int first_item(int start) { const int nb = gridDim.x; return start + (int)((blockIdx.x + nb - start % nb) % nb); }
DI void phase3(const Params& p) {
    char* ws = p.ws;
    for (int it = gridDim.x == 256 ? 256 : first_item(0); it < 256; it += gridDim.x) {
        const int bh = it >> 4, b = bh >> 2, h = bh & 3, chunk = (it & 15) * 8 + (threadIdx.x >> 6);
        rec_prep2<16>((const u16*)(ws + WS_GQT) + (long)bh * 262144, (const u16*)(ws + WS_GKA) + (long)bh * 262144,
                      (const u16*)(ws + WS_GVT) + (long)bh * 128 * 256 * 16, (float*)(ws + WS_GOI) + (long)bh * 128 * 16 * 256, chunk);
    }
    for (int it = first_item(256); it < 512; it += gridDim.x) { const int u = it - 256; attn_sample_item(p, u >> 1, u & 1); }
    {
        const float* cp = (const float*)(ws + WS_CPP);
        const float* hc = (const float*)(ws + WS_HCONST);
        u16* a2 = (u16*)(ws + WS_A2P);
        for (int i = blockIdx.x * 512 + threadIdx.x; i < 2 * 1024 * 64; i += gridDim.x * 512) {
            const int slot = i >> 16, row = (i >> 6) & 1023, c4 = (i & 63) * 4;
            const f32x4 a = *reinterpret_cast<const f32x4*>(cp + ((long)slot * 1024 + row) * 256 + c4);
            const f32x4 b2 = *reinterpret_cast<const f32x4*>(cp + ((long)(2 + slot) * 1024 + row) * 256 + c4);
            const f32x4 h0 = *reinterpret_cast<const f32x4*>(hc + slot * 256 + c4);
            f32x4 o;
#pragma unroll
            for (int j = 0; j < 4; ++j) o[j] = ((row & 127) == 127) ? 0.f : gelu_tanh(a[j] + b2[j] + h0[j]);
            *reinterpret_cast<u32x2*>(a2 + ((long)slot * 1024 + row) * 256 + c4) = pk4(o);
        }
    }
}
DI void phase4(const Params& p) {
    char* ws = p.ws;
    const int w = __builtin_amdgcn_readfirstlane((int)(threadIdx.x >> 6));
    const bool pair = gridDim.x == 256;
    if (threadIdx.x < 2) reinterpret_cast<int*>(smem + RW_OFF + RW_SLOTS * 4096)[threadIdx.x] = 0;
    __syncthreads();
    if (w == 0 || (pair && w == 3)) {
        for (int t0 = blockIdx.x; t0 < 256; t0 += gridDim.x) {
            const int t = (gridDim.x == 256) ? (((t0 & 7) * 2 + (t0 >> 7)) << 4) + ((t0 >> 3) & 15) : t0;
            const int bh = t >> 4, b = bh >> 2, h = bh & 3, vt = t & 15;
            if (!pair)
                rec_walker<16>((const u16*)(ws + WS_GQT) + (long)bh * 262144, (const u16*)(ws + WS_GKST) + (long)bh * 128 * 2048,
                               (const u16*)(ws + WS_GVT) + (long)bh * 128 * 256 * 16, (const u16*)(ws + WS_GDC) + (long)bh * 128 * 128,
                               (const float*)(ws + WS_GOI) + (long)bh * 128 * 16 * 256, vt,
                               (float*)(ws + WS_OB32) + (long)b * 2048 * 1024 + h * 256, 1024, p.out + O_GLAP + (long)bh * 128 * 256, 256);
            else if (w == 0)
                rec_state_wave<16>((const u16*)(ws + WS_GKST) + (long)bh * 128 * 2048, (const u16*)(ws + WS_GVT) + (long)bh * 128 * 256 * 16,
                                   (const u16*)(ws + WS_GDC) + (long)bh * 128 * 128, vt, p.out + O_GLAP + (long)bh * 128 * 256, 256, RW_OFF);
            else
                rec_out_wave<16>((const u16*)(ws + WS_GQT) + (long)bh * 262144, (const u16*)(ws + WS_GKA) + (long)bh * 262144,
                                 (const u16*)(ws + WS_GVT) + (long)bh * 128 * 256 * 16, vt,
                                 (float*)(ws + WS_OB32) + (long)b * 2048 * 1024 + h * 256, 1024, RW_OFF);
        }
    } else {
        if (!(pair && w >= 3))
            for (int it = blockIdx.x + gridDim.x * (w - 1); it < 512; it += gridDim.x * 7)
                gla_sample_wave(p, it >> 2, it & 3, reinterpret_cast<float*>(smem + w * 8192));
    }
    __syncthreads();
    for (int it = first_item(0); it < 8; it += gridDim.x) {
        const int slot = it >> 2, rt = it & 3;
        EpiCmp2P e{(u16*)(ws + WS_KCP), (u16*)(ws + WS_VCTP), slot};
        gemm_tile((const u16*)(ws + WS_A2P) + (long)slot * 1024 * 256, 256, (const u16*)(ws + WS_W2T) + (long)slot * 256 * 256, 256, 256, rt * 256, 0, e);
    }
}
DI void final_norm_rows(const Params& p, int r0, int r1, int parts) {
    const float* x2 = (const float*)(p.ws + (parts > 0 ? WS_X1 : WS_X2));
    const float* pp = (const float*)(p.ws + WS_PROJC);
    const int lane = threadIdx.x & 63, wid = threadIdx.x >> 6;
    for (int row = r0 + blockIdx.x * 8 + wid; row < r1; row += gridDim.x * 8) {
        const float4* x = reinterpret_cast<const float4*>(x2 + (long)row * DM);
        float4* y = reinterpret_cast<float4*>(row < NTP ? p.out + O_YP + (long)row * DM : p.out + O_YS + (long)(row - NTP) * DM);
        float4 v[8]; float ss = 0.f;
#pragma unroll
        for (int i = 0; i < 8; ++i) v[i] = x[lane + 64 * i];
        for (int q4 = 0; q4 < parts; ++q4) {
            const float4* xp = reinterpret_cast<const float4*>(pp + ((long)q4 * NTS + (row - NTP)) * DM);
#pragma unroll
            for (int i = 0; i < 8; ++i) { const float4 a = xp[lane + 64 * i]; v[i].x += a.x; v[i].y += a.y; v[i].z += a.z; v[i].w += a.w; }
        }
#pragma unroll
        for (int i = 0; i < 8; ++i) ss += v[i].x * v[i].x + v[i].y * v[i].y + v[i].z * v[i].z + v[i].w * v[i].w;
        ss = wave_sum(ss);
        const float inv = rsqrtf(ss * (1.f / DM) + 1e-6f);
#pragma unroll
        for (int i = 0; i < 8; ++i) {
            const float4 g = reinterpret_cast<const float4*>(p.final_norm)[lane + 64 * i];
            y[lane + 64 * i] = make_float4(v[i].x * inv * g.x, v[i].y * inv * g.y, v[i].z * inv * g.z, v[i].w * inv * g.w);
        }
    }
}
DI void win_copy_range(const Params& p, int i0, int i1) {
    const int n = 128 * 508 * 128;
    const f32x4* src = reinterpret_cast<const f32x4*>(p.cache_win);
    f32x4* dst = reinterpret_cast<f32x4*>(p.out + O_WINS);
    i1 = min(i1, n);
    for (int ib = i0 + (int)threadIdx.x; ib < i1; ib += 16 * 512) {
        f32x4 v[16];
#pragma unroll
        for (int u = 0; u < 16; ++u) { const int i = min(ib + u * 512, i1 - 1); const int b = i / (508 * 128), r = i - b * (508 * 128); v[u] = src[b * 512 * 128 + 4 * 128 + r]; }
#pragma unroll
        for (int u = 0; u < 16; ++u) { const int i = min(ib + u * 512, i1 - 1); const int b = i / (508 * 128), r = i - b * (508 * 128); dst[b * 512 * 128 + r] = v[u]; }
    }
}
DI int win_w(int x) { return x < 14 ? (int)((0x23345567788867ull >> (4 * x)) & 15) : 0; }
DI int win_wsum(int x) { int s = 0; for (int i = 0; i < x; ++i) s += win_w(i); return s; }
constexpr int WIN_U5 = 79, WIN_UT = 90;
DI void phase5(const Params& p) {
    char* ws = p.ws;
    for (int it = blockIdx.x; it < 256; it += gridDim.x) attn_prompt_item(p, it >> 6, (it >> 5) & 1, it & 31);
    for (int it = blockIdx.x; it < 256; it += gridDim.x) {
        const int x = it & 31;
        if (x >= 2) continue;
        const int j = (it >> 5) * 2 + x;
        EpiRes e{p.x_prompt, p.x_sample, (float*)(ws + WS_X1)};
        gemm_tile((const u16*)(ws + WS_OA), DM, (const u16*)(ws + WS_WOUTA), DM, DM, (32 + (j >> 3)) * 256, (j & 7) * 256, e);
    }
    if (gridDim.x == 256) {
        const int x = blockIdx.x & 31;
        if (x >= 2 && x < 16) gla_norm_gate(p, (blockIdx.x >> 5) * 14 + (x - 2), 112);
        if (win_w(x) > 0) {
            const long n = 128 * 508 * 128, units = 8 * WIN_UT;
            const long u0 = (blockIdx.x >> 5) * WIN_U5 + win_wsum(x), u1 = u0 + win_w(x);
            win_copy_range(p, (int)(n * u0 / units), (int)(n * u1 / units));
        }
    } else {
        gla_norm_gate(p, blockIdx.x, gridDim.x);
    }
}
DI void phase6(const Params& p) {
    char* ws = p.ws;
    for (int t = blockIdx.x; t < 32 * 8; t += gridDim.x) {
        EpiRes e{p.x_prompt, p.x_sample, (float*)(ws + WS_X1)};
        gemm_tile((const u16*)(ws + WS_OA), DM, (const u16*)(ws + WS_WOUTA), DM, DM, (t & 31) * 256, (t >> 5) * 256, e);
    }
    rmsnorm_rows_bf16((const float*)(ws + WS_X1) + (long)NTP * DM, (const float*)(ws + WS_X1) + (long)NTP * DM, NTS, NTS, p.c_norm, (u16*)(ws + WS_H) + (long)NTP * DM, blockIdx.x, gridDim.x);
}
DI EpiInC make_epi_c(const Params& p) {
    char* ws = p.ws;
    return EpiInC{(u16*)(ws + WS_HQT), (u16*)(ws + WS_HKA), (u16*)(ws + WS_HKST), (u16*)(ws + WS_HVT), (u16*)(ws + WS_ZB),
                  (u16*)(ws + WS_HDC), (float*)(ws + WS_PCS), p.c_lb_logits};
}
DI void phase7(const Params& p) {
    char* ws = p.ws;
    for (int t = blockIdx.x; t < 128; t += gridDim.x) {
        const int half = t >> 6, tile = t & 63;
        EpiInC e = make_epi_c(p);
        e.PCS += (long)half * NTS * NC;
        gemm_tile((const u16*)(ws + WS_H) + half * 1024, DM, (const u16*)(ws + WS_WINC) + half * 1024, DM, 1024, (32 + (tile & 1)) * 256, (tile >> 1) * 256, e);
    }
    {
        const int nb = gridDim.x, first = nb > 128 ? 128 : 0, cnt = nb - first;
        if ((int)blockIdx.x >= first) {
            const int rank = blockIdx.x - first;
            rmsnorm_rows_bf16((const float*)(ws + WS_X1), (const float*)(ws + WS_X1), NTP, NTP, p.c_norm, (u16*)(ws + WS_H), rank, cnt);
            const long n = 128 * 508 * 128;
            const long c0 = nb == 256 ? n * (8 * WIN_U5) / (8 * WIN_UT) : 0;
            win_copy_range(p, (int)(c0 + (n - c0) * rank / cnt), (int)(c0 + (n - c0) * (rank + 1) / cnt));
        }
    }
}
DI void phase8(const Params& p) {
    char* ws = p.ws;
    for (int t = blockIdx.x; t < 32 * 32; t += gridDim.x) {
        const EpiInC e = make_epi_c(p);
        gemm_tile((const u16*)(ws + WS_H), DM, (const u16*)(ws + WS_WINC), DM, DM, (t & 31) * 256, (t >> 5) * 256, e);
    }
}
DI void phase9(const Params& p) {
    char* ws = p.ws;
    for (int it = first_item(0); it < 1024; it += gridDim.x) {
        const int bh = it >> 4, b = bh >> 4, h = bh & 15, chunk = (it & 15) * 8 + (threadIdx.x >> 6);
        rec_prep2<8>((const u16*)(ws + WS_HQT) + (long)bh * 262144, (const u16*)(ws + WS_HKA) + (long)bh * 262144,
                     (const u16*)(ws + WS_HVT) + (long)bh * 128 * 128 * 16, (float*)(ws + WS_HOI) + (long)bh * 128 * 8 * 256, chunk);
    }
    if (gridDim.x != 256) hgrn_sample_loop(p, first_item(1024) - 1024, 2048, gridDim.x);
}
DI void phase10(const Params&) {}
DI void phase11(const Params& p) {
    char* ws = p.ws;
    const int nb = gridDim.x, w = __builtin_amdgcn_readfirstlane((int)(threadIdx.x >> 6));
    if (nb == 256) {
        if (threadIdx.x < 4) reinterpret_cast<int*>(smem + RW_OFF + (threadIdx.x >> 1) * RW_PAIR_BYTES + RW_SLOTS * 4096)[threadIdx.x & 1] = 0;
        __syncthreads();
        if (w >= 6) {
            for (int n = 0; n < 4; ++n) hgrn_sample_wave(p, (int)blockIdx.x * 2 + (w - 6) + 512 * n, reinterpret_cast<float*>(smem + (w - 6) * 8192));
        } else if (w != 2 && w != 5) {
            const int ww = w >= 3 ? w - 3 : w;
            const int j = blockIdx.x & 7, local = ((int)blockIdx.x >> 3) + 32 * ww;
            const int t = (j * 8 + (local >> 3)) * 8 + (local & 7);
            const int bh = t >> 3, b = bh >> 4, h = bh & 15, vt = t & 7;
            if (w < 3)
                rec_state_wave<8>((const u16*)(ws + WS_HKST) + (long)bh * 128 * 2048, (const u16*)(ws + WS_HVT) + (long)bh * 128 * 128 * 16,
                                  (const u16*)(ws + WS_HDC) + (long)bh * 128 * 128, vt, p.out + O_HGP + (long)bh * 128 * 128, 128,
                                  RW_OFF + ww * RW_PAIR_BYTES);
            else
                rec_out_wave<8>((const u16*)(ws + WS_HQT) + (long)bh * 262144, (const u16*)(ws + WS_HKA) + (long)bh * 262144,
                                (const u16*)(ws + WS_HVT) + (long)bh * 128 * 128 * 16, vt,
                                (float*)(ws + WS_OC32) + (long)b * 2048 * DM + h * 128, DM, RW_OFF + ww * RW_PAIR_BYTES);
        }
    } else if (nb >= 64) {
        if ((int)blockIdx.x < 16) {
            for (int t = blockIdx.x; t < 16; t += 16) {
                EpiRes e{(const float*)(ws + WS_X1), (const float*)(ws + WS_X1) + (long)NTP * DM, (float*)(ws + WS_X2)};
                gemm_tile((const u16*)(ws + WS_OA), DM, (const u16*)(ws + WS_WOUTC), DM, DM, (32 + (t >> 3)) * 256, (t & 7) * 256, e);
            }
        } else {
            const int nw = nb - 16;
            {
                for (int t0 = (blockIdx.x - 16) + nw * w; t0 < 512; t0 += nw * 8) {
                    const int t = t0;
                    const int bh = t >> 3, b = bh >> 4, h = bh & 15, vt = t & 7;
                    rec_walker<8>((const u16*)(ws + WS_HQT) + (long)bh * 262144, (const u16*)(ws + WS_HKST) + (long)bh * 128 * 2048,
                                  (const u16*)(ws + WS_HVT) + (long)bh * 128 * 128 * 16, (const u16*)(ws + WS_HDC) + (long)bh * 128 * 128,
                                  (const float*)(ws + WS_HOI) + (long)bh * 128 * 8 * 256, vt,
                                  (float*)(ws + WS_OC32) + (long)b * 2048 * DM + h * 128, DM, p.out + O_HGP + (long)bh * 128 * 128, 128);
                }
            }
        }
    } else {
        for (int t = blockIdx.x; t < 16; t += nb) {
            EpiRes e{(const float*)(ws + WS_X1), (const float*)(ws + WS_X1) + (long)NTP * DM, (float*)(ws + WS_X2)};
            gemm_tile((const u16*)(ws + WS_OA), DM, (const u16*)(ws + WS_WOUTC), DM, DM, (32 + (t >> 3)) * 256, (t & 7) * 256, e);
        }
        for (int t = blockIdx.x + nb * w; t < 512; t += nb * 8) {
            const int bh = t >> 3, b = bh >> 4, h = bh & 15, vt = t & 7;
            rec_walker<8>((const u16*)(ws + WS_HQT) + (long)bh * 262144, (const u16*)(ws + WS_HKST) + (long)bh * 128 * 2048,
                          (const u16*)(ws + WS_HVT) + (long)bh * 128 * 128 * 16, (const u16*)(ws + WS_HDC) + (long)bh * 128 * 128,
                          (const float*)(ws + WS_HOI) + (long)bh * 128 * 8 * 256, vt,
                          (float*)(ws + WS_OC32) + (long)b * 2048 * DM + h * 128, DM, p.out + O_HGP + (long)bh * 128 * 128, 128);
        }
    }
}
DI void phase12(const Params& p) {
    char* ws = p.ws;
    if (gridDim.x == 256) {
        if (blockIdx.x < 64) {
            const int q4 = blockIdx.x >> 4, t = blockIdx.x & 15;
            EpiStore e{(float*)(ws + WS_PROJC) + ((long)q4 * NTS - NTP) * DM, DM};
            gemm_tile((const u16*)(ws + WS_OA) + q4 * 512, DM, (const u16*)(ws + WS_WOUTC) + q4 * 512, DM, 512, (32 + (t >> 3)) * 256, (t & 7) * 256, e);
        } else {
            hgrn_norm_gate(p, blockIdx.x - 64, 192);
        }
    } else {
        hgrn_norm_gate(p, blockIdx.x, gridDim.x);
    }
}
DI void phase13(const Params& p) {
    char* ws = p.ws;
    for (int t = blockIdx.x; t < 32 * 8; t += gridDim.x) {
        EpiRes e{(const float*)(ws + WS_X1), (const float*)(ws + WS_X1) + (long)NTP * DM, (float*)(ws + WS_X2)};
        gemm_tile((const u16*)(ws + WS_OA), DM, (const u16*)(ws + WS_WOUTC), DM, DM, (t & 31) * 256, (t >> 5) * 256, e);
    }
    final_norm_rows(p, NTP, NT, gridDim.x == 256 ? 4 : 0);
}
DI void phase14(const Params& p) { final_norm_rows(p, 0, NTP, 0); }

template <int PH> DI void run_phase(const Params& p) {
    if (PH == 0) phase0(p);
    if (PH == 1) phase1(p);
    if (PH == 2) phase2(p);
    if (PH == 3) phase3(p);
    if (PH == 4) phase4(p);
    if (PH == 5) phase5(p);
    if (PH == 6) phase6(p);
    if (PH == 7) phase7(p);
    if (PH == 8) phase8(p);
    if (PH == 9) phase9(p);
    if (PH == 10) phase10(p);
    if (PH == 11) phase11(p);
    if (PH == 12) phase12(p);
    if (PH == 13) phase13(p);
    if (PH == 14) phase14(p);
}

#ifndef MK_MULTI
#define MK_MULTI 0
#endif

#ifndef MK_DUMP_LO
#define MK_DUMP_LO 0
#define MK_DUMP_HI 4096
#endif
#if MK_MULTI
template <int PH> __global__ void __launch_bounds__(512, 2) k_phase(Params p) { run_phase<PH>(p); }
__global__ void k_dump(const float4* src, float4* dst, long n) {
    const u16* s = (const u16*)src; float* d = (float*)dst;
    for (long i = (long)blockIdx.x * blockDim.x + threadIdx.x; i < n; i += (long)gridDim.x * blockDim.x) { float v = bf2f(s[i]); const int col = (int)(i & 2047); if (col < MK_DUMP_LO || col >= MK_DUMP_HI) v = 0.f; d[i] = (fabsf(v) < 1e30f) ? v : 12345.f; } }
#else
__global__ void __launch_bounds__(512, 2) k_forward(Params p) {
    volatile LAS unsigned* xbw = (volatile LAS unsigned*)(smem + LDS_BYTES - 16);
    if (threadIdx.x == 0) { xbw[0] = 0u; xbw[1] = 0u; xbw[2] = 0u; xbw[3] = 0u; }
    __syncthreads();
    XcdBarrier bar = xcd_barrier_post(reinterpret_cast<unsigned*>(p.ws + WS_BAR), xbw);
#ifndef MK_DUP
#define MK_DUP -1
#endif
#define RUN_PH(PH) do { run_phase<PH>(p); if (MK_DUP == PH) { xcd_barrier(bar); run_phase<PH>(p); } } while (0)
    RUN_PH(0);  xcd_barrier(bar);
    RUN_PH(1);  xcd_barrier(bar);
    RUN_PH(2);  xcd_barrier(bar);
    RUN_PH(3);  xcd_barrier(bar);
    RUN_PH(4);  xcd_barrier(bar);
    RUN_PH(5);  xcd_barrier(bar);
    RUN_PH(6);  xcd_barrier(bar);
    RUN_PH(7);  xcd_barrier(bar);
    RUN_PH(8);  xcd_barrier(bar);
    if (gridDim.x != 256) { RUN_PH(9);  xcd_barrier(bar); }
#ifdef DBG_XBAR
    for (int i = 0; i < DBG_XBAR; ++i) xcd_barrier(bar);
#endif
    RUN_PH(11); xcd_barrier(bar);
    RUN_PH(12); xcd_barrier(bar);
    RUN_PH(13); xcd_barrier(bar);
    RUN_PH(14);
}
#endif

extern "C" void kernel_launch(void* const* d_in, const int* in_sizes, int n_in, void* d_out, int out_size, void* d_ws, size_t ws_size,
                              hipStream_t stream) {
    (void)in_sizes; (void)n_in; (void)out_size; (void)ws_size;
    Params p{};
    p.x_prompt = (const float*)d_in[0];  p.x_sample = (const float*)d_in[1];  p.cache_kv = (const float*)d_in[2];
    p.cache_win = (const float*)d_in[3]; p.state_gla = (const float*)d_in[4]; p.state_hgrn = (const float*)d_in[5];
    p.page_table = (const int*)d_in[6];
    p.a_norm = (const float*)d_in[7];    p.a_w_in = (const float*)d_in[8];    p.a_gla_w2 = (const float*)d_in[9];
    p.a_gla_b = (const float*)d_in[10];  p.a_gla_gn = (const float*)d_in[11]; p.a_cmp_pe = (const float*)d_in[12];
    p.a_cmp_w1 = (const float*)d_in[13]; p.a_cmp_b1 = (const float*)d_in[14]; p.a_cmp_w2 = (const float*)d_in[15];
    p.a_w_out = (const float*)d_in[16];  p.c_norm = (const float*)d_in[17];   p.c_w_in = (const float*)d_in[18];
    p.c_lb_logits = (const float*)d_in[19]; p.c_gn = (const float*)d_in[20];  p.c_w_out = (const float*)d_in[21];
    p.final_norm = (const float*)d_in[22];
    p.out = (float*)d_out; p.ws = (char*)d_ws;
    static int grid = 0;
#if MK_MULTI
    if (!grid) {
        int dev = 0, cus = 0; (void)hipGetDevice(&dev); (void)hipDeviceGetAttribute(&cus, hipDeviceAttributeMultiprocessorCount, dev);
        grid = cus > 0 ? cus : 256;
    }
#define LAUNCH_PH(PH) do { (void)hipFuncSetAttribute((const void*)k_phase<PH>, hipFuncAttributeMaxDynamicSharedMemorySize, LDS_BYTES); \
        hipLaunchKernelGGL(k_phase<PH>, dim3(grid), dim3(512), LDS_BYTES, stream, p); } while (0)
#ifndef MK_LAST
#define MK_LAST 14
#endif
#ifndef MK_SKIP
#define MK_SKIP 99
#endif
#define LAUNCH_IF(PH) do { if (PH <= MK_LAST && PH != MK_SKIP) LAUNCH_PH(PH); } while (0)
    LAUNCH_IF(0); LAUNCH_IF(1); LAUNCH_IF(2); LAUNCH_IF(3); LAUNCH_IF(4); LAUNCH_IF(5); LAUNCH_IF(6);
    LAUNCH_IF(7); LAUNCH_IF(8); LAUNCH_IF(9); LAUNCH_IF(10); LAUNCH_IF(11); LAUNCH_IF(12); LAUNCH_IF(13); LAUNCH_IF(14);
#ifdef MK_DUMP_OFF
    hipLaunchKernelGGL(k_dump, dim3(1024), dim3(256), 0, stream, (const float4*)(p.ws + MK_DUMP_OFF), (float4*)p.out, (long)MK_DUMP_N4);
#endif
#else
    if (!grid) {
        int dev = 0, cus = 0, per_cu = 0; (void)hipGetDevice(&dev); (void)hipDeviceGetAttribute(&cus, hipDeviceAttributeMultiprocessorCount, dev);
        (void)hipFuncSetAttribute((const void*)k_forward, hipFuncAttributeMaxDynamicSharedMemorySize, LDS_BYTES);
        (void)hipOccupancyMaxActiveBlocksPerMultiprocessor(&per_cu, (const void*)k_forward, 512, LDS_BYTES);
        if (cus <= 0) cus = 256;
        grid = cus * (per_cu < 1 ? 1 : 1);
    }
    (void)hipMemsetAsync(d_ws, 0, 65536, stream);
    hipLaunchKernelGGL(k_forward, dim3(grid), dim3(512), LDS_BYTES, stream, p);
#endif
}
```

```cpp
#include <hip/hip_runtime.h>
#include <stdint.h>

typedef unsigned short u16;
typedef unsigned int u32;
typedef unsigned long long u64;
using bf16x8 = __attribute__((ext_vector_type(8))) short;
using f32x4  = __attribute__((ext_vector_type(4))) float;
using f32x16 = __attribute__((ext_vector_type(16))) float;
using u32x4  = __attribute__((ext_vector_type(4))) unsigned;
using u32x2  = __attribute__((ext_vector_type(2))) unsigned;
#define DI __device__ __forceinline__

constexpr int DM = 2048, NTP = 8192, NTS = 512, NT = 8704;
constexpr int SEQ = 2048, NB = 4, DB = 128, DSEQ = 4, PAST = 2048;
constexpr int NA = 6696, NAP = 6912, NC = 8192;
constexpr int CQ = 0, CKV = 1024, CZA = 2560, CQB = 3584, CKB = 4096, CVB = 4608, CZB = 5632, CGB = 6656, CLR = 6680;
constexpr float QSCALE = 0.08838834764831845f;
constexpr float QSCALE_L2E = 0.08838834764831845f * 1.4426950408889634f;

constexpr long O_YP = 0, O_YS = 16777216, O_KVP = 17825792, O_KVS = 26214400, O_WINP = 26738688, O_WINS = 27787264,
               O_GLAP = 61341696, O_GLAS = 61865984, O_HGP = 78643200, O_HGS = 79691776;

constexpr size_t AL(size_t x) { return (x + 255) & ~(size_t)255; }
constexpr size_t WS_BAR   = 0;
constexpr size_t WS_WINA  = 65536;
constexpr size_t WS_WOUTA = WS_WINA  + AL((size_t)NAP * DM * 2);
constexpr size_t WS_WINC  = WS_WOUTA + AL((size_t)DM * DM * 2);
constexpr size_t WS_WOUTC = WS_WINC  + AL((size_t)NC * DM * 2);
constexpr size_t WS_W1T   = WS_WOUTC + AL((size_t)DM * DM * 2);
constexpr size_t WS_W2T   = WS_W1T   + AL((size_t)2 * 256 * 4096 * 2);
constexpr size_t WS_HCONST= WS_W2T   + AL((size_t)2 * 256 * 256 * 2);
constexpr size_t WS_H     = WS_HCONST+ AL(2 * 256 * 4);
constexpr size_t WS_XCS   = WS_H     + AL((size_t)NT * DM * 2);
constexpr size_t WS_KV6   = WS_XCS   + AL((size_t)2 * 128 * 2 * 2048 * 128 * 2 + 16384);
constexpr size_t WS_VT    = WS_KV6   + AL((size_t)6 * 4 * 2 * 2048 * 128 * 2 + 16384);
constexpr size_t WS_KF    = WS_VT    + AL((size_t)2 * 4 * 2 * 128 * 2048 * 2 + 16384);
constexpr size_t WS_A2S   = WS_KF    + AL((size_t)2 * 4 * 2 * 128 * 2048 * 2 + 16384);
constexpr size_t WS_A2P   = WS_A2S   + AL((size_t)2 * 32768 * 256 * 2);
constexpr size_t WS_KCS   = WS_A2P   + AL((size_t)2 * 1024 * 256 * 2);
constexpr size_t WS_KCP   = WS_KCS   + AL((size_t)2 * 256 * 128 * 128 * 4);
constexpr size_t WS_VCTP  = WS_KCP   + AL((size_t)8 * 128 * 128 * 2 + 4096);
constexpr size_t WS_PROJ  = WS_VCTP  + AL((size_t)8 * 128 * 128 * 2 + 4096);
constexpr size_t WS_Q     = WS_PROJ  + AL((size_t)NT * NAP * 4);
constexpr size_t WS_GQT   = WS_Q     + AL((size_t)NT * 1024 * 2);
constexpr size_t WS_GKA   = WS_GQT   + AL((size_t)NTP * 512 * 2);
constexpr size_t WS_GKST  = WS_GKA   + AL((size_t)NTP * 512 * 2);
constexpr size_t WS_GVT   = WS_GKST  + AL((size_t)NTP * 512 * 2);
constexpr size_t WS_GDC   = WS_GVT   + AL((size_t)NTP * 1024 * 2);
constexpr size_t WS_GOI   = WS_GDC   + AL((size_t)16 * 128 * 128 * 4);
constexpr size_t WS_OB32  = WS_GOI   + AL((size_t)16 * 128 * 16 * 256 * 4);
constexpr size_t WS_OA    = WS_OB32  + AL((size_t)NTP * 1024 * 4);
constexpr size_t WS_X1    = WS_OA    + AL((size_t)NT * DM * 2);
constexpr size_t WS_PROJC = WS_X1    + AL((size_t)NT * DM * 4);
constexpr size_t WS_HQT   = WS_PROJC + AL((size_t)NT * NC * 4);
constexpr size_t WS_HKA   = WS_HQT   + AL((size_t)NTP * DM * 2);
constexpr size_t WS_HKST  = WS_HKA   + AL((size_t)NTP * DM * 2);
constexpr size_t WS_HVT   = WS_HKST  + AL((size_t)NTP * DM * 2);
constexpr size_t WS_HDC   = WS_HVT   + AL((size_t)NTP * DM * 2);
constexpr size_t WS_HOI   = WS_HDC   + AL((size_t)64 * 128 * 128 * 4);
constexpr size_t WS_OC32  = WS_HOI   + AL((size_t)64 * 128 * 8 * 256 * 4);
constexpr size_t WS_X2    = WS_OC32  + AL((size_t)NTP * DM * 4);
constexpr size_t WS_ZB    = WS_X2    + AL((size_t)NT * DM * 4);
constexpr size_t WS_PCS   = WS_ZB    + AL((size_t)NTP * DM * 2);
constexpr size_t WS_CPP   = WS_PCS   + AL((size_t)2 * NTS * NC * 4);
constexpr size_t WS_END   = WS_CPP   + AL((size_t)4 * 1024 * 256 * 4);

struct Params {
    const float *x_prompt, *x_sample, *cache_kv, *cache_win, *state_gla, *state_hgrn;
    const int* page_table;
    const float *a_norm, *a_w_in, *a_gla_w2, *a_gla_b, *a_gla_gn, *a_cmp_pe, *a_cmp_w1, *a_cmp_b1, *a_cmp_w2, *a_w_out;
    const float *c_norm, *c_w_in, *c_lb_logits, *c_gn, *c_w_out, *final_norm;
    float* out;
    char* ws;
};

extern __shared__ __attribute__((aligned(16))) char smem[];
constexpr int LDS_BYTES = 148480;

typedef float f32x2_t __attribute__((ext_vector_type(2))); typedef __bf16 bf16x2_t __attribute__((ext_vector_type(2)));
DI u32 cvt_pk(float lo, float hi) { f32x2_t v = {lo, hi}; bf16x2_t b = __builtin_convertvector(v, bf16x2_t); return __builtin_bit_cast(u32, b); }
DI u16 f2bf(float x) { return (u16)(cvt_pk(x, 0.f) & 0xffffu); }
DI float bf2f(u16 x) { return __uint_as_float(((u32)x) << 16); }
DI float bflo(u32 w) { return __uint_as_float(w << 16); }
DI float bfhi(u32 w) { return __uint_as_float(w & 0xffff0000u); }
DI float wave_sum(float v) {
#pragma unroll
    for (int o = 32; o >= 1; o >>= 1) v += __shfl_xor(v, o, 64);
    return v;
}
DI float exp2f_(float x) { return __builtin_amdgcn_exp2f(x); }
using f16x2 = __attribute__((ext_vector_type(2))) _Float16;
DI u16 f2h(float x) { const _Float16 h = (_Float16)x; return __builtin_bit_cast(u16, h); }
DI float sigmoidf_(float x) { return 1.f / (1.f + __expf(-x)); }
DI float siluf_(float x) { return x / (1.f + __expf(-x)); }
DI float logsigmoidf_(float x) { return fminf(x, 0.f) - log1pf(__expf(-fabsf(x))); }
DI float gelu_tanh(float x) { const float u = 0.7978845608028654f * (x + 0.044715f * x * x * x); return x / (1.f + __expf(-2.f * u)); }
DI bf16x8 mk8(u32 a, u32 b, u32 c, u32 d) { u32x4 v = {a, b, c, d}; return __builtin_bit_cast(bf16x8, v); }
DI bf16x8 ld8(const u16* p) { return *reinterpret_cast<const bf16x8*>(p); }
DI f32x4 mfma16(bf16x8 a, bf16x8 b, f32x4 c) { return __builtin_amdgcn_mfma_f32_16x16x32_bf16(a, b, c, 0, 0, 0); }
DI f32x16 mfma32(bf16x8 a, bf16x8 b, f32x16 c) { return __builtin_amdgcn_mfma_f32_32x32x16_bf16(a, b, c, 0, 0, 0); }

#define XB_TMO      128
#define XB_XCNT(j)  (256  + 64 * (j))
#define XB_XSUB(j)  (1280 + 64 * (j))
#define XB_XGEN(j)  (2304 + 64 * (j))
#define XB_TOP      3328
#define XB_TOPGEN   3392
#define XCD_BAR_WORDS 3456
#define XB_SPIN_CAP (1u << 18)
#define LAS __attribute__((address_space(3)))

__device__ __forceinline__ unsigned xb_ld(unsigned* p)              { return __hip_atomic_load(p, __ATOMIC_RELAXED, __HIP_MEMORY_SCOPE_AGENT); }
__device__ __forceinline__ unsigned xb_add(unsigned* p, unsigned v) { return __hip_atomic_fetch_add(p, v, __ATOMIC_RELAXED, __HIP_MEMORY_SCOPE_AGENT); }
__device__ __forceinline__ unsigned xb_xcc_id() { return (unsigned)__builtin_amdgcn_s_getreg((3 << 11) | 20) & 0xFu; }
#define XB_SPIN(cond, bar) do { unsigned _sp = 0; while (cond) { __builtin_amdgcn_s_sleep(1); \
    if ((++_sp & 255u) == 0u) { if (xb_ld(&(bar)[XB_TMO])) break; if (_sp > XB_SPIN_CAP) { atomicAdd(&(bar)[XB_TMO], 1u); break; } } } } while (0)

struct XcdBarrier { unsigned* bar; unsigned x; volatile LAS unsigned* st; };

__device__ __forceinline__ XcdBarrier xcd_barrier_post(unsigned* bar, volatile LAS unsigned* st) {
    XcdBarrier b; b.bar = bar; b.x = xb_xcc_id(); b.st = st;
    if (threadIdx.x == 0) (void)xb_add(&bar[XB_XCNT(b.x)], 1u);
    return b;
}
__device__ __forceinline__ void xcd_barrier_complete(unsigned* bar, unsigned x, unsigned& nloc, unsigned& nx) {
    const unsigned G = gridDim.x * gridDim.y * gridDim.z;
    unsigned sum, cnt, mine, sp = 0u;
    for (;;) {
        sum = 0u; cnt = 0u; mine = 0u;
#pragma unroll
        for (unsigned j = 0; j < 16; ++j) { const unsigned c = xb_ld(&bar[XB_XCNT(j)]); sum += c; cnt += (c > 0u) ? 1u : 0u; mine = (j == x) ? c : mine; }
        if (sum == G) break;
        __builtin_amdgcn_s_sleep(1);
        if ((++sp & 255u) == 0u) { if (xb_ld(&bar[XB_TMO])) break; if (sp > XB_SPIN_CAP) { atomicAdd(&bar[XB_TMO], 1u); break; } }
    }
    nloc = mine > 0u ? mine : 1u; nx = cnt > 0u ? cnt : 1u;
}
__device__ __forceinline__ void xcd_barrier(const XcdBarrier& b) {
    asm volatile("s_waitcnt vmcnt(0)" ::: "memory");
    __syncthreads();
    if (threadIdx.x == 0) {
        unsigned* bar = b.bar;
        __builtin_amdgcn_s_waitcnt(0);
        unsigned nloc = b.st[0], nx = b.st[1];
        if (nloc == 0u) { xcd_barrier_complete(bar, b.x, nloc, nx); b.st[0] = nloc; b.st[1] = nx; }
        const unsigned old = xb_add(&bar[XB_XSUB(b.x)], 1u);
        const unsigned gen = old / nloc;
        if (old + 1u == (gen + 1u) * nloc) {
            __builtin_amdgcn_fence(__ATOMIC_RELEASE, "agent");
            asm volatile("s_waitcnt vmcnt(0)" ::: "memory");
            const unsigned og = xb_add(&bar[XB_TOP], 1u);
            const unsigned tg = og / nx;
            if (og + 1u == (tg + 1u) * nx) xb_add(&bar[XB_TOPGEN], 1u);
            else XB_SPIN(xb_ld(&bar[XB_TOPGEN]) == tg, bar);
            __builtin_amdgcn_fence(__ATOMIC_ACQUIRE, "agent");
            xb_add(&bar[XB_XGEN(b.x)], 1u);
            asm volatile("s_waitcnt vmcnt(0)" ::: "memory");
        } else {
            XB_SPIN(xb_ld(&bar[XB_XGEN(b.x)]) == gen, bar);
            __builtin_amdgcn_fence(__ATOMIC_ACQUIRE, "agent");
            asm volatile("s_waitcnt vmcnt(0)" ::: "memory");
        }
    }
    __syncthreads();
}

constexpr int G_BK = 64, G_HALF = 128, G_HT = G_HALF * G_BK;
DI int g_lds_byte(int r, int c) {
    int st = (r >> 4) * 2 + (c >> 5), rr = r & 15, cc = c & 31, ob = rr * 64 + cc * 2;
    return st * 1024 + (ob ^ (((ob >> 9) & 1) << 5));
}
DI void g_stage_rc(int b, int& R, int& C) {
    int st = b / 1024, sb = b % 1024, swz = sb ^ (((sb >> 9) & 1) << 5);
    R = (st >> 1) * 16 + swz / 64; C = (st & 1) * 32 + (swz % 64) / 2;
}

template <class Epi, bool DIRECT = Epi::direct>
DI void gemm_tile(const u16* __restrict__ A, int lda, const u16* __restrict__ Bt, int ldb, int K, int brow, int bcol, const Epi& epi) {
    u16* shm = reinterpret_cast<u16*>(smem);
#define SA(b,h) (shm+((b)*2+(h))*G_HT)
#define SB(b,h) (shm+(4+(b)*2+(h))*G_HT)
#define STAGE_X(T,P,BASE,LD,br,kt,OFF) do{const u16* _gb=(BASE)+((long)(br)*(LD)+(long)(kt)*G_BK); \
    for(int _i=0;_i<2;++_i){int _b=(T)*16+_i*8192; \
      __builtin_amdgcn_global_load_lds((const unsigned*)(_gb+OFF[_i]), \
        (unsigned*)((char*)(P)+_b),16,0,0);}}while(0)
#define STAGEA(P,br,kt) STAGE_X(t0,P,A,lda,br,kt,offA)
#define STAGEB(P,br,kt) STAGE_X(t0,P,Bt,ldb,br,kt,offB)
#define MKOFF(T) do{for(int _i=0;_i<2;++_i){int _r,_c;g_stage_rc((T)*16+_i*8192,_r,_c);offA[_i]=_r*lda+_c;offB[_i]=_r*ldb+_c;}}while(0)
#define LDA(dst,b,h) for(int m=0;m<4;++m)for(int k=0;k<2;++k) \
    dst[m][k]=*reinterpret_cast<const bf16x8*>((char*)SA(b,h)+g_lds_byte(wr*64+m*16+fr,k*32+fq*8))
#define LDB(dst,b,h) for(int n=0;n<2;++n)for(int k=0;k<2;++k) \
    dst[n][k]=*reinterpret_cast<const bf16x8*>((char*)SB(b,h)+g_lds_byte(wc*32+n*16+fr,k*32+fq*8))
#define MMA(ai,bj,At,Bx) do{__builtin_amdgcn_s_setprio(1); \
    for(int m=0;m<4;++m)for(int n=0;n<2;++n)for(int k=0;k<2;++k) \
      acc[ai][bj][m][n]=DIRECT?__builtin_amdgcn_mfma_f32_16x16x32_bf16(Bx[n][k],At[m][k],acc[ai][bj][m][n],0,0,0) \
                                    :__builtin_amdgcn_mfma_f32_16x16x32_bf16(At[m][k],Bx[n][k],acc[ai][bj][m][n],0,0,0); \
    __builtin_amdgcn_s_setprio(0);}while(0)
#define WAIT_V(n) asm volatile("s_waitcnt vmcnt(" #n ")":::"memory")
#define WAIT_L(n) asm volatile("s_waitcnt lgkmcnt(" #n ")":::"memory")
#define BAR __builtin_amdgcn_s_barrier()
#define SCHED __builtin_amdgcn_sched_barrier(0)
    int t0 = threadIdx.x; asm volatile("" : "+v"(t0));
    int wid = t0 >> 6, lane = t0 & 63, wr = wid >> 2, wc = wid & 3, fr = lane & 15, fq = lane >> 4;
    f32x4 acc[2][2][4][2] = {};
    bf16x8 At[4][2], B0[2][2], B1[2][2];
    const int nt = K / G_BK;
    int offA[2], offB[2];
    MKOFF(t0);
    WAIT_V(0);
    STAGEB(SB(0,0),bcol,0); STAGEA(SA(0,0),brow,0);
    STAGEB(SB(0,1),bcol+G_HALF,0); STAGEA(SA(0,1),brow+G_HALF,0);
    if(wr==1)BAR;
    WAIT_V(4); BAR;
    STAGEB(SB(1,0),bcol,1); STAGEA(SA(1,0),brow,1); STAGEB(SB(1,1),bcol+G_HALF,1);
    WAIT_V(6); BAR;
    for(int t=0;t<nt-2;t+=2){
      LDB(B0,0,0); SCHED; LDA(At,0,0); STAGEA(SA(1,1),brow+G_HALF,t+1);
      WAIT_L(8); BAR; WAIT_L(0); MMA(0,0,At,B0); BAR; SCHED;
      LDB(B1,0,1); STAGEB(SB(0,0),bcol,t+2);
      BAR; WAIT_L(0); MMA(0,1,At,B1); BAR;
      LDA(At,0,1); STAGEA(SA(0,0),brow,t+2);
      BAR; WAIT_L(0); MMA(1,0,At,B0); BAR; SCHED;
      STAGEB(SB(0,1),bcol+G_HALF,t+2);
      WAIT_V(6); BAR; MMA(1,1,At,B1); BAR;
      LDB(B0,1,0); SCHED; LDA(At,1,0); STAGEA(SA(0,1),brow+G_HALF,t+2);
      WAIT_L(8); BAR; WAIT_L(0); MMA(0,0,At,B0); BAR; SCHED;
      LDB(B1,1,1); STAGEB(SB(1,0),bcol,t+3);
      BAR; WAIT_L(0); MMA(0,1,At,B1); BAR;
      LDA(At,1,1); STAGEA(SA(1,0),brow,t+3);
      BAR; WAIT_L(0); MMA(1,0,At,B0); BAR; SCHED;
      STAGEB(SB(1,1),bcol+G_HALF,t+3);
      WAIT_V(6); BAR; MMA(1,1,At,B1); BAR;
    }
    int tz=t0; asm volatile("":"+v"(tz)); wid=tz>>6; lane=tz&63; wr=wid>>2; wc=wid&3; fr=lane&15; fq=lane>>4;
    MKOFF(tz);
    { LDB(B0,0,0); WAIT_V(0); LDA(At,0,0); STAGE_X(tz,SA(1,1),A,lda,brow+G_HALF,nt-1,offA);
      BAR; WAIT_L(0); MMA(0,0,At,B0); BAR;
      LDB(B1,0,1); BAR; WAIT_L(0); MMA(0,1,At,B1); BAR;
      LDA(At,0,1); WAIT_V(4); BAR; WAIT_L(0); MMA(1,0,At,B0); MMA(1,1,At,B1); BAR; }
    { LDB(B0,1,0); LDA(At,1,0); WAIT_V(2); BAR; WAIT_L(0); MMA(0,0,At,B0); BAR;
      LDB(B1,1,1); WAIT_V(0); BAR; WAIT_L(0); MMA(0,1,At,B1); BAR;
      LDA(At,1,1); BAR; WAIT_L(0); MMA(1,0,At,B0); MMA(1,1,At,B1); BAR; }
    if(wr==0)BAR;
    if (DIRECT) {
#pragma unroll
        for (int ai = 0; ai < 2; ++ai)
#pragma unroll
            for (int bj = 0; bj < 2; ++bj)
#pragma unroll
                for (int m = 0; m < 4; ++m)
#pragma unroll
                    for (int n = 0; n < 2; ++n)
                        epi.row4(brow + ai * G_HALF + wr * 64 + m * 16 + fr, bcol + bj * G_HALF + wc * 32 + n * 16 + fq * 4, acc[ai][bj][m][n]);
        __syncthreads();
    } else
    {
        float* Cs = reinterpret_cast<float*>(smem);
        const bool cm = epi.colmode(brow, bcol), tm = epi.tilemode(brow, bcol);
#pragma unroll
        for (int ai = 0; ai < 2; ++ai) {
#pragma unroll
            for (int bj = 0; bj < 2; ++bj)
#pragma unroll
                for (int m = 0; m < 4; ++m)
#pragma unroll
                    for (int n = 0; n < 2; ++n)
#pragma unroll
                        for (int j = 0; j < 4; ++j)
                            Cs[(wr * 64 + m * 16 + fq * 4 + j) * 256 + bj * G_HALF + wc * 32 + n * 16 + fr] = acc[ai][bj][m][n][j];
            __syncthreads();
            if (tm) {
                epi.tile(Cs, brow + ai * G_HALF, bcol, tz);
            } else if (cm) {
#pragma unroll 4
                for (int i = 0; i < 16; ++i) {
                    const int idx = i * 512 + tz, col = idx & 255, rg = idx >> 8;
                    f32x4 v;
                    v[0] = Cs[(rg * 4 + 0) * 256 + col]; v[1] = Cs[(rg * 4 + 1) * 256 + col]; v[2] = Cs[(rg * 4 + 2) * 256 + col]; v[3] = Cs[(rg * 4 + 3) * 256 + col];
                    epi.col4(brow + ai * G_HALF + rg * 4, bcol + col, v);
                }
            } else {
#pragma unroll 4
                for (int i = 0; i < 16; ++i) {
                    const int idx = i * 512 + tz, row = idx >> 6, c4 = (idx & 63) * 4;
                    epi.row4(brow + ai * G_HALF + row, bcol + c4, *reinterpret_cast<const f32x4*>(Cs + row * 256 + c4));
                }
            }
            __syncthreads();
        }
    }
#undef SA
#undef SB
#undef STAGE_X
#undef STAGEA
#undef STAGEB
#undef MKOFF
#undef LDA
#undef LDB
#undef MMA
}

DI u32x2 pk4(f32x4 v) { u32x2 w = {cvt_pk(v[0], v[1]), cvt_pk(v[2], v[3])}; return w; }
struct EpiInA {
    float* proj; u16* Q; u16* KV6; u16* VT; u16* KF; float* out;
    static constexpr bool direct = false;
    DI bool tilemode(int, int) const { return false; }
    DI void tile(const float*, int, int, int) const {}
    DI bool colmode(int brow, int bcol) const { const int slot = (bcol - CKV) >> 8; return brow < NTP && bcol >= CKV && (slot == 3 || slot == 5); }
    DI void row4(int row, int col0, f32x4 v) const {
        if (col0 < CKV) {
            *reinterpret_cast<u32x2*>(Q + row * 1024 + col0) = pk4(v * QSCALE_L2E);
        } else if (col0 < CZA) {
            const int c1 = col0 - CKV, slot = c1 >> 8, g = (c1 >> 7) & 1, d = c1 & 127;
            if (row < NTP) {
                const int b = row >> 11, t = row & 2047;
                if (slot < 2) {
                    *reinterpret_cast<u32x2*>(KV6 + ((((slot * 4 + b) * 2 + g) * 2048 + t) * 128 + d)) = pk4(v);
                } else {
                    const int which = slot == 4 ? 1 : 0;
                    *reinterpret_cast<u32x2*>(KF + ((((which * 4 + b) * 2 + g) * 64 + (t >> 5)) * 4096 + (d >> 4) * 512 + (((d >> 3) & 1) * 32 + (t & 31)) * 8 + (d & 7))) = pk4(v);
                }
                if (c1 < 1024) *reinterpret_cast<f32x4*>(out + O_KVP + row * 1024 + c1) = v;
                else if (t >= 1536) *reinterpret_cast<f32x4*>(out + O_WINP + (b * 512 + t - 1536) * 512 + (c1 - 1024)) = v;
            } else {
                const int rr = row - NTP, b = rr >> 2, t = rr & 3;
                if (c1 < 1024) *reinterpret_cast<f32x4*>(out + O_KVS + rr * 1024 + c1) = v;
                else *reinterpret_cast<f32x4*>(out + O_WINS + (b * 512 + 508 + t) * 512 + (c1 - 1024)) = v;
                *reinterpret_cast<f32x4*>(proj + (long)row * NAP + col0) = v;
            }
        } else {
            *reinterpret_cast<f32x4*>(proj + (long)row * NAP + col0) = v;
        }
    }
    DI void col4(int row0, int col, f32x4 v) const {
        const int c1 = col - CKV, slot = c1 >> 8, g = (c1 >> 7) & 1, d = c1 & 127;
        const int b = row0 >> 11, t = row0 & 2047;
        {
            const int which = slot == 5 ? 1 : 0, r = t & 31, kk = r & 15;
            *reinterpret_cast<u32x2*>(VT + (((((which * 4 + b) * 2 + g) * 64 + (t >> 5)) * 8 + (r >> 4) * 4 + (d >> 5)) * 512 + (((kk >> 2) & 1) * 32 + (d & 31)) * 8 + (kk >> 3) * 4)) = pk4(v);
        }
        if (c1 < 1024) {
#pragma unroll
            for (int j = 0; j < 4; ++j) out[O_KVP + (row0 + j) * 1024 + c1] = v[j];
        } else if (t >= 1536) {
#pragma unroll
            for (int j = 0; j < 4; ++j) out[O_WINP + (b * 512 + t + j - 1536) * 512 + (c1 - 1024)] = v[j];
        }
    }
};
struct EpiCmp1 {
    const float* hc; u16* A2;
    static constexpr bool direct = false;
    DI bool tilemode(int, int) const { return false; }
    DI void tile(const float*, int, int, int) const {}
    DI bool colmode(int, int) const { return false; }
    DI void col4(int, int, f32x4) const {}
    DI void row4(int row, int col0, f32x4 v) const {
        const f32x4 h0 = *reinterpret_cast<const f32x4*>(hc + col0);
        f32x4 o;
#pragma unroll
        for (int j = 0; j < 4; ++j) o[j] = ((row & 127) == 127) ? 0.f : gelu_tanh(v[j] + h0[j]);
        *reinterpret_cast<u32x2*>(A2 + row * 256 + col0) = pk4(o);
    }
};
struct EpiCmp2S {
    float* dst;
    static constexpr bool direct = true;
    DI bool tilemode(int, int) const { return false; }
    DI void tile(const float*, int, int, int) const {}
    DI bool colmode(int, int) const { return false; }
    DI void col4(int, int, f32x4) const {}
    DI void row4(int row, int col0, f32x4 v) const { if (col0 < 128) *reinterpret_cast<f32x4*>(dst + row * 128 + col0) = v; }
};
struct EpiCmp2P {
    u16* kc; u16* vct; int slot;
    static constexpr bool direct = false;
    DI bool tilemode(int, int) const { return false; }
    DI void tile(const float*, int, int, int) const {}
    DI bool colmode(int, int) const { return slot == 1; }
    DI void row4(int row, int col0, f32x4 v) const { if (col0 < 128) *reinterpret_cast<u32x2*>(kc + row * 128 + col0) = pk4(v); }
    DI void col4(int row0, int col, f32x4 v) const {
        if (col < 128) { const int bg = row0 >> 7, c = row0 & 127; *reinterpret_cast<u32x2*>(vct + (bg * 128 + col) * 128 + c) = pk4(v); }
    }
};
struct EpiRes {
    const float* rp; const float* rs; float* dst;
    static constexpr bool direct = true;
    DI bool tilemode(int, int) const { return false; }
    DI void tile(const float*, int, int, int) const {}
    DI bool colmode(int, int) const { return false; }
    DI void col4(int, int, f32x4) const {}
    DI void row4(int row, int col0, f32x4 v) const {
        const f32x4 r = row < NTP ? *reinterpret_cast<const f32x4*>(rp + row * DM + col0) : *reinterpret_cast<const f32x4*>(rs + (row - NTP) * DM + col0);
        *reinterpret_cast<f32x4*>(dst + row * DM + col0) = v + r;
    }
};
struct EpiStore {
    float* dst; int ld;
    static constexpr bool direct = true;
    DI bool tilemode(int, int) const { return false; }
    DI void tile(const float*, int, int, int) const {}
    DI bool colmode(int, int) const { return false; }
    DI void col4(int, int, f32x4) const {}
    DI void row4(int row, int col0, f32x4 v) const { *reinterpret_cast<f32x4*>(dst + (long)row * ld + col0) = v; }
};

struct EpiInC {
    u16 *QT, *KA, *KST, *VT, *ZB, *DC; float *PCS; const float* lbl;
    DI bool colmode(int, int) const { return false; }
    DI void col4(int, int, f32x4) const {}
    static constexpr bool direct = false;
    DI bool tilemode(int brow, int) const { return brow < NTP; }
    DI void row4(int row, int col0, f32x4 v) const {
        const int T = col0 >> 8, cc = col0 & 255;
        *reinterpret_cast<f32x4*>(PCS + (long)(row - NTP) * NC + (cc >> 6) * 2048 + 64 * T + (cc & 63)) = v;
    }
    DI void tile(const float* Cs, int row0, int bcol, int tid) const {
        const int ck = tid >> 6, ch = tid & 63, T = bcol >> 8;
        const int gc = 64 * T + ch, h = T >> 1, kch = gc & 127;
        const int tok0 = row0 + ck * 16, b = tok0 >> 11, chunk = (tok0 & 2047) >> 4, bh = b * 16 + h;
        const float* cs = Cs + (ck * 16) * 256 + ch;
        const float lb = sigmoidf_(lbl[2048 + gc] - lbl[gc]);
        float bc[16], kk[16]; float bs = 0.f;
#pragma unroll
        for (int t = 0; t < 16; ++t) {
            const float fr = cs[t * 256 + 64];
            const float sg = 1.f / (1.f + __expf(-fr)), sn = 1.f / (1.f + __expf(fr));
            bs += __logf(lb + (1.f - lb) * sg);
            bc[t] = bs;
            kk[t] = (1.f - lb) * sn;
        }
        u32 kw[8], vw[8];
#pragma unroll
        for (int t = 0; t < 16; t += 2) {
            float ks[2];
#pragma unroll
            for (int u = 0; u < 2; ++u) {
                const float qv = siluf_(cs[(t + u) * 256]);
                const int fo = ((bh * 128 + chunk) * 4 + ((kch >> 3) & 3)) * 512 + ((kch >> 5) * 16 + t + u) * 8 + (kch & 7);
                QT[fo] = f2bf(qv * __expf(bc[t + u]));
                KA[fo] = f2bf(kk[t + u] * __expf(-bc[t + u]));
                ZB[(tok0 + t + u) * DM + gc] = f2bf(cs[(t + u) * 256 + 192]);
                ks[u] = kk[t + u] * __expf(bs - bc[t + u]);
            }
            kw[t >> 1] = cvt_pk(ks[0], ks[1]);
            vw[t >> 1] = cvt_pk(cs[t * 256 + 128], cs[(t + 1) * 256 + 128]);
        }
        const int o16 = ((bh * 128 + chunk) * 128 + kch) * 16;
        {
            u16* kd = KST + (((bh * 128 + chunk) * 4 + ((kch & 7) >> 1)) * 64 + (kch >> 3)) * 8 + (kch & 1) * 4;
#pragma unroll
            for (int qq = 0; qq < 4; ++qq) { u32x2 w2 = {kw[2 * qq], kw[2 * qq + 1]}; *reinterpret_cast<u32x2*>(kd + qq * 128) = w2; }
        }
        u32x4 a0 = {vw[0], vw[1], vw[2], vw[3]}, a1 = {vw[4], vw[5], vw[6], vw[7]};
        reinterpret_cast<u32x4*>(VT + o16)[0] = a0; reinterpret_cast<u32x4*>(VT + o16)[1] = a1;
        DC[(bh * 128 + chunk) * 128 + kch] = f2bf(__expf(bs));
    }
};

DI int mapA(int n) {
    if (n < 2560) return n;
    if (n < 3584) return n - 2560 + 2584;
    if (n < 4096) return n - 3584 + 3608;
    if (n < 4608) return n - 4096 + 4120;
    if (n < 5632) return n - 4608 + 4632;
    if (n < 6656) return n - 5632 + 5672;
    if (n < 6680) return n - 6656 + 2560;
    if (n < 6696) return n - 6680 + 5656;
    return -1;
}
template <int MODE>
DI void tr_tile(const float* __restrict__ src, int lds_, u16* __restrict__ dst, int ldd, int n0, int k0) {
    float* t = reinterpret_cast<float*>(smem);
    int tid = threadIdx.x; asm volatile("" : "+v"(tid));
    {
        const int nn = tid & 63, n = n0 + nn;
        int sc = n;
        if (MODE == 1) sc = mapA(n);
        if (MODE == 2) sc = n < 128 ? n : -1;
        if (MODE == 3) sc = ((n & 255) >> 6) * 2048 + 64 * (n >> 8) + (n & 63);
        float v[32];
#pragma unroll
        for (int i = 0; i < 32; ++i) v[i] = sc >= 0 ? src[(long)(k0 + i * 8 + (tid >> 6)) * lds_ + sc] : 0.f;
#pragma unroll
        for (int i = 0; i < 32; ++i) t[nn * 257 + i * 8 + (tid >> 6)] = v[i];
    }
    __syncthreads();
#pragma unroll
    for (int j = 0; j < 4; ++j) {
        const int nn = tid >> 3, k8 = (tid & 7) * 8 + j * 64;
        const float* r = t + nn * 257 + k8;
        u32x4 w = {cvt_pk(r[0], r[1]), cvt_pk(r[2], r[3]), cvt_pk(r[4], r[5]), cvt_pk(r[6], r[7])};
        *reinterpret_cast<u32x4*>(dst + (long)(n0 + nn) * ldd + k0 + k8) = w;
    }
    __syncthreads();
}

DI void rmsnorm_rows_bf16(const float* __restrict__ xa, const float* __restrict__ xb, int nsplit, int nrows,
                          const float* __restrict__ w, u16* __restrict__ dst, int rank, int count) {
    const int lane = threadIdx.x & 63, wid = threadIdx.x >> 6;
    for (int row = rank * 8 + wid; row < nrows; row += count * 8) {
        const float4* x = reinterpret_cast<const float4*>(row < nsplit ? xa + (long)row * DM : xb + (long)(row - nsplit) * DM);
        float4 v[8]; float ss = 0.f;
#pragma unroll
        for (int i = 0; i < 8; ++i) { v[i] = x[lane + 64 * i]; ss += v[i].x * v[i].x + v[i].y * v[i].y + v[i].z * v[i].z + v[i].w * v[i].w; }
        ss = wave_sum(ss);
        const float inv = rsqrtf(ss * (1.f / DM) + 1e-6f);
#pragma unroll
        for (int i = 0; i < 8; ++i) {
            const float4 g = reinterpret_cast<const float4*>(w)[lane + 64 * i];
            u32x2 o = {cvt_pk(v[i].x * inv * g.x, v[i].y * inv * g.y), cvt_pk(v[i].z * inv * g.z, v[i].w * inv * g.w)};
            *reinterpret_cast<u32x2*>(dst + (long)row * DM + (lane + 64 * i) * 4) = o;
        }
    }
}

constexpr int TRD1 = 32 * 8, TRD2 = TRD1 + 128 * 8, TRD3 = TRD2 + 32 * 8;
DI void tr_deferred(const Params& p, int t) {
    char* ws = p.ws;
    if (t < TRD1)      { tr_tile<0>(p.a_w_out, DM, (u16*)(ws + WS_WOUTA), DM, (t >> 3) * 64, (t & 7) * 256); }
    else if (t < TRD2) { const int u = t - TRD1; tr_tile<3>(p.c_w_in, NC, (u16*)(ws + WS_WINC), DM, (u >> 3) * 64, (u & 7) * 256); }
    else               { const int u = t - TRD2; tr_tile<0>(p.c_w_out, DM, (u16*)(ws + WS_WOUTC), DM, (u >> 3) * 64, (u & 7) * 256); }
}

DI void phase0(const Params& p) {
    const int tid = threadIdx.x, bid = blockIdx.x, nb = gridDim.x;
    char* ws = p.ws;
    {
        constexpr int T0 = (NAP / 64) * 8, T4 = T0 + 2 * 4 * 16, T5 = T4 + 2 * 4;
        for (int t = bid; t < T5; t += nb) {
            if (t < T0)      { tr_tile<1>(p.a_w_in, NA, (u16*)(ws + WS_WINA), DM, (t >> 3) * 64, (t & 7) * 256); }
            else if (t < T4) { const int u = t - T0, s = u >> 6, v = u & 63;
                               tr_tile<0>(p.a_cmp_w1 + (long)s * 4096 * 256, 256, (u16*)(ws + WS_W1T) + (long)s * 256 * 4096, 4096, (v >> 4) * 64, (v & 15) * 256); }
            else             { const int u = t - T4, s = u >> 2, v = u & 3;
                               tr_tile<2>(p.a_cmp_w2 + (long)s * 256 * 128, 128, (u16*)(ws + WS_W2T) + (long)s * 256 * 256, 256, v * 64, 0); }
        }
    }
    if (nb < 16) rmsnorm_rows_bf16(p.x_prompt, p.x_sample, NTP, NT, p.a_norm, (u16*)(ws + WS_H), bid, nb);
    else if (bid < nb - 8) rmsnorm_rows_bf16(p.x_prompt, p.x_sample, NTP, NT, p.a_norm, (u16*)(ws + WS_H), bid, nb - 8);
    for (int it = nb >= 16 ? bid - (nb - 8) : bid; it >= 0 && it < 8; it += nb) {
        const int slot = it >> 2, e4 = (it & 3) * 64 + (tid & 15) * 4, kg = tid >> 4;
        const float* w1 = p.a_cmp_w1 + (long)slot * 4096 * 256 + e4;
        const float* pe = p.a_cmp_pe + slot * 4096;
        f32x4 s = {0.f, 0.f, 0.f, 0.f};
        for (int k0 = kg; k0 < 4096; k0 += 32 * 8) {
            f32x4 wv[8]; float pv[8];
#pragma unroll
            for (int u = 0; u < 8; ++u) { wv[u] = *reinterpret_cast<const f32x4*>(w1 + (long)(k0 + 32 * u) * 256); pv[u] = pe[k0 + 32 * u]; }
#pragma unroll
            for (int u = 0; u < 8; ++u) s += wv[u] * pv[u];
        }
        f32x4* red = reinterpret_cast<f32x4*>(smem);
        red[tid] = s;
        __syncthreads();
        if (tid < 16) {
            f32x4 a = {0.f, 0.f, 0.f, 0.f};
            for (int j = 0; j < 32; ++j) a += red[j * 16 + tid];
            const f32x4 b1 = *reinterpret_cast<const f32x4*>(p.a_cmp_b1 + slot * 256 + e4);
            *reinterpret_cast<f32x4*>(reinterpret_cast<float*>(ws + WS_HCONST) + slot * 256 + e4) = a + b1;
        }
        __syncthreads();
    }
}

template <int KS> DI int lds_byte_ks(int r, int c) {
    int st = (r >> 4) * KS + (c >> 5), ob = (r & 15) * 64 + (c & 31) * 2;
    return st * 1024 + (ob ^ (((ob >> 9) & 1) << 5));
}
DI void cmp_gemm_tile(const Params& p, int slot, int bg) {
    char* ws = p.ws;
    constexpr int TA = 128 * 32 * 4, TB = 512 * 32 * 2, NA = 5, B_OFF = NA * TA;
    int tid = threadIdx.x; asm volatile("" : "+v"(tid));
    const int wid = __builtin_amdgcn_readfirstlane(tid >> 6), lane = tid & 63, wr = wid >> 2, wc = wid & 3, fr = lane & 15, fq = lane >> 4;
    const int b = bg >> 1, g = bg & 1;
    const bool awave = wid < 4;
    const int t4 = tid & 255;
    int aoff[4];
#pragma unroll
    for (int i = 0; i < 4; ++i) {
        const int n = 32 * i + (t4 >> 3), sl = (t4 & 7) ^ (((n & 1) << 1) | ((n >> 1) & 1) | (n & 4));
        aoff[i] = (p.page_table[b * 16 + (n >> 3)] * 128 + 16 * (n & 7)) * 1024 + slot * 256 + g * 128 + sl * 4;
    }
    const u16* Bb = (const u16*)(ws + WS_W1T) + (long)slot * 256 * 4096;
    int boff[8];
#pragma unroll
    for (int i = 0; i < 8; ++i) {
        const int bb = (wid & 3) * 1024 + i * 4096 + lane * 16, st = bb >> 10, sb = bb & 1023, swz = sb ^ (((sb >> 9) & 1) << 5);
        const int R = st * 16 + swz / 64, C = (swz % 64) / 2;
        boff[i] = (R & 255) * 4096 + (R >> 8) * 2048 + C;
    }
    auto issue_a = [&](int kt) {
        char* l = smem + (kt % NA) * TA;
        const int o = (kt >> 2) * 1024 + (kt & 3) * 32;
#pragma unroll
        for (int i = 0; i < 4; ++i) __builtin_amdgcn_global_load_lds((const unsigned*)(p.cache_kv + aoff[i] + o), (unsigned*)(l + (i * 256 + t4) * 16), 16, 0, 0);
    };
    auto issue_b = [&](int kt) {
        char* l = smem + B_OFF + (kt & 1) * TB;
#pragma unroll
        for (int i = 0; i < 8; ++i) __builtin_amdgcn_global_load_lds((const unsigned*)(Bb + boff[i] + kt * 32), (unsigned*)(l + (wid & 3) * 1024 + i * 4096 + lane * 16), 16, 0, 0);
    };
    f32x4 acc[4][8];
#pragma unroll
    for (int m = 0; m < 4; ++m)
#pragma unroll
        for (int n = 0; n < 8; ++n) acc[m][n] = (f32x4){0.f, 0.f, 0.f, 0.f};
    constexpr int nt = 64;
    if (awave) { issue_a(0); issue_a(1); issue_a(2); issue_a(3); } else { issue_b(0); }
    for (int t = 0; t < nt; ++t) {
        if (awave) {
            const int rem = nt - t;
            if (rem >= 4) asm volatile("s_waitcnt vmcnt(12)" ::: "memory");
            else if (rem == 3) asm volatile("s_waitcnt vmcnt(8)" ::: "memory");
            else if (rem == 2) asm volatile("s_waitcnt vmcnt(4)" ::: "memory");
            else asm volatile("s_waitcnt vmcnt(0)" ::: "memory");
        } else {
            asm volatile("s_waitcnt vmcnt(0)" ::: "memory");
        }
        __builtin_amdgcn_s_barrier();
        if (awave) { if (t + 4 < nt) issue_a(t + 4); } else { if (t + 1 < nt) issue_b(t + 1); }
        const char* sA = smem + (t % NA) * TA; const char* sB = smem + B_OFF + (t & 1) * TB;
        bf16x8 At[4];
#pragma unroll
        for (int m = 0; m < 4; ++m) {
            const char* ra = sA + (wr * 64 + m * 16 + fr) * 128;
            const int sg = ((fr & 1) << 1) | ((fr >> 1) & 1) | (fr & 4);
            const f32x4 x0 = *reinterpret_cast<const f32x4*>(ra + (((2 * fq) ^ sg) << 4));
            const f32x4 x1 = *reinterpret_cast<const f32x4*>(ra + (((2 * fq + 1) ^ sg) << 4));
            At[m] = mk8(cvt_pk(x0[0], x0[1]), cvt_pk(x0[2], x0[3]), cvt_pk(x1[0], x1[1]), cvt_pk(x1[2], x1[3]));
        }
#pragma unroll
        for (int nh = 0; nh < 2; ++nh) {
            bf16x8 Bf[4];
#pragma unroll
            for (int n = 0; n < 4; ++n) Bf[n] = *reinterpret_cast<const bf16x8*>(sB + lds_byte_ks<1>(wc * 128 + (nh * 4 + n) * 16 + fr, fq * 8));
#pragma unroll
            for (int m = 0; m < 4; ++m)
#pragma unroll
                for (int n = 0; n < 4; ++n) acc[m][nh * 4 + n] = mfma16(At[m], Bf[n], acc[m][nh * 4 + n]);
        }
    }
    __syncthreads();
    float* Cs = reinterpret_cast<float*>(smem);
    if (wc >= 2) {
#pragma unroll
        for (int m = 0; m < 4; ++m)
#pragma unroll
            for (int n = 0; n < 8; ++n)
#pragma unroll
                for (int j = 0; j < 4; ++j) Cs[(wr * 64 + m * 16 + fq * 4 + j) * 256 + (wc - 2) * 128 + n * 16 + fr] = acc[m][n][j];
    }
    __syncthreads();
    if (wc < 2) {
        const float* hc = reinterpret_cast<const float*>(ws + WS_HCONST) + slot * 256;
        u16* A2 = (u16*)(ws + WS_A2S) + ((long)slot * 32768 + bg * 128) * 256;
#pragma unroll
        for (int n = 0; n < 8; ++n) {
            const int col = wc * 128 + n * 16 + fr;
            const float h0 = hc[col];
#pragma unroll
            for (int m = 0; m < 4; ++m)
#pragma unroll
                for (int j = 0; j < 4; ++j) {
                    const int row = wr * 64 + m * 16 + fq * 4 + j;
                    const float u1 = Cs[min(row + 1, 127) * 256 + col];
                    A2[row * 256 + col] = (row == 127) ? (u16)0 : f2bf(gelu_tanh(acc[m][n][j] + u1 + h0));
                    asm volatile("" ::: "memory");
                }
        }
    }
    asm volatile("s_waitcnt vmcnt(0)" ::: "memory");
    __syncthreads();
}
DI void phase1(const Params& p) {
    char* ws = p.ws;
    const int nb = gridDim.x, bid = blockIdx.x;
    const int n_full = (34 * 27 - 1 - bid) / nb + 1;
    const int n_cmp = bid < 256 ? (256 - 1 - bid) / nb + 1 : 0;
    const int cmp_at = (bid & 1) ? n_full : 0;
    int n_in = 0, n_c = 0;
#if defined(DBG_DUP1A) || defined(DBG_DUP1B) || defined(DBG_DUP1C)
    for (int rep = 0; rep < 2; ++rep) { n_in = 0; n_c = 0;
#endif
    for (int k = 0; k < n_full + n_cmp; ++k) {
        const bool is_cmp = (k >= cmp_at) && (n_c < n_cmp);
#ifdef DBG_DUP1A
        if (rep == 1 && is_cmp) { ++n_c; continue; }
#endif
#if defined(DBG_DUP1B) || defined(DBG_DUP1C)
        if (rep == 1 && !is_cmp) { ++n_in; continue; }
#endif
        if (is_cmp) {
            const int t = bid + n_c * nb, slot = t >> 7, rt = t & 127;
            cmp_gemm_tile(p, slot, 2 * rt);
            cmp_gemm_tile(p, slot, 2 * rt + 1);
            EpiCmp2S e{(float*)(ws + WS_KCS) + (long)slot * 32768 * 128};
            gemm_tile((const u16*)(ws + WS_A2S) + (long)slot * 32768 * 256, 256, (const u16*)(ws + WS_W2T) + (long)slot * 256 * 256, 256, 256, rt * 256, 0, e);
            ++n_c;
        } else {
            const int u = bid + n_in * nb, pm = u % 34, pn = u / 34;
            EpiInA e{(float*)(ws + WS_PROJ), (u16*)(ws + WS_Q), (u16*)(ws + WS_KV6), (u16*)(ws + WS_VT), (u16*)(ws + WS_KF), p.out};
            if (e.colmode(pm * 256, pn * 256)) gemm_tile<EpiInA, false>((const u16*)(ws + WS_H), DM, (const u16*)(ws + WS_WINA), DM, DM, pm * 256, pn * 256, e);
            else                               gemm_tile<EpiInA, true>((const u16*)(ws + WS_H), DM, (const u16*)(ws + WS_WINA), DM, DM, pm * 256, pn * 256, e);
            ++n_in;
        }
    }
#if defined(DBG_DUP1A) || defined(DBG_DUP1B) || defined(DBG_DUP1C)
    }
#endif
    {
        const int rem = (34 * 27) % nb;
        const int sidx = rem == 0 ? bid : bid - rem, scount = rem == 0 ? nb : nb - rem;
        if (sidx >= 0) for (int t = sidx; t < TRD3; t += scount) tr_deferred(p, t);
    }
}

template <int NVT>
DI void rec_prep2(const u16* __restrict__ QT, const u16* __restrict__ KA, const u16* __restrict__ VTc,
                  float* __restrict__ OI, int chunk) {
    const int lane = threadIdx.x & 63, c = lane & 15, q = lane >> 4;
    bf16x8 fa[4], fb[4];
#pragma unroll
    for (int m = 0; m < 4; ++m) { const int o = ((chunk * 4 + q) * 64 + m * 16 + c) * 8; fa[m] = ld8(KA + o); fb[m] = ld8(QT + o); }
    u32x2 w[NVT];
#pragma unroll
    for (int vt = 0; vt < NVT; ++vt) w[vt] = *reinterpret_cast<const u32x2*>(VTc + ((chunk * NVT + vt) * 16 + c) * 16 + 4 * q);
    f32x4 att = {0.f, 0.f, 0.f, 0.f};
#pragma unroll
    for (int m = 0; m < 4; ++m) att = mfma16(fa[m], fb[m], att);
#pragma unroll
    for (int jj = 0; jj < 4; ++jj) if (4 * q + jj > c) att[jj] = 0.f;
    const bf16x8 Pa = mk8(cvt_pk(att[0], att[1]), cvt_pk(att[2], att[3]), 0u, 0u);
#pragma unroll
    for (int vt = 0; vt < NVT; ++vt) {
        const f32x4 zero4 = {0.f, 0.f, 0.f, 0.f};
        const f32x4 o = mfma16(Pa, mk8(w[vt].x, w[vt].y, 0u, 0u), zero4);
        *reinterpret_cast<f32x4*>(OI + ((chunk * NVT + vt) * 64 + lane) * 4) = o;
    }
}

using bf16x4 = __attribute__((ext_vector_type(4))) short;
DI bf16x4 ld4(const u16* p) { return *reinterpret_cast<const bf16x4*>(p); }
DI f32x4 mfma16k16(bf16x4 a, bf16x4 b, f32x4 c) { return __builtin_amdgcn_mfma_f32_16x16x16bf16_1k(a, b, c, 0, 0, 0); }
struct RecOps { bf16x8 Aq[4]; bf16x8 Ak[4]; u32x4 dv[4]; bf16x4 Bu; f32x4 oi; };
template <int NVT>
DI void rec_load(RecOps& R, const u16* __restrict__ QT, const u16* __restrict__ KST, const u16* __restrict__ VTc,
                 const u16* __restrict__ DC, const float* __restrict__ OI, int vt, int ch, int lane) {
    const int c = lane & 15, q = lane >> 4;
    const u16* qt = QT + ch * 2048 + lane * 8;
#pragma unroll
    for (int pp = 0; pp < 4; ++pp) R.Aq[pp] = ld8(qt + pp * 512);
    const u16* ks = KST + ch * 2048 + lane * 8;
#pragma unroll
    for (int r2 = 0; r2 < 4; ++r2) R.Ak[r2] = ld8(ks + r2 * 512);
    const u16* dc = DC + ch * 128 + 32 * q;
#pragma unroll
    for (int i = 0; i < 4; ++i) R.dv[i] = *reinterpret_cast<const u32x4*>(dc + 8 * i);
    R.Bu = ld4(VTc + ((ch * NVT + vt) * 16 + c) * 16 + 4 * q);
    R.oi = *reinterpret_cast<const f32x4*>(OI + ((ch * NVT + vt) * 64 + lane) * 4);
}
DI void rec_step(const RecOps& R, f32x4 (&S)[8], float* __restrict__ Orow, int ldo) {
    f32x4 o = R.oi;
#pragma unroll
    for (int pp = 0; pp < 4; ++pp) {
        const bf16x8 Bs = mk8(cvt_pk(S[0][pp], S[1][pp]), cvt_pk(S[2][pp], S[3][pp]), cvt_pk(S[4][pp], S[5][pp]), cvt_pk(S[6][pp], S[7][pp]));
        o = mfma16(R.Aq[pp], Bs, o);
    }
#pragma unroll
    for (int jj = 0; jj < 4; ++jj) Orow[jj * ldo] = o[jj];
#pragma unroll
    for (int rt = 0; rt < 8; ++rt) {
        f32x4 d;
#pragma unroll
        for (int jj = 0; jj < 4; ++jj) d[jj] = (rt & 1) ? bfhi(R.dv[jj][rt >> 1]) : bflo(R.dv[jj][rt >> 1]);
        const bf16x4 ak = (rt & 1) ? __builtin_shufflevector(R.Ak[rt >> 1], R.Ak[rt >> 1], 4, 5, 6, 7) : __builtin_shufflevector(R.Ak[rt >> 1], R.Ak[rt >> 1], 0, 1, 2, 3);
        S[rt] = mfma16k16(ak, R.Bu, S[rt] * d);
    }
}
template <int NVT>
DI void rec_walker(const u16* __restrict__ QT, const u16* __restrict__ KST, const u16* __restrict__ VTc,
                   const u16* __restrict__ DC, const float* __restrict__ OI, int vt,
                   float* __restrict__ O, int ldo, float* __restrict__ Sout, int DV) {
    int lane = threadIdx.x & 63; asm volatile("" : "+v"(lane));
    const int c = lane & 15, q = lane >> 4;
    f32x4 S[8];
#pragma unroll
    for (int rt = 0; rt < 8; ++rt) S[rt] = (f32x4){0.f, 0.f, 0.f, 0.f};
    float* o0 = O + (4 * q) * ldo + 16 * vt + c;
    RecOps A, B, C;
    rec_load<NVT>(A, QT, KST, VTc, DC, OI, vt, 0, lane);
    rec_load<NVT>(B, QT, KST, VTc, DC, OI, vt, 1, lane);
    rec_load<NVT>(C, QT, KST, VTc, DC, OI, vt, 2, lane);
    for (int ch = 0; ch < 126; ch += 3) {
        __builtin_amdgcn_sched_barrier(0);
        rec_step(A, S, o0 + (ch * 16) * ldo, ldo);
        __builtin_amdgcn_sched_barrier(0);
        rec_load<NVT>(A, QT, KST, VTc, DC, OI, vt, ch + 3, lane);
        __builtin_amdgcn_sched_barrier(0);
        rec_step(B, S, o0 + ((ch + 1) * 16) * ldo, ldo);
        __builtin_amdgcn_sched_barrier(0);
        rec_load<NVT>(B, QT, KST, VTc, DC, OI, vt, ch + 4, lane);
        __builtin_amdgcn_sched_barrier(0);
        rec_step(C, S, o0 + ((ch + 2) * 16) * ldo, ldo);
        __builtin_amdgcn_sched_barrier(0);
        rec_load<NVT>(C, QT, KST, VTc, DC, OI, vt, min(ch + 5, 127), lane);
    }
    __builtin_amdgcn_sched_barrier(0);
    rec_step(A, S, o0 + (126 * 16) * ldo, ldo);
    rec_step(B, S, o0 + (127 * 16) * ldo, ldo);
#pragma unroll
    for (int rt = 0; rt < 8; ++rt)
#pragma unroll
        for (int jj = 0; jj < 4; ++jj) Sout[(32 * q + 8 * jj + rt) * DV + 16 * vt + c] = S[rt][jj];
}

constexpr int RW_SLOTS = 8, RW_PAIR_BYTES = RW_SLOTS * 4096 + 64, RW_OFF = 32768;
DI void rw_wait_gt(volatile LAS int* f, int v) { while (*f <= v) __builtin_amdgcn_s_sleep(1); asm volatile("" ::: "memory"); }
struct RecSt { bf16x8 Ak[4]; u32x4 dv[4]; bf16x4 Bu; };
template <int NVT>
DI void rs_load(RecSt& R, const u16* __restrict__ KST, const u16* __restrict__ VTc, const u16* __restrict__ DC, int vt, int ch, int lane) {
    const int c = lane & 15, q = lane >> 4;
    const u16* ks = KST + ch * 2048 + lane * 8;
#pragma unroll
    for (int r2 = 0; r2 < 4; ++r2) R.Ak[r2] = ld8(ks + r2 * 512);
    const u16* dc = DC + ch * 128 + 32 * q;
#pragma unroll
    for (int i = 0; i < 4; ++i) R.dv[i] = *reinterpret_cast<const u32x4*>(dc + 8 * i);
    R.Bu = ld4(VTc + ((ch * NVT + vt) * 16 + c) * 16 + 4 * q);
}
DI void rs_step(const RecSt& R, f32x4 (&S)[8], char* __restrict__ slot, volatile LAS int* prod, volatile LAS int* cons, int s, int lane) {
    rw_wait_gt(cons, s - RW_SLOTS);
#pragma unroll
    for (int pp = 0; pp < 4; ++pp) {
        const bf16x8 Bs = mk8(cvt_pk(S[0][pp], S[1][pp]), cvt_pk(S[2][pp], S[3][pp]), cvt_pk(S[4][pp], S[5][pp]), cvt_pk(S[6][pp], S[7][pp]));
        *reinterpret_cast<bf16x8*>(slot + pp * 1024 + lane * 16) = Bs;
    }
    asm volatile("" ::: "memory");
    *prod = s + 1;
#pragma unroll
    for (int rt = 0; rt < 8; ++rt) {
        f32x4 d;
#pragma unroll
        for (int jj = 0; jj < 4; ++jj) d[jj] = (rt & 1) ? bfhi(R.dv[jj][rt >> 1]) : bflo(R.dv[jj][rt >> 1]);
        const bf16x4 ak = (rt & 1) ? __builtin_shufflevector(R.Ak[rt >> 1], R.Ak[rt >> 1], 4, 5, 6, 7) : __builtin_shufflevector(R.Ak[rt >> 1], R.Ak[rt >> 1], 0, 1, 2, 3);
        S[rt] = mfma16k16(ak, R.Bu, S[rt] * d);
    }
}
template <int NVT>
DI void rec_state_wave(const u16* __restrict__ KST, const u16* __restrict__ VTc, const u16* __restrict__ DC, int vt,
                       float* __restrict__ Sout, int DV, int ring_off) {
    char* ring = smem + ring_off;
    int lane = threadIdx.x & 63; asm volatile("" : "+v"(lane));
    const int c = lane & 15, q = lane >> 4;
    volatile LAS int* prod = (volatile LAS int*)(ring + RW_SLOTS * 4096);
    volatile LAS int* cons = prod + 1;
    f32x4 S[8];
#pragma unroll
    for (int rt = 0; rt < 8; ++rt) S[rt] = (f32x4){0.f, 0.f, 0.f, 0.f};
    RecSt R[4];
#pragma unroll
    for (int i = 0; i < 4; ++i) rs_load<NVT>(R[i], KST, VTc, DC, vt, i, lane);
    for (int ch = 0; ch < 128; ch += 4) {
#pragma unroll
        for (int i = 0; i < 4; ++i) {
            __builtin_amdgcn_sched_barrier(0);
            rs_step(R[i], S, ring + ((ch + i) & (RW_SLOTS - 1)) * 4096, prod, cons, ch + i, lane);
            __builtin_amdgcn_sched_barrier(0);
            rs_load<NVT>(R[i], KST, VTc, DC, vt, min(ch + i + 4, 127), lane);
        }
    }
#pragma unroll
    for (int rt = 0; rt < 8; ++rt)
#pragma unroll
        for (int jj = 0; jj < 4; ++jj) Sout[(32 * q + 8 * jj + rt) * DV + 16 * vt + c] = S[rt][jj];
}
struct RecOut { bf16x8 Aq[4]; bf16x8 fa[4]; bf16x8 fb[4]; u32x2 w; };
template <int NVT>
DI void ro_load(RecOut& R, const u16* __restrict__ QT, const u16* __restrict__ KA, const u16* __restrict__ VTc, int vt, int ch, int lane) {
    const int c = lane & 15, q = lane >> 4;
    const u16* qt = QT + ch * 2048 + lane * 8;
#pragma unroll
    for (int pp = 0; pp < 4; ++pp) R.Aq[pp] = ld8(qt + pp * 512);
#pragma unroll
    for (int m = 0; m < 4; ++m) { const int o = ((ch * 4 + q) * 64 + m * 16 + c) * 8; R.fa[m] = ld8(KA + o); R.fb[m] = ld8(QT + o); }
    R.w = *reinterpret_cast<const u32x2*>(VTc + ((ch * NVT + vt) * 16 + c) * 16 + 4 * q);
}
template <int NVT>
DI void rec_out_wave(const u16* __restrict__ QT, const u16* __restrict__ KA, const u16* __restrict__ VTc, int vt,
                     float* __restrict__ O, int ldo, int ring_off) {
    char* ring = smem + ring_off;
    int lane = threadIdx.x & 63; asm volatile("" : "+v"(lane));
    const int c = lane & 15, q = lane >> 4;
    volatile LAS int* prod = (volatile LAS int*)(ring + RW_SLOTS * 4096);
    volatile LAS int* cons = prod + 1;
    float* o0 = O + (4 * q) * ldo + 16 * vt + c;
    RecOut R[4];
#pragma unroll
    for (int i = 0; i < 4; ++i) ro_load<NVT>(R[i], QT, KA, VTc, vt, i, lane);
    for (int ch = 0; ch < 128; ch += 4) {
#pragma unroll
        for (int i = 0; i < 4; ++i) {
            const int s = ch + i;
            __builtin_amdgcn_sched_barrier(0);
            f32x4 att = {0.f, 0.f, 0.f, 0.f};
#pragma unroll
            for (int m = 0; m < 4; ++m) att = mfma16(R[i].fa[m], R[i].fb[m], att);
#pragma unroll
            for (int jj = 0; jj < 4; ++jj) if (4 * q + jj > c) att[jj] = 0.f;
            const bf16x8 Pa = mk8(cvt_pk(att[0], att[1]), cvt_pk(att[2], att[3]), 0u, 0u);
            const f32x4 zero4 = {0.f, 0.f, 0.f, 0.f};
            f32x4 o = mfma16(Pa, mk8(R[i].w.x, R[i].w.y, 0u, 0u), zero4);
            rw_wait_gt(prod, s);
            const char* slot = ring + (s & (RW_SLOTS - 1)) * 4096 + lane * 16;
            bf16x8 Bs[4];
#pragma unroll
            for (int pp = 0; pp < 4; ++pp) Bs[pp] = *reinterpret_cast<const bf16x8*>(slot + pp * 1024);
#pragma unroll
            for (int pp = 0; pp < 4; ++pp) o = mfma16(R[i].Aq[pp], Bs[pp], o);
            asm volatile("" ::: "memory");
            *cons = s + 1;
            float* orow = o0 + (s * 16) * ldo;
#pragma unroll
            for (int jj = 0; jj < 4; ++jj) orow[jj * ldo] = o[jj];
            __builtin_amdgcn_sched_barrier(0);
            ro_load<NVT>(R[i], QT, KA, VTc, vt, min(s + 4, 127), lane);
        }
    }
}

DI void gla_prep(const Params& p, int rank, int count) {
    char* ws = p.ws;
    const float* proj = (const float*)(ws + WS_PROJ);
    u16* QT = (u16*)(ws + WS_GQT); u16* KA = (u16*)(ws + WS_GKA); u16* KST = (u16*)(ws + WS_GKST); u16* VT = (u16*)(ws + WS_GVT);
    u16* DC = (u16*)(ws + WS_GDC);
    const int tid = threadIdx.x;
    for (int base = rank * 4; base < 2048; base += count * 4) {
        const int item = base + (tid >> 7), ch = tid & 127;
        const int b = item >> 9, h = (item >> 7) & 3, chunk = item & 127;
        const long tok0 = (long)b * 2048 + chunk * 16;
        float gw[16];
#pragma unroll
        for (int r = 0; r < 16; ++r) gw[r] = p.a_gla_w2[r * 512 + h * 128 + ch];
        const float gb = p.a_gla_b[h * 128 + ch];
        float bc[16]; float bs = 0.f;
#pragma unroll
        for (int t = 0; t < 16; ++t) {
            const float* lr = proj + (tok0 + t) * NAP + CLR;
            float z = gb;
#pragma unroll
            for (int r = 0; r < 16; ++r) z += lr[r] * gw[r];
            bs += logsigmoidf_(z) * (1.f / 16.f);
            bc[t] = bs;
        }
        u32 kw[8];
#pragma unroll
        for (int t = 0; t < 16; t += 2) {
            float kk[2];
#pragma unroll
            for (int u = 0; u < 2; ++u) {
                const float* pr = proj + (tok0 + t + u) * NAP;
                const float qv = pr[CQB + h * 128 + ch] * QSCALE, kv = pr[CKB + h * 128 + ch];
                const int fo = (((b * 4 + h) * 128 + chunk) * 4 + ((ch >> 3) & 3)) * 512 + ((ch >> 5) * 16 + t + u) * 8 + (ch & 7);
                QT[fo] = f2bf(qv * __expf(bc[t + u]));
                KA[fo] = f2bf(kv * __expf(-bc[t + u]));
                kk[u] = kv * __expf(bs - bc[t + u]);
            }
            kw[t >> 1] = cvt_pk(kk[0], kk[1]);
        }
        {
            u16* kd = KST + ((((long)(b * 4 + h) * 128 + chunk) * 4 + ((ch & 7) >> 1)) * 64 + (ch >> 3)) * 8 + (ch & 1) * 4;
#pragma unroll
            for (int qq = 0; qq < 4; ++qq) { u32x2 w2 = {kw[2 * qq], kw[2 * qq + 1]}; *reinterpret_cast<u32x2*>(kd + qq * 128) = w2; }
        }
        DC[((long)(b * 4 + h) * 128 + chunk) * 128 + ch] = f2bf(__expf(bs));
    }
    for (long i = (long)rank * 512 + tid; i < (long)16 * 128 * 256; i += (long)count * 512) {
        const int v = (int)(i & 255), chunk = (int)((i >> 8) & 127), bh = (int)(i >> 15), b = bh >> 2, h = bh & 3;
        const long tok0 = (long)b * 2048 + chunk * 16;
        u32 w[8];
#pragma unroll
        for (int t = 0; t < 16; t += 2)
            w[t >> 1] = cvt_pk(proj[(tok0 + t) * NAP + CVB + h * 256 + v], proj[(tok0 + t + 1) * NAP + CVB + h * 256 + v]);
        u32x4* d = reinterpret_cast<u32x4*>(VT + i * 16);
        u32x4 a0 = {w[0], w[1], w[2], w[3]}, a1 = {w[4], w[5], w[6], w[7]};
        d[0] = a0; d[1] = a1;
    }
}

DI void hgrn_prep(const Params& p) {
    char* ws = p.ws;
    const float* pc = (const float*)(ws + WS_PROJC);
    u16* QT = (u16*)(ws + WS_HQT); u16* KA = (u16*)(ws + WS_HKA); u16* KST = (u16*)(ws + WS_HKST); u16* VT = (u16*)(ws + WS_HVT);
    float* DC = (float*)(ws + WS_HDC);
    const int tid = threadIdx.x;
    for (int base = blockIdx.x * 4; base < 64 * 128; base += gridDim.x * 4) {
        const int item = base + (tid >> 7), ch = tid & 127;
        const int bh = item >> 7, b = bh >> 4, h = bh & 15, chunk = item & 127;
        const long tok0 = (long)b * 2048 + chunk * 16;
        const int gc = h * 128 + ch;
        const float lb = sigmoidf_(p.c_lb_logits[2048 + gc] - p.c_lb_logits[gc]);
        float bc[16], kk[16]; float bs = 0.f;
#pragma unroll
        for (int t = 0; t < 16; ++t) {
            const float fr = pc[(tok0 + t) * NC + 2048 + gc];
            const float sg = 1.f / (1.f + __expf(-fr)), sn = 1.f / (1.f + __expf(fr));
            bs += __logf(lb + (1.f - lb) * sg);
            bc[t] = bs;
            kk[t] = (1.f - lb) * sn;
        }
        u32 kw[8];
#pragma unroll
        for (int t = 0; t < 16; t += 2) {
            float ks[2];
#pragma unroll
            for (int u = 0; u < 2; ++u) {
                const float qv = siluf_(pc[(tok0 + t + u) * NC + gc]);
                QT[(tok0 + t + u) * DM + gc] = f2bf(qv * __expf(bc[t + u]));
                KA[(tok0 + t + u) * DM + gc] = f2bf(kk[t + u] * __expf(-bc[t + u]));
                ks[u] = kk[t + u] * __expf(bs - bc[t + u]);
            }
            kw[t >> 1] = cvt_pk(ks[0], ks[1]);
        }
        u32x4* kd = reinterpret_cast<u32x4*>(KST + (((long)bh * 128 + chunk) * 128 + ch) * 16);
        u32x4 k0 = {kw[0], kw[1], kw[2], kw[3]}, k1 = {kw[4], kw[5], kw[6], kw[7]};
        kd[0] = k0; kd[1] = k1;
        DC[((long)bh * 128 + chunk) * 128 + ch] = __expf(bs);
        u32 w[8];
#pragma unroll
        for (int t = 0; t < 16; t += 2) w[t >> 1] = cvt_pk(pc[(tok0 + t) * NC + 4096 + gc], pc[(tok0 + t + 1) * NC + 4096 + gc]);
        u32x4* d = reinterpret_cast<u32x4*>(VT + (((long)bh * 128 + chunk) * 128 + ch) * 16);
        u32x4 a0 = {w[0], w[1], w[2], w[3]}, a1 = {w[4], w[5], w[6], w[7]};
        d[0] = a0; d[1] = a1;
    }
}

DI void gla_sample_item(const Params& p, int b, int h) {
    char* ws = p.ws;
    const float* proj = (const float*)(ws + WS_PROJ);
    float* L = reinterpret_cast<float*>(smem);
    float* La = L; float* Lk = L + 512; float* Lq = L + 1024; float* Lv = L + 1536; float* Lp = L + 2560; float* Lr = L + 4608;
    int tid = threadIdx.x; asm volatile("" : "+v"(tid));
    {
        const int t = tid >> 7, ch = tid & 127;
        const float* pr = proj + (long)(NTP + b * 4 + t) * NAP;
        float z = p.a_gla_b[h * 128 + ch];
#pragma unroll
        for (int r = 0; r < 16; ++r) z += pr[CLR + r] * p.a_gla_w2[r * 512 + h * 128 + ch];
        La[tid] = __expf(logsigmoidf_(z) * (1.f / 16.f));
        Lk[tid] = pr[CKB + h * 128 + ch];
        Lq[tid] = pr[CQB + h * 128 + ch] * QSCALE;
        for (int i = tid; i < 1024; i += 512) Lv[i] = proj[(long)(NTP + b * 4 + (i >> 8)) * NAP + CVB + h * 256 + (i & 255)];
    }
    __syncthreads();
    {
        const int v = tid & 255, kh = tid >> 8;
        const float* S0 = p.state_gla + ((long)(b * 4 + h) * 128) * 256;
        float* S1 = p.out + O_GLAS + ((long)(b * 4 + h) * 128) * 256;
        const float v0 = Lv[v], v1 = Lv[256 + v], v2 = Lv[512 + v], v3 = Lv[768 + v];
        float o0 = 0.f, o1 = 0.f, o2 = 0.f, o3 = 0.f;
#pragma unroll 16
        for (int kk = 0; kk < 64; ++kk) {
            const int k = kh * 64 + kk;
            float s = S0[(long)k * 256 + v];
            s = La[k] * s + Lk[k] * v0;             o0 += Lq[k] * s;
            s = La[128 + k] * s + Lk[128 + k] * v1; o1 += Lq[128 + k] * s;
            s = La[256 + k] * s + Lk[256 + k] * v2; o2 += Lq[256 + k] * s;
            s = La[384 + k] * s + Lk[384 + k] * v3; o3 += Lq[384 + k] * s;
            S1[(long)k * 256 + v] = s;
        }
        Lp[(0 * 2 + kh) * 256 + v] = o0; Lp[(1 * 2 + kh) * 256 + v] = o1; Lp[(2 * 2 + kh) * 256 + v] = o2; Lp[(3 * 2 + kh) * 256 + v] = o3;
    }
    __syncthreads();
    {
        const int w = tid >> 6, lane = tid & 63, t = w >> 1, v = (w & 1) * 128 + lane * 2;
        const float a0 = Lp[(t * 2) * 256 + v] + Lp[(t * 2 + 1) * 256 + v], a1 = Lp[(t * 2) * 256 + v + 1] + Lp[(t * 2 + 1) * 256 + v + 1];
        const float ss = wave_sum(a0 * a0 + a1 * a1);
        if (lane == 0) Lr[w] = ss;
        __syncthreads();
        const float inv = rsqrtf((Lr[t * 2] + Lr[t * 2 + 1]) * (1.f / 256.f) + 1e-6f);
        const long tok = NTP + b * 4 + t;
        const float* zb = proj + tok * NAP + CZB + h * 256 + v;
        u16* oa = (u16*)(ws + WS_OA) + tok * DM + 1024 + h * 256 + v;
        *reinterpret_cast<u32*>(oa) = cvt_pk(a0 * inv * p.a_gla_gn[v] * siluf_(zb[0]), a1 * inv * p.a_gla_gn[v + 1] * siluf_(zb[1]));
    }
    __syncthreads();
}

DI void gla_sample_wave(const Params& p, int b, int h, float* __restrict__ Lw) {
    char* ws = p.ws;
    const float* proj = (const float*)(ws + WS_PROJ);
    int lane = threadIdx.x & 63; asm volatile("" : "+v"(lane));
    float* La = Lw; float* Lk = Lw + 512; float* Lq = Lw + 1024;
    const long tok0 = NTP + b * 4;
#pragma unroll
    for (int t = 0; t < 4; ++t) {
        const float* pr = proj + (tok0 + t) * NAP;
#pragma unroll
        for (int u = 0; u < 2; ++u) {
            const int ch = lane + 64 * u;
            float z = p.a_gla_b[h * 128 + ch];
#pragma unroll
            for (int r = 0; r < 16; ++r) z += pr[CLR + r] * p.a_gla_w2[r * 512 + h * 128 + ch];
            La[ch * 4 + t] = __expf(logsigmoidf_(z) * (1.f / 16.f));
            Lk[ch * 4 + t] = pr[CKB + h * 128 + ch];
            Lq[ch * 4 + t] = pr[CQB + h * 128 + ch] * QSCALE;
        }
    }
    f32x4 vv[4], o[4];
#pragma unroll
    for (int t = 0; t < 4; ++t) {
        vv[t] = *reinterpret_cast<const f32x4*>(proj + (tok0 + t) * NAP + CVB + h * 256 + lane * 4);
        o[t] = (f32x4){0.f, 0.f, 0.f, 0.f};
    }
    const float* S0 = p.state_gla + ((long)(b * 4 + h) * 128) * 256 + lane * 4;
    float* S1 = p.out + O_GLAS + ((long)(b * 4 + h) * 128) * 256 + lane * 4;
    for (int k0 = 0; k0 < 128; k0 += 16) {
        f32x4 s[16];
#pragma unroll
        for (int kk = 0; kk < 16; ++kk) s[kk] = *reinterpret_cast<const f32x4*>(S0 + (long)(k0 + kk) * 256);
#pragma unroll
        for (int kk = 0; kk < 16; ++kk) {
            const f32x4 a = *reinterpret_cast<const f32x4*>(La + (k0 + kk) * 4), kx = *reinterpret_cast<const f32x4*>(Lk + (k0 + kk) * 4),
                        qx = *reinterpret_cast<const f32x4*>(Lq + (k0 + kk) * 4);
#pragma unroll
            for (int t = 0; t < 4; ++t) { s[kk] = s[kk] * a[t] + vv[t] * kx[t]; o[t] += s[kk] * qx[t]; }
            *reinterpret_cast<f32x4*>(S1 + (long)(k0 + kk) * 256) = s[kk];
        }
    }
    const f32x4 gn = *reinterpret_cast<const f32x4*>(p.a_gla_gn + lane * 4);
#pragma unroll
    for (int t = 0; t < 4; ++t) {
        const float ss = wave_sum(o[t][0] * o[t][0] + o[t][1] * o[t][1] + o[t][2] * o[t][2] + o[t][3] * o[t][3]);
        const float inv = rsqrtf(ss * (1.f / 256.f) + 1e-6f);
        const f32x4 z = *reinterpret_cast<const f32x4*>(proj + (tok0 + t) * NAP + CZB + h * 256 + lane * 4);
        u32x2 w2 = {cvt_pk(o[t][0] * inv * gn[0] * siluf_(z[0]), o[t][1] * inv * gn[1] * siluf_(z[1])),
                    cvt_pk(o[t][2] * inv * gn[2] * siluf_(z[2]), o[t][3] * inv * gn[3] * siluf_(z[3]))};
        *reinterpret_cast<u32x2*>((u16*)(ws + WS_OA) + (tok0 + t) * DM + 1024 + h * 256 + lane * 4) = w2;
    }
}

DI void hgrn_sample_loop(const Params& p, int it0, int itN, int stride) {
    char* ws = p.ws;
    const float* pc = (const float*)(ws + WS_PCS);
    float* L = reinterpret_cast<float*>(smem);
    float* La = L; float* Lk = L + 512; float* Lq = L + 1024; float* Lv = L + 1536; float* Lp = L + 2048; float* Lr = L + 4096;
    int tid = threadIdx.x; asm volatile("" : "+v"(tid));
    const int t = tid >> 7, ch = tid & 127;
    const int v = tid & 127, kq = tid >> 7;
    const int w = tid >> 6, lane = tid & 63, tn = w >> 1, vn = (w & 1) * 64 + lane;
    float sreg[32], pf = 0.f, pq = 0.f, pv = 0.f, pz = 0.f, l0 = 0.f, l1 = 0.f;
    auto prefetch = [&](int it) {
        const int b = it >> 4, h = it & 15, gc = h * 128 + ch;
        const float* S0 = p.state_hgrn + ((long)it * 128 + kq * 32) * 128 + v;
#pragma unroll
        for (int kk = 0; kk < 32; ++kk) sreg[kk] = S0[kk * 128];
        const float* pr = pc + (long)(b * 4 + t) * NC;
        const float* pr2 = pr + (long)NTS * NC;
        pf = pr[2048 + gc] + pr2[2048 + gc]; pq = pr[gc] + pr2[gc]; pv = pr[4096 + gc] + pr2[4096 + gc];
        l0 = p.c_lb_logits[gc]; l1 = p.c_lb_logits[2048 + gc];
        pz = pc[(long)(b * 4 + tn) * NC + 6144 + h * 128 + vn] + pc[(long)(NTS + b * 4 + tn) * NC + 6144 + h * 128 + vn];
    };
    if (it0 < itN) prefetch(it0);
    for (int it = it0; it < itN; it += stride) {
        const int b = it >> 4, h = it & 15;
        {
            const float lb = sigmoidf_(l1 - l0);
            const float sg = 1.f / (1.f + __expf(-pf)), sn = 1.f / (1.f + __expf(pf));
            La[tid] = lb + (1.f - lb) * sg;
            Lk[tid] = (1.f - lb) * sn;
            Lq[tid] = siluf_(pq);
            Lv[tid] = pv;
        }
        const float zc = pz;
        __syncthreads();
        {
            float* S1 = p.out + O_HGS + ((long)it * 128 + kq * 32) * 128 + v;
            const float v0 = Lv[v], v1 = Lv[128 + v], v2 = Lv[256 + v], v3 = Lv[384 + v];
            float o0 = 0.f, o1 = 0.f, o2 = 0.f, o3 = 0.f;
#pragma unroll
            for (int kk = 0; kk < 32; ++kk) {
                const int k = kq * 32 + kk;
                float s = sreg[kk];
                s = La[k] * s + Lk[k] * v0;             o0 += Lq[k] * s;
                s = La[128 + k] * s + Lk[128 + k] * v1; o1 += Lq[128 + k] * s;
                s = La[256 + k] * s + Lk[256 + k] * v2; o2 += Lq[256 + k] * s;
                s = La[384 + k] * s + Lk[384 + k] * v3; o3 += Lq[384 + k] * s;
                S1[kk * 128] = s;
            }
            Lp[(0 * 4 + kq) * 128 + v] = o0; Lp[(1 * 4 + kq) * 128 + v] = o1; Lp[(2 * 4 + kq) * 128 + v] = o2; Lp[(3 * 4 + kq) * 128 + v] = o3;
        }
        if (it + stride < itN) prefetch(it + stride);
        __syncthreads();
        {
            const float a0 = Lp[(tn * 4) * 128 + vn] + Lp[(tn * 4 + 1) * 128 + vn] + Lp[(tn * 4 + 2) * 128 + vn] + Lp[(tn * 4 + 3) * 128 + vn];
            const float ss = wave_sum(a0 * a0);
            if (lane == 0) Lr[w] = ss;
            __syncthreads();
            const float inv = rsqrtf((Lr[tn * 2] + Lr[tn * 2 + 1]) * (1.f / 128.f) + 1e-6f);
            const long tok = NTP + b * 4 + tn;
            ((u16*)(ws + WS_OA))[tok * DM + h * 128 + vn] = f2bf(a0 * inv * p.c_gn[vn] * siluf_(zc));
        }
        __syncthreads();
    }
}

DI void hgrn_sample_wave(const Params& p, int it, float* __restrict__ Lw) {
    char* ws = p.ws;
    const float* pc = (const float*)(ws + WS_PCS);
    const long H2 = (long)NTS * NC;
    int lane = threadIdx.x & 63; asm volatile("" : "+v"(lane));
    const int b = it >> 4, h = it & 15, kp = lane >> 5, c4 = (lane & 31) * 4;
    float* La = Lw; float* Lk = Lw + 512; float* Lq = Lw + 1024;
#pragma unroll
    for (int u = 0; u < 2; ++u) {
        const int ch = lane + 64 * u, gc = h * 128 + ch;
        const float lb = sigmoidf_(p.c_lb_logits[2048 + gc] - p.c_lb_logits[gc]);
#pragma unroll
        for (int t = 0; t < 4; ++t) {
            const float* pr = pc + (long)(b * 4 + t) * NC;
            const float pf = pr[2048 + gc] + pr[H2 + 2048 + gc], pq = pr[gc] + pr[H2 + gc];
            const float sg = 1.f / (1.f + __expf(-pf)), sn = 1.f / (1.f + __expf(pf));
            La[ch * 4 + t] = lb + (1.f - lb) * sg;
            Lk[ch * 4 + t] = (1.f - lb) * sn;
            Lq[ch * 4 + t] = siluf_(pq);
        }
    }
    f32x4 vv[4], o[4];
#pragma unroll
    for (int t = 0; t < 4; ++t) {
        const float* pr = pc + (long)(b * 4 + t) * NC + 4096 + h * 128 + c4;
        vv[t] = *reinterpret_cast<const f32x4*>(pr) + *reinterpret_cast<const f32x4*>(pr + H2);
        o[t] = (f32x4){0.f, 0.f, 0.f, 0.f};
    }
    const float* S0 = p.state_hgrn + ((long)it * 128 + kp) * 128 + c4;
    float* S1 = p.out + O_HGS + ((long)it * 128 + kp) * 128 + c4;
    for (int i0 = 0; i0 < 64; i0 += 16) {
        f32x4 s[16];
#pragma unroll
        for (int ii = 0; ii < 16; ++ii) s[ii] = *reinterpret_cast<const f32x4*>(S0 + (long)(i0 + ii) * 256);
#pragma unroll
        for (int ii = 0; ii < 16; ++ii) {
            const int k = 2 * (i0 + ii) + kp;
            const f32x4 a = *reinterpret_cast<const f32x4*>(La + k * 4), kx = *reinterpret_cast<const f32x4*>(Lk + k * 4),
                        qx = *reinterpret_cast<const f32x4*>(Lq + k * 4);
#pragma unroll
            for (int t = 0; t < 4; ++t) { s[ii] = s[ii] * a[t] + vv[t] * kx[t]; o[t] += s[ii] * qx[t]; }
            *reinterpret_cast<f32x4*>(S1 + (long)(i0 + ii) * 256) = s[ii];
        }
    }
    const f32x4 gn = *reinterpret_cast<const f32x4*>(p.c_gn + c4);
#pragma unroll
    for (int t = 0; t < 4; ++t) {
#pragma unroll
        for (int j = 0; j < 4; ++j) o[t][j] += __shfl_xor(o[t][j], 32, 64);
        const float ss = 0.5f * wave_sum(o[t][0] * o[t][0] + o[t][1] * o[t][1] + o[t][2] * o[t][2] + o[t][3] * o[t][3]);
        const float inv = rsqrtf(ss * (1.f / 128.f) + 1e-6f);
        const float* zr = pc + (long)(b * 4 + t) * NC + 6144 + h * 128 + c4;
        const f32x4 z = *reinterpret_cast<const f32x4*>(zr) + *reinterpret_cast<const f32x4*>(zr + H2);
        u32x2 w2 = {cvt_pk(o[t][0] * inv * gn[0] * siluf_(z[0]), o[t][1] * inv * gn[1] * siluf_(z[1])),
                    cvt_pk(o[t][2] * inv * gn[2] * siluf_(z[2]), o[t][3] * inv * gn[3] * siluf_(z[3]))};
        if (kp == 0) *reinterpret_cast<u32x2*>((u16*)(ws + WS_OA) + (long)(NTP + b * 4 + t) * DM + h * 128 + c4) = w2;
    }
}

DI void gla_norm_gate(const Params& p, int rank, int count) {
    char* ws = p.ws;
    const float* ob = (const float*)(ws + WS_OB32);
    const float* proj = (const float*)(ws + WS_PROJ);
    u16* oa = (u16*)(ws + WS_OA);
    const int lane = threadIdx.x & 63, wid = threadIdx.x >> 6;
    const f32x4 g = reinterpret_cast<const f32x4*>(p.a_gla_gn)[lane];
    for (int it0 = (rank * 8 + wid) * 4; it0 < NTP * 4; it0 += count * 8 * 4) {
        f32x4 v[4], z[4];
#pragma unroll
        for (int u = 0; u < 4; ++u) {
            const int it = it0 + u; const long tok = it >> 2; const int h = it & 3;
            v[u] = reinterpret_cast<const f32x4*>(ob + tok * 1024 + h * 256)[lane];
            z[u] = reinterpret_cast<const f32x4*>(proj + tok * NAP + CZB + h * 256)[lane];
        }
#pragma unroll
        for (int u = 0; u < 4; ++u) {
            const int it = it0 + u; const long tok = it >> 2; const int h = it & 3;
            const float ss = wave_sum(v[u][0] * v[u][0] + v[u][1] * v[u][1] + v[u][2] * v[u][2] + v[u][3] * v[u][3]);
            const float inv = rsqrtf(ss * (1.f / 256.f) + 1e-6f);
            u32x2 o = {cvt_pk(v[u][0] * inv * g[0] * siluf_(z[u][0]), v[u][1] * inv * g[1] * siluf_(z[u][1])),
                       cvt_pk(v[u][2] * inv * g[2] * siluf_(z[u][2]), v[u][3] * inv * g[3] * siluf_(z[u][3]))};
            *reinterpret_cast<u32x2*>(oa + tok * DM + 1024 + h * 256 + lane * 4) = o;
        }
    }
}
DI void hgrn_norm_gate(const Params& p, int rank, int count) {
    char* ws = p.ws;
    const float* oc = (const float*)(ws + WS_OC32);
    const u16* zb = (const u16*)(ws + WS_ZB);
    u16* oa = (u16*)(ws + WS_OA);
    const int lane = threadIdx.x & 63, wid = threadIdx.x >> 6;
    const float2 g = reinterpret_cast<const float2*>(p.c_gn)[lane];
    for (int it0 = (rank * 8 + wid) * 8; it0 < NTP * 16; it0 += count * 8 * 8) {
        float2 v[8]; u32 zw[8];
#pragma unroll
        for (int u = 0; u < 8; ++u) {
            const int it = it0 + u; const long tok = it >> 4; const int h = it & 15;
            v[u] = reinterpret_cast<const float2*>(oc + tok * DM + h * 128)[lane];
            zw[u] = reinterpret_cast<const u32*>(zb + tok * DM + h * 128)[lane];
        }
#pragma unroll
        for (int u = 0; u < 8; ++u) {
            const int it = it0 + u; const long tok = it >> 4; const int h = it & 15;
            const float ss = wave_sum(v[u].x * v[u].x + v[u].y * v[u].y);
            const float inv = rsqrtf(ss * (1.f / 128.f) + 1e-6f);
            *reinterpret_cast<u32*>(oa + tok * DM + h * 128 + lane * 2) = cvt_pk(v[u].x * inv * g.x * siluf_(bflo(zw[u])), v[u].y * inv * g.y * siluf_(bfhi(zw[u])));
        }
    }
}

struct Acc16 { float m, l; f32x4 O[8]; };

DI f32x4 scores16(const float* __restrict__ kr, const bf16x8 (&Qb)[4], int q) {
    f32x4 s = {0.f, 0.f, 0.f, 0.f};
#pragma unroll
    for (int m = 0; m < 4; ++m) {
        const f32x4 a = *reinterpret_cast<const f32x4*>(kr + 32 * m + 4 * q);
        const f32x4 b = *reinterpret_cast<const f32x4*>(kr + 32 * m + 16 + 4 * q);
        s = mfma16(mk8(cvt_pk(a[0], a[1]), cvt_pk(a[2], a[3]), cvt_pk(b[0], b[1]), cvt_pk(b[2], b[3])), Qb[m], s);
    }
    return s;
}
template <class RV>
DI void pv16(int k0, const RV& rowv, const float (&pv)[8], f32x4 (&O)[8], int c, int q) {
    const bf16x8 P = mk8(cvt_pk(pv[0], pv[1]), cvt_pk(pv[2], pv[3]), cvt_pk(pv[4], pv[5]), cvt_pk(pv[6], pv[7]));
    f32x4 L[8], H[8];
#pragma unroll
    for (int e = 0; e < 8; ++e) {
        const int key = k0 + (e < 4 ? 4 * q + e : 16 + 4 * q + e - 4);
        const float* vr = rowv(key);
        L[e] = *reinterpret_cast<const f32x4*>(vr + 4 * c);
        H[e] = *reinterpret_cast<const f32x4*>(vr + 64 + 4 * c);
    }
#pragma unroll
    for (int dt = 0; dt < 4; ++dt) {
        O[dt] = mfma16(mk8(cvt_pk(L[0][dt], L[1][dt]), cvt_pk(L[2][dt], L[3][dt]), cvt_pk(L[4][dt], L[5][dt]), cvt_pk(L[6][dt], L[7][dt])), P, O[dt]);
        O[4 + dt] = mfma16(mk8(cvt_pk(H[0][dt], H[1][dt]), cvt_pk(H[2][dt], H[3][dt]), cvt_pk(H[4][dt], H[5][dt]), cvt_pk(H[6][dt], H[7][dt])), P, O[4 + dt]);
    }
}
template <class RK, class RV, class MK>
DI void attn16_group(int k0, const RK& rowk, const RV& rowv, const MK& valid, const bf16x8 (&Qb)[4], Acc16& A, int c, int q) {
    const f32x4 s0 = scores16(rowk(k0 + c), Qb, q), s1 = scores16(rowk(k0 + 16 + c), Qb, q);
    float sv[8];
#pragma unroll
    for (int jj = 0; jj < 4; ++jj) {
        sv[jj] = valid(k0 + 4 * q + jj) ? s0[jj] : -INFINITY;
        sv[4 + jj] = valid(k0 + 16 + 4 * q + jj) ? s1[jj] : -INFINITY;
    }
    float mx = sv[0];
#pragma unroll
    for (int i = 1; i < 8; ++i) mx = fmaxf(mx, sv[i]);
    mx = fmaxf(mx, __shfl_xor(mx, 16, 64)); mx = fmaxf(mx, __shfl_xor(mx, 32, 64));
    const float mnew = fmaxf(A.m, mx);
    const float muse = (mnew == -INFINITY) ? 0.f : mnew;
    const float alpha = exp2f_(A.m - muse);
    float pv[8]; float ps = 0.f;
#pragma unroll
    for (int i = 0; i < 8; ++i) { pv[i] = exp2f_(sv[i] - muse); ps += pv[i]; }
    ps += __shfl_xor(ps, 16, 64); ps += __shfl_xor(ps, 32, 64);
    A.l = A.l * alpha + ps; A.m = mnew;
#pragma unroll
    for (int dt = 0; dt < 8; ++dt) A.O[dt] *= alpha;
    pv16(k0, rowv, pv, A.O, c, q);
}

constexpr int AS_WAVE_BYTES = 9216;
constexpr int AS_OW_OFF = 8 * AS_WAVE_BYTES;
constexpr int AS_OW_LD = 132;

DI void attn_sample_item(const Params& p, int b, int g) {
    char* ws = p.ws;
    const float* proj = (const float*)(ws + WS_PROJ);
    int tid = threadIdx.x; asm volatile("" : "+v"(tid));
    const int w = tid >> 6, lane = tid & 63, c = lane & 15, q = lane >> 4;
    const int tokc = c >> 2, r = c & 3;
    float* Pl = reinterpret_cast<float*>(smem + w * AS_WAVE_BYTES);
    float* IMP = Pl + 16 * 128;
    float* Ow = reinterpret_cast<float*>(smem + AS_OW_OFF);
    float* ML = Ow + 8 * 16 * AS_OW_LD;
    bf16x8 Qb[4];
    {
        const u16* qb = (const u16*)(ws + WS_Q) + (long)(NTP + b * 4 + tokc) * 1024 + (g * 4 + r) * 128;
#pragma unroll
        for (int m = 0; m < 4; ++m) {
            const u32x2 w0 = *reinterpret_cast<const u32x2*>(qb + 32 * m + 4 * q), w1 = *reinterpret_cast<const u32x2*>(qb + 32 * m + 16 + 4 * q);
            Qb[m] = mk8(w0.x, w0.y, w1.x, w1.y);
        }
    }
    const int cq = tid >> 5, cd = (tid & 31) * 4;
    f32x4 acc = {0.f, 0.f, 0.f, 0.f};
    float gate[3];
    {
        const float* gp = proj + (long)(NTP + b * 4 + (cq >> 2)) * NAP + CGB + (g * 4 + (cq & 3)) * 3;
        gate[0] = sigmoidf_(gp[0]); gate[1] = sigmoidf_(gp[1]); gate[2] = sigmoidf_(gp[2]);
    }
    auto combine = [&](const Acc16& A, float gt) {
#pragma unroll
        for (int dt = 0; dt < 8; ++dt)
#pragma unroll
            for (int jj = 0; jj < 4; ++jj) Ow[(w * 16 + c) * AS_OW_LD + 4 * (4 * q + jj) + (dt & 3) + 64 * (dt >> 2)] = A.O[dt][jj];
        if (q == 0) { ML[(w * 16 + c) * 2] = A.m; ML[(w * 16 + c) * 2 + 1] = A.l; }
        __syncthreads();
        float M = -INFINITY;
#pragma unroll
        for (int ww = 0; ww < 8; ++ww) M = fmaxf(M, ML[(ww * 16 + cq) * 2]);
        float Lsum = 0.f; f32x4 o = {0.f, 0.f, 0.f, 0.f};
        if (M > -INFINITY) {
#pragma unroll
            for (int ww = 0; ww < 8; ++ww) {
                const float sc = exp2f_(ML[(ww * 16 + cq) * 2] - M);
                Lsum += ML[(ww * 16 + cq) * 2 + 1] * sc;
                o += *reinterpret_cast<const f32x4*>(Ow + (ww * 16 + cq) * AS_OW_LD + cd) * sc;
            }
        }
        if (Lsum > 0.f) acc += o * (gt / Lsum);
        __syncthreads();
    };

    const float* kcs = (const float*)(ws + WS_KCS) + ((long)(b * 2 + g) * 128) * 128;
    const float* vcs = kcs + (long)256 * 128 * 128;
    float pc[4][8];
    {
        float mx = -INFINITY;
#pragma unroll
        for (int gi = 0; gi < 4; ++gi) {
            const f32x4 s0 = scores16(kcs + (long)(32 * gi + c) * 128, Qb, q), s1 = scores16(kcs + (long)(32 * gi + 16 + c) * 128, Qb, q);
#pragma unroll
            for (int jj = 0; jj < 4; ++jj) {
                pc[gi][jj] = s0[jj];
                pc[gi][4 + jj] = (32 * gi + 16 + 4 * q + jj < 127) ? s1[jj] : -INFINITY;
                mx = fmaxf(mx, fmaxf(pc[gi][jj], pc[gi][4 + jj]));
            }
        }
        mx = fmaxf(mx, __shfl_xor(mx, 16, 64)); mx = fmaxf(mx, __shfl_xor(mx, 32, 64));
        float ls = 0.f;
#pragma unroll
        for (int gi = 0; gi < 4; ++gi)
#pragma unroll
            for (int i = 0; i < 8; ++i) { pc[gi][i] = exp2f_(pc[gi][i] - mx); ls += pc[gi][i]; }
        ls += __shfl_xor(ls, 16, 64); ls += __shfl_xor(ls, 32, 64);
        const float il = 1.f / ls;
#pragma unroll
        for (int gi = 0; gi < 4; ++gi)
#pragma unroll
            for (int jj = 0; jj < 4; ++jj) {
                pc[gi][jj] *= il; pc[gi][4 + jj] *= il;
                Pl[c * 128 + 32 * gi + 4 * q + jj] = pc[gi][jj];
                Pl[c * 128 + 32 * gi + 16 + 4 * q + jj] = pc[gi][4 + jj];
            }
    }
    __syncthreads();
#pragma unroll
    for (int n = 0; n < 2; ++n) {
        const int pi = lane + 64 * n, tk = pi >> 5, u = pi & 31;
        float s = 0.f;
#pragma unroll
        for (int rr = 0; rr < 4; ++rr) {
            const float* pr = Pl + (tk * 4 + rr) * 128 + 4 * u;
            s += 2.f * (pr[0] + pr[1] + pr[2]) + pr[3] + (u > 0 ? pr[-1] : 0.f);
        }
        IMP[pi] = s;
    }
    __syncthreads();
    u32 mymask;
    {
        u64 bal[2];
#pragma unroll
        for (int n = 0; n < 2; ++n) {
            const int pi = lane + 64 * n, tk = pi >> 5, u = pi & 31;
            bool sel;
            if (u == 0 || u == 31) sel = true;
            else {
                const float mine = IMP[pi];
                int rank = 0;
                for (int u2 = 1; u2 <= 30; ++u2) { const float o = IMP[tk * 32 + u2]; rank += (o > mine || (o == mine && u2 < u)) ? 1 : 0; }
                sel = rank < 13;
            }
            bal[n] = __ballot(sel);
        }
        mymask = tokc == 0 ? (u32)bal[0] : tokc == 1 ? (u32)(bal[0] >> 32) : tokc == 2 ? (u32)bal[1] : (u32)(bal[1] >> 32);
    }
    const u32 umask = (u32)__builtin_amdgcn_readfirstlane((int)(__shfl(mymask, 0, 64) | __shfl(mymask, 4, 64) | __shfl(mymask, 8, 64) | __shfl(mymask, 12, 64)));
    {
        Acc16 A; A.m = -INFINITY; A.l = 0.f;
#pragma unroll
        for (int dt = 0; dt < 8; ++dt) A.O[dt] = (f32x4){0.f, 0.f, 0.f, 0.f};
        if (w < 4) {
            float pvv[8]; float ps = 0.f;
#pragma unroll
            for (int i = 0; i < 8; ++i) { pvv[i] = w == 0 ? pc[0][i] : w == 1 ? pc[1][i] : w == 2 ? pc[2][i] : pc[3][i]; ps += pvv[i]; }
            ps += __shfl_xor(ps, 16, 64); ps += __shfl_xor(ps, 32, 64);
            A.m = 0.f; A.l = ps;
            pv16(32 * w, [&](int key) { return vcs + (long)key * 128; }, pvv, A.O, c, q);
        }
        combine(A, gate[0]);
    }
    {
        Acc16 A; A.m = -INFINITY; A.l = 0.f;
#pragma unroll
        for (int dt = 0; dt < 8; ++dt) A.O[dt] = (f32x4){0.f, 0.f, 0.f, 0.f};
        const int tpos = PAST + tokc;
        for (int gi = w; gi < 65; gi += 8) {
            const int j = gi >> 1;
            if (j < 32 && !((umask >> j) & 1u)) continue;
            const int k0 = 32 * gi;
            const float* pagep = p.cache_kv + (long)p.page_table[b * 16 + (k0 < PAST ? (k0 >> 7) : 15)] * 128 * 1024 + 512 + g * 128;
            const float* newp = proj + (long)(NTP + b * 4) * NAP + CKV + 512 + g * 128;
            auto rowk = [&](int key) { return key < PAST ? pagep + (long)(key & 127) * 1024 : newp + (long)min(key - PAST, 3) * NAP; };
            auto rowv = [&](int key) { return (key < PAST ? pagep + (long)(key & 127) * 1024 : newp + (long)min(key - PAST, 3) * NAP) + 256; };
            const bool selj = j >= 32 || ((mymask >> j) & 1u);
            auto valid = [&](int key) { return selj && key <= tpos; };
            attn16_group(k0, rowk, rowv, valid, Qb, A, c, q);
        }
        combine(A, gate[1]);
    }
    {
        Acc16 A; A.m = -INFINITY; A.l = 0.f;
#pragma unroll
        for (int dt = 0; dt < 8; ++dt) A.O[dt] = (f32x4){0.f, 0.f, 0.f, 0.f};
        const float* winp = p.cache_win + (long)b * 512 * 512 + g * 128;
        const float* newp = proj + (long)(NTP + b * 4) * NAP + CKV + 1024 + g * 128;
        for (int gi = w; gi < 17; gi += 8) {
            const int k0 = 32 * gi;
            auto rowk = [&](int key) { return key < 512 ? winp + (long)key * 512 : newp + (long)min(key - 512, 3) * NAP; };
            auto rowv = [&](int key) { return (key < 512 ? winp + (long)key * 512 : newp + (long)min(key - 512, 3) * NAP) + 256; };
            auto valid = [&](int key) { return key <= 512 + tokc && key > tokc; };
            attn16_group(k0, rowk, rowv, valid, Qb, A, c, q);
        }
        combine(A, gate[2]);
    }
    {
        const long tok = NTP + b * 4 + (cq >> 2); const int h = g * 4 + (cq & 3);
        const f32x4 z = *reinterpret_cast<const f32x4*>(proj + tok * NAP + CZA + h * 128 + cd);
        u32x2 o = {cvt_pk(acc[0] * siluf_(z[0]), acc[1] * siluf_(z[1])), cvt_pk(acc[2] * siluf_(z[2]), acc[3] * siluf_(z[3]))};
        *reinterpret_cast<u32x2*>((u16*)(ws + WS_OA) + tok * DM + h * 128 + cd) = o;
    }
}

DI f32x16 scores32(const u16* __restrict__ kr, const bf16x8 (&Qb)[8], int hh) {
    f32x16 s;
#pragma unroll
    for (int i = 0; i < 16; ++i) s[i] = 0.f;
#pragma unroll
    for (int ks = 0; ks < 8; ++ks) s = mfma32(ld8(kr + 16 * ks + 8 * hh), Qb[ks], s);
    return s;
}
DI void pv32(const u16* __restrict__ vt, int ldt, const float (&pr)[16], f32x16 (&O)[4], int c, int hh) {
#pragma unroll
    for (int s2 = 0; s2 < 2; ++s2) {
        const bf16x8 B = mk8(cvt_pk(pr[8 * s2 + 0], pr[8 * s2 + 1]), cvt_pk(pr[8 * s2 + 2], pr[8 * s2 + 3]),
                             cvt_pk(pr[8 * s2 + 4], pr[8 * s2 + 5]), cvt_pk(pr[8 * s2 + 6], pr[8 * s2 + 7]));
#pragma unroll
        for (int mt = 0; mt < 4; ++mt) {
            const u16* a = vt + (long)(32 * mt + c) * ldt + 16 * s2 + 4 * hh;
            const u32x2 w0 = *reinterpret_cast<const u32x2*>(a), w1 = *reinterpret_cast<const u32x2*>(a + 8);
            O[mt] = mfma32(mk8(w0.x, w0.y, w1.x, w1.y), B, O[mt]);
        }
    }
}
struct Acc32 { float m, l; f32x16 O[4]; };
DI void acc32_init(Acc32& A) {
    A.m = -INFINITY; A.l = 0.f;
#pragma unroll
    for (int mt = 0; mt < 4; ++mt)
#pragma unroll
        for (int i = 0; i < 16; ++i) A.O[mt][i] = 0.f;
}
DI void load_kf(bf16x8 (&kf)[8], const u16* __restrict__ kt, int koff) {
#pragma unroll
    for (int ks = 0; ks < 8; ++ks) kf[ks] = ld8(kt + koff + 16 * ks);
}
DI void load_vf(u32x2 (&vf)[2][4][2], const u16* __restrict__ vt, int ldt, int voff) {
#pragma unroll
    for (int mt = 0; mt < 4; ++mt) {
        const u16* a = vt + 32 * mt * ldt;
#pragma unroll
        for (int s2 = 0; s2 < 2; ++s2) {
            vf[s2][mt][0] = *reinterpret_cast<const u32x2*>(a + voff + 16 * s2);
            vf[s2][mt][1] = *reinterpret_cast<const u32x2*>(a + voff + 16 * s2 + 8);
        }
    }
}
DI void load_kff(bf16x8 (&kf)[8], const u16* __restrict__ kt, int l8) {
#pragma unroll
    for (int ks = 0; ks < 8; ++ks) kf[ks] = ld8(kt + ks * 512 + l8);
}
DI void load_vff(bf16x8 (&vf)[2][4], const u16* __restrict__ vt, int l8) {
#pragma unroll
    for (int s2 = 0; s2 < 2; ++s2)
#pragma unroll
        for (int mt = 0; mt < 4; ++mt) vf[s2][mt] = ld8(vt + (s2 * 4 + mt) * 512 + l8);
}
DI void pv32ff(const bf16x8 (&vf)[2][4], const float (&pr)[16], f32x16 (&O)[4]) {
#pragma unroll
    for (int s2 = 0; s2 < 2; ++s2) {
        const bf16x8 B = mk8(cvt_pk(pr[8 * s2 + 0], pr[8 * s2 + 1]), cvt_pk(pr[8 * s2 + 2], pr[8 * s2 + 3]),
                             cvt_pk(pr[8 * s2 + 4], pr[8 * s2 + 5]), cvt_pk(pr[8 * s2 + 6], pr[8 * s2 + 7]));
#pragma unroll
        for (int mt = 0; mt < 4; ++mt) O[mt] = mfma32(vf[s2][mt], B, O[mt]);
    }
}
DI void pv32f(const u32x2 (&vf)[2][4][2], const float (&pr)[16], f32x16 (&O)[4]) {
#pragma unroll
    for (int s2 = 0; s2 < 2; ++s2) {
        const bf16x8 B = mk8(cvt_pk(pr[8 * s2 + 0], pr[8 * s2 + 1]), cvt_pk(pr[8 * s2 + 2], pr[8 * s2 + 3]),
                             cvt_pk(pr[8 * s2 + 4], pr[8 * s2 + 5]), cvt_pk(pr[8 * s2 + 6], pr[8 * s2 + 7]));
#pragma unroll
        for (int mt = 0; mt < 4; ++mt) O[mt] = mfma32(mk8(vf[s2][mt][0].x, vf[s2][mt][0].y, vf[s2][mt][1].x, vf[s2][mt][1].y), B, O[mt]);
    }
}
template <class LIM>
DI void attn32_run(u64 tmask, const u16* __restrict__ K, const u16* __restrict__ VT, const bf16x8 (&Qb)[8], Acc32& A, int c, int hh, const LIM& lim) {
    if (tmask == 0) return;
    int T = __builtin_ctzll(tmask); tmask &= tmask - 1;
    bf16x8 kf[8];
    const int l8 = (hh * 32 + c) * 8;
    load_kff(kf, K + T * 4096, l8);
    for (;;) {
        f32x16 s;
#pragma unroll
        for (int i = 0; i < 16; ++i) s[i] = 0.f;
#pragma unroll
        for (int ks = 0; ks < 8; ++ks) s = mfma32(kf[ks], Qb[ks], s);
        __builtin_amdgcn_sched_barrier(0);
        bf16x8 vf[2][4];
        load_vff(vf, VT + T * 4096, l8);
        const bool more = tmask != 0;
        const int Tn = more ? (int)__builtin_ctzll(tmask) : T;
        tmask &= tmask - 1;
        load_kff(kf, K + Tn * 4096, l8);
        int lo, hi; lim(T, lo, hi);
        float sv[16];
        float mx = -INFINITY;
#pragma unroll
        for (int i = 0; i < 16; ++i) {
            const int kc = (i & 3) + 8 * (i >> 2);
            sv[i] = (kc <= hi && kc > lo) ? s[i] : -INFINITY;
            mx = fmaxf(mx, sv[i]);
        }
        mx = fmaxf(mx, __shfl_xor(mx, 32, 64));
        const float mnew = fmaxf(A.m, mx);
        const float muse = (mnew == -INFINITY) ? 0.f : mnew;
        const float alpha = exp2f_(A.m - muse);
        float ps = 0.f;
#pragma unroll
        for (int i = 0; i < 16; ++i) { sv[i] = exp2f_(sv[i] - muse); ps += sv[i]; }
        ps += __shfl_xor(ps, 32, 64);
        A.l = A.l * alpha + ps; A.m = mnew;
#pragma unroll
        for (int mt = 0; mt < 4; ++mt) A.O[mt] *= alpha;
        pv32ff(vf, sv, A.O);
        if (!more) break;
        T = Tn;
    }
}

constexpr int AP_WAVE_BYTES = 17408;
constexpr int AP_UM_OFF = 8 * AP_WAVE_BYTES;
constexpr int AP_ST_LD = 132;
constexpr int AP_ST_BYTES = 32 * AP_ST_LD * 2;
constexpr int AP_RING_OFF = 69632;

template <class LIM, class USE>
DI void attn32_ring(u64 tmask, const u16* __restrict__ K, const u16* __restrict__ VT, int tid, int lane,
                    const bf16x8 (&Qb)[8], Acc32& A, const LIM& lim, const USE& use) {
    if (tmask == 0) return;
    auto issue = [&](int P, int st) {
        char* l = smem + AP_RING_OFF + st * 32768 + tid * 16;
        const u16* k0 = K + (2 * P) * 4096 + tid * 8; const u16* v0 = VT + (2 * P) * 4096 + tid * 8;
        __builtin_amdgcn_global_load_lds((const unsigned*)k0, (unsigned*)l, 16, 0, 0);
        __builtin_amdgcn_global_load_lds((const unsigned*)v0, (unsigned*)(l + 8192), 16, 0, 0);
        __builtin_amdgcn_global_load_lds((const unsigned*)(k0 + 4096), (unsigned*)(l + 16384), 16, 0, 0);
        __builtin_amdgcn_global_load_lds((const unsigned*)(v0 + 4096), (unsigned*)(l + 24576), 16, 0, 0);
    };
    int P0 = __builtin_ctzll(tmask) >> 1; tmask &= ~(3ull << (2 * P0));
    issue(P0, 0);
    int st = 0;
    for (;;) {
        int P1 = -1; if (tmask) { P1 = __builtin_ctzll(tmask) >> 1; tmask &= ~(3ull << (2 * P1)); }
        asm volatile("s_waitcnt vmcnt(0)" ::: "memory");
        __builtin_amdgcn_s_barrier();
        if (P1 >= 0) issue(P1, st ^ 1);
#pragma unroll 1
        for (int half = 0; half < 2; ++half) {
            const int T0 = 2 * P0 + half;
            if (!use(T0)) continue;
            const char* kb = smem + AP_RING_OFF + st * 32768 + half * 16384 + lane * 16;
            f32x16 s;
#pragma unroll
            for (int i = 0; i < 16; ++i) s[i] = 0.f;
#pragma unroll
            for (int ks = 0; ks < 8; ++ks) s = mfma32(*reinterpret_cast<const bf16x8*>(kb + ks * 1024), Qb[ks], s);
            int lo, hi; lim(T0, lo, hi);
            float sv[16];
            float mx = -INFINITY;
#pragma unroll
            for (int i = 0; i < 16; ++i) {
                const int kc = (i & 3) + 8 * (i >> 2);
                sv[i] = (kc <= hi && kc > lo) ? s[i] : -INFINITY;
                mx = fmaxf(mx, sv[i]);
            }
            mx = fmaxf(mx, __shfl_xor(mx, 32, 64));
            if (__any(mx > A.m)) {
                const float mnew = fmaxf(A.m, mx);
                const float alpha = exp2f_(A.m - ((mnew == -INFINITY) ? 0.f : mnew));
                A.l *= alpha; A.m = mnew;
#pragma unroll
                for (int mt = 0; mt < 4; ++mt) A.O[mt] *= alpha;
            }
            const float muse = (A.m == -INFINITY) ? 0.f : A.m;
            float ps = 0.f;
#pragma unroll
            for (int i = 0; i < 16; ++i) { sv[i] = exp2f_(sv[i] - muse); ps += sv[i]; }
            ps += __shfl_xor(ps, 32, 64);
            A.l += ps;
#pragma unroll
            for (int s2 = 0; s2 < 2; ++s2) {
                const bf16x8 B = mk8(cvt_pk(sv[8 * s2 + 0], sv[8 * s2 + 1]), cvt_pk(sv[8 * s2 + 2], sv[8 * s2 + 3]),
                                     cvt_pk(sv[8 * s2 + 4], sv[8 * s2 + 5]), cvt_pk(sv[8 * s2 + 6], sv[8 * s2 + 7]));
#pragma unroll
                for (int mt = 0; mt < 4; ++mt) A.O[mt] = mfma32(*reinterpret_cast<const bf16x8*>(kb + 8192 + (s2 * 4 + mt) * 1024), B, A.O[mt]);
            }
        }
        if (P1 < 0) break;
        P0 = P1; st ^= 1;
    }
    __builtin_amdgcn_s_barrier();
}

DI void attn_prompt_item(const Params& p, int b, int g, int X) {
    char* ws = p.ws;
    const float* proj = (const float*)(ws + WS_PROJ);
    int tid = threadIdx.x; asm volatile("" : "+v"(tid));
    const int w = __builtin_amdgcn_readfirstlane(tid >> 6), lane = tid & 63, c = lane & 31, hh = lane >> 5;
    const int ti = c >> 2, r = c & 3;
    const int t0w = 64 * X + 8 * w;
    const int tpos = t0w + ti;
    const long tok = (long)b * 2048 + tpos;
    const int h = g * 4 + r;
    float* OS = reinterpret_cast<float*>(smem + w * AP_WAVE_BYTES);
    float* IMP = OS + 128 * 32;
    int osl = 128 * hh + c;
    asm volatile("" : "+v"(osl));
    bf16x8 Qb[8];
    {
        const u16* qb = (const u16*)(ws + WS_Q) + tok * 1024 + h * 128;
#pragma unroll
        for (int ks = 0; ks < 8; ++ks) Qb[ks] = ld8(qb + 16 * ks + 8 * hh);
    }
    float gate[3];
    {
        const float* gp = proj + tok * NAP + CGB + h * 3;
        gate[0] = sigmoidf_(gp[0]); gate[1] = sigmoidf_(gp[1]); gate[2] = sigmoidf_(gp[2]);
    }
    const int bg = b * 2 + g;
    const int cur = X;
    u32 mymask, umask, bmask;
    u16* ST = reinterpret_cast<u16*>(smem + w * AP_ST_BYTES) + c * AP_ST_LD + 4 * hh;
    {
        const u16* kc = (const u16*)(ws + WS_KCP) + (long)bg * 128 * 128;
        const u16* vct = (const u16*)(ws + WS_VCTP) + (long)bg * 128 * 128;
        float pc[4][16];
        float mx = -INFINITY;
        const int lim2 = min((tpos - 31) >> 4, 126) - 4 * hh;
        bf16x8 kf[8];
        load_kf(kf, kc, c * 128 + 8 * hh);
#pragma unroll
        for (int tl = 0; tl < 4; ++tl) {
            f32x16 s;
#pragma unroll
            for (int i = 0; i < 16; ++i) s[i] = 0.f;
#pragma unroll
            for (int ks = 0; ks < 8; ++ks) s = mfma32(kf[ks], Qb[ks], s);
            if (tl < 3) load_kf(kf, kc + 32 * (tl + 1) * 128, c * 128 + 8 * hh);
#pragma unroll
            for (int i = 0; i < 16; ++i) {
                pc[tl][i] = (32 * tl + (i & 3) + 8 * (i >> 2) <= lim2) ? s[i] : -INFINITY;
                mx = fmaxf(mx, pc[tl][i]);
            }
        }
        mx = fmaxf(mx, __shfl_xor(mx, 32, 64));
        const float muse = (mx == -INFINITY) ? 0.f : mx;
        float ls = 0.f;
#pragma unroll
        for (int tl = 0; tl < 4; ++tl)
#pragma unroll
            for (int i = 0; i < 16; ++i) { pc[tl][i] = exp2f_(pc[tl][i] - muse); ls += pc[tl][i]; }
        ls += __shfl_xor(ls, 32, 64);
        const float il = ls > 0.f ? 1.f / ls : 0.f;
#pragma unroll
        for (int tl = 0; tl < 4; ++tl)
#pragma unroll
            for (int i = 0; i < 16; ++i) {
                pc[tl][i] *= il;
                OS[osl + ((32 * tl + (i & 3) + 8 * (i >> 2))) * 32] = pc[tl][i];
            }
        __syncthreads();
#pragma unroll
        for (int n = 0; n < 4; ++n) {
            const int pi = lane + 64 * n, tk = pi >> 5, u = pi & 31;
            float s = 0.f;
#pragma unroll
            for (int rr = 0; rr < 4; ++rr) {
                const float* pr = OS + (4 * u) * 32 + tk * 4 + rr;
                s += 2.f * (pr[0] + pr[32] + pr[64]) + pr[96] + (u > 0 ? pr[-32] : 0.f);
            }
            IMP[pi] = s;
        }
        __syncthreads();
        u64 bal[4];
#pragma unroll
        for (int n = 0; n < 4; ++n) {
            const int pi = lane + 64 * n, tk = pi >> 5, u = pi & 31;
            bool sel;
            const bool forced = (u == 0) || (u == cur) || (u == cur - 1);
            if (u > cur) sel = false;
            else if (forced) sel = true;
            else {
                const int nf = cur == 0 ? 1 : cur == 1 ? 2 : 3;
                const float mine = IMP[pi];
                int rank = 0;
                for (int u2 = 1; u2 < cur - 1; ++u2) { const float o = IMP[tk * 32 + u2]; rank += (o > mine || (o == mine && u2 < u)) ? 1 : 0; }
                sel = rank < 16 - nf;
            }
            bal[n] = __ballot(sel);
        }
        const u64 bsel = ti < 2 ? bal[0] : ti < 4 ? bal[1] : ti < 6 ? bal[2] : bal[3];
        mymask = (ti & 1) ? (u32)(bsel >> 32) : (u32)bsel;
        umask = (u32)(bal[0] | (bal[0] >> 32) | bal[1] | (bal[1] >> 32) | bal[2] | (bal[2] >> 32) | bal[3] | (bal[3] >> 32));
        if (lane == 0) reinterpret_cast<u32*>(smem + AP_UM_OFF)[w] = umask;
        f32x16 O[4];
#pragma unroll
        for (int mt = 0; mt < 4; ++mt)
#pragma unroll
            for (int i = 0; i < 16; ++i) O[mt][i] = 0.f;
#pragma unroll
        for (int tl = 0; tl < 4; ++tl) {
            u32x2 vf[2][4][2]; load_vf(vf, vct + 32 * tl, 128, c * 128 + 4 * hh);
            float pr[16];
#pragma unroll
            for (int i = 0; i < 16; ++i) pr[i] = OS[osl + ((32 * tl + (i & 3) + 8 * (i >> 2))) * 32];
            pv32f(vf, pr, O);
            __builtin_amdgcn_sched_barrier(0);
        }
        __syncthreads();
        {
            const u32* um = reinterpret_cast<const u32*>(smem + AP_UM_OFF);
            bmask = um[0] | um[1] | um[2] | um[3] | um[4] | um[5] | um[6] | um[7];
            bmask = (u32)__builtin_amdgcn_readfirstlane((int)bmask);
        }
#pragma unroll
        for (int mt = 0; mt < 4; ++mt)
#pragma unroll
            for (int rr = 0; rr < 4; ++rr) {
                u32x2 wv = {cvt_pk(gate[0] * O[mt][4 * rr], gate[0] * O[mt][4 * rr + 1]), cvt_pk(gate[0] * O[mt][4 * rr + 2], gate[0] * O[mt][4 * rr + 3])};
                *reinterpret_cast<u32x2*>(ST + 32 * mt + 8 * rr) = wv;
            }
    }
    const int tp4 = tpos - 4 * hh;
    {
        Acc32 A; acc32_init(A);
        const u16* K = (const u16*)(ws + WS_KF) + ((long)(0 * 4 + b) * 2 + g) * 64 * 4096;
        const u16* VT = (const u16*)(ws + WS_VT) + ((long)(0 * 4 + b) * 2 + g) * 64 * 4096;
        u64 tm = 0;
        for (int j = 0; j <= cur; ++j) if ((bmask >> j) & 1u) tm |= 3ull << (2 * j);
        attn32_ring(tm, K, VT, tid, lane, Qb, A,
                    [&](int T, int& lo, int& hi) { lo = -(1 << 30); hi = ((mymask >> (T >> 1)) & 1u) ? tp4 - 32 * T : -1; },
                    [&](int T) { return ((umask >> (T >> 1)) & 1u) && 32 * T <= t0w + 7; });
#ifdef DBG_DUPSEL
        {
            Acc32 A2; acc32_init(A2);
            attn32_ring(tm, K, VT, tid, lane, Qb, A2,
                        [&](int T, int& lo, int& hi) { lo = -(1 << 30); hi = ((mymask >> (T >> 1)) & 1u) ? tp4 - 32 * T : -1; },
                        [&](int T) { return ((umask >> (T >> 1)) & 1u) && 32 * T <= t0w + 7; });
            asm volatile("" :: "v"(A2.l), "v"(A2.O[0][0]), "v"(A2.O[1][0]), "v"(A2.O[2][0]), "v"(A2.O[3][0]));
        }
#endif
        const float cf = A.l > 0.f ? gate[1] / A.l : 0.f;
#pragma unroll
        for (int mt = 0; mt < 4; ++mt)
#pragma unroll
            for (int rr = 0; rr < 4; ++rr) {
                const u32x2 o = *reinterpret_cast<const u32x2*>(ST + 32 * mt + 8 * rr);
                u32x2 wv = {cvt_pk(bflo(o.x) + cf * A.O[mt][4 * rr], bfhi(o.x) + cf * A.O[mt][4 * rr + 1]),
                            cvt_pk(bflo(o.y) + cf * A.O[mt][4 * rr + 2], bfhi(o.y) + cf * A.O[mt][4 * rr + 3])};
                *reinterpret_cast<u32x2*>(ST + 32 * mt + 8 * rr) = wv;
            }
    }
    {
        Acc32 A; acc32_init(A);
        const u16* K = (const u16*)(ws + WS_KF) + ((long)(1 * 4 + b) * 2 + g) * 64 * 4096;
        const u16* VT = (const u16*)(ws + WS_VT) + ((long)(1 * 4 + b) * 2 + g) * 64 * 4096;
        const int Tlo = max(0, 64 * X - 511) >> 5, Tmax = 2 * X + 1;
        const u64 tm = ((2ull << Tmax) - 1ull) & ~((1ull << Tlo) - 1ull);
        attn32_ring(tm, K, VT, tid, lane, Qb, A,
                    [&](int T, int& lo, int& hi) { hi = tp4 - 32 * T; lo = hi - 512; },
                    [&](int T) { return 32 * T <= t0w + 7 && 32 * T + 31 > t0w - 512; });
        const float cf = A.l > 0.f ? gate[2] / A.l : 0.f;
        int h4 = 4 * hh; asm volatile("" : "+v"(h4));
        u16* oa = (u16*)(ws + WS_OA) + tok * DM + h * 128 + h4;
        const float* za = proj + tok * NAP + CZA + h * 128 + h4;
#pragma unroll
        for (int mt = 0; mt < 4; ++mt)
#pragma unroll
            for (int rr = 0; rr < 4; ++rr) {
                const int d0 = 32 * mt + 8 * rr;
                const f32x4 z = *reinterpret_cast<const f32x4*>(za + d0);
                const u32x2 o = *reinterpret_cast<const u32x2*>(ST + d0);
                u32x2 wv = {cvt_pk((bflo(o.x) + cf * A.O[mt][4 * rr]) * siluf_(z[0]), (bfhi(o.x) + cf * A.O[mt][4 * rr + 1]) * siluf_(z[1])),
                            cvt_pk((bflo(o.y) + cf * A.O[mt][4 * rr + 2]) * siluf_(z[2]), (bfhi(o.y) + cf * A.O[mt][4 * rr + 3]) * siluf_(z[3]))};
                *reinterpret_cast<u32x2*>(oa + d0) = wv;
                asm volatile("" ::: "memory");
            }
    }
    __syncthreads();
}

DI int gemm_tile_id(int i) {
    const int nb = gridDim.x, nx = nb >> 5;
    if ((nb & 31) != 0) return blockIdx.x + i * nb;
    return ((i * nx + (int)(blockIdx.x % nx)) << 5) + (int)(blockIdx.x / nx);
}
DI void gemm_tile_pos(int u, int ncol, int& pm, int& pn) {
    const int P = u / (2 * ncol), rem = u - P * 2 * ncol;
    pn = rem >> 1; pm = 2 * P + (rem & 1);
}
DI void phase2(const Params& p) {
    char* ws = p.ws;
    const int nb = gridDim.x, bid = blockIdx.x;
    const bool split = nb >= 32;
    if (!split || bid < 16) {
        for (int u = bid; u < 16; u += nb) {
            const int half = u >> 3, slot = (u >> 2) & 1, rt = u & 3;
            EpiStore e{(float*)(ws + WS_CPP) + (long)(half * 2 + slot) * 1024 * 256, 256};
            gemm_tile((const u16*)(ws + WS_KV6) + (long)slot * 1024 * 2048 + half * 2048, 2048,
                      (const u16*)(ws + WS_W1T) + (long)slot * 256 * 4096 + half * 2048, 4096, 2048, rt * 256, 0, e);
        }
    }
    if (!split || bid >= 16) {
        const int rank = split ? bid - 16 : bid, count = split ? nb - 16 : nb;
        gla_prep(p, rank, count);
    }
}
DI int first_item(int start) { const int nb = gridDim.x; return start + (int)((blockIdx.x + nb - start % nb) % nb); }
DI void phase3(const Params& p) {
    char* ws = p.ws;
    for (int it = gridDim.x == 256 ? 256 : first_item(0); it < 256; it += gridDim.x) {
        const int bh = it >> 4, b = bh >> 2, h = bh & 3, chunk = (it & 15) * 8 + (threadIdx.x >> 6);
        rec_prep2<16>((const u16*)(ws + WS_GQT) + (long)bh * 262144, (const u16*)(ws + WS_GKA) + (long)bh * 262144,
                      (const u16*)(ws + WS_GVT) + (long)bh * 128 * 256 * 16, (float*)(ws + WS_GOI) + (long)bh * 128 * 16 * 256, chunk);
    }
    for (int it = first_item(256); it < 512; it += gridDim.x) { const int u = it - 256; attn_sample_item(p, u >> 1, u & 1); }
    {
        const float* cp = (const float*)(ws + WS_CPP);
        const float* hc = (const float*)(ws + WS_HCONST);
        u16* a2 = (u16*)(ws + WS_A2P);
        for (int i = blockIdx.x * 512 + threadIdx.x; i < 2 * 1024 * 64; i += gridDim.x * 512) {
            const int slot = i >> 16, row = (i >> 6) & 1023, c4 = (i & 63) * 4;
            const f32x4 a = *reinterpret_cast<const f32x4*>(cp + ((long)slot * 1024 + row) * 256 + c4);
            const f32x4 b2 = *reinterpret_cast<const f32x4*>(cp + ((long)(2 + slot) * 1024 + row) * 256 + c4);
            const f32x4 h0 = *reinterpret_cast<const f32x4*>(hc + slot * 256 + c4);
            f32x4 o;
#pragma unroll
            for (int j = 0; j < 4; ++j) o[j] = ((row & 127) == 127) ? 0.f : gelu_tanh(a[j] + b2[j] + h0[j]);
            *reinterpret_cast<u32x2*>(a2 + ((long)slot * 1024 + row) * 256 + c4) = pk4(o);
        }
    }
}
DI void phase4(const Params& p) {
    char* ws = p.ws;
    const int w = __builtin_amdgcn_readfirstlane((int)(threadIdx.x >> 6));
    const bool pair = gridDim.x == 256;
    if (threadIdx.x < 2) reinterpret_cast<int*>(smem + RW_OFF + RW_SLOTS * 4096)[threadIdx.x] = 0;
    __syncthreads();
    if (w == 0 || (pair && w == 3)) {
        for (int t0 = blockIdx.x; t0 < 256; t0 += gridDim.x) {
            const int t = (gridDim.x == 256) ? (((t0 & 7) * 2 + (t0 >> 7)) << 4) + ((t0 >> 3) & 15) : t0;
            const int bh = t >> 4, b = bh >> 2, h = bh & 3, vt = t & 15;
            if (!pair)
                rec_walker<16>((const u16*)(ws + WS_GQT) + (long)bh * 262144, (const u16*)(ws + WS_GKST) + (long)bh * 128 * 2048,
                               (const u16*)(ws + WS_GVT) + (long)bh * 128 * 256 * 16, (const u16*)(ws + WS_GDC) + (long)bh * 128 * 128,
                               (const float*)(ws + WS_GOI) + (long)bh * 128 * 16 * 256, vt,
                               (float*)(ws + WS_OB32) + (long)b * 2048 * 1024 + h * 256, 1024, p.out + O_GLAP + (long)bh * 128 * 256, 256);
            else if (w == 0)
                rec_state_wave<16>((const u16*)(ws + WS_GKST) + (long)bh * 128 * 2048, (const u16*)(ws + WS_GVT) + (long)bh * 128 * 256 * 16,
                                   (const u16*)(ws + WS_GDC) + (long)bh * 128 * 128, vt, p.out + O_GLAP + (long)bh * 128 * 256, 256, RW_OFF);
            else
                rec_out_wave<16>((const u16*)(ws + WS_GQT) + (long)bh * 262144, (const u16*)(ws + WS_GKA) + (long)bh * 262144,
                                 (const u16*)(ws + WS_GVT) + (long)bh * 128 * 256 * 16, vt,
                                 (float*)(ws + WS_OB32) + (long)b * 2048 * 1024 + h * 256, 1024, RW_OFF);
        }
    } else {
        if (!(pair && w >= 3))
            for (int it = blockIdx.x + gridDim.x * (w - 1); it < 512; it += gridDim.x * 7)
                gla_sample_wave(p, it >> 2, it & 3, reinterpret_cast<float*>(smem + w * 8192));
    }
    __syncthreads();
    for (int it = first_item(0); it < 8; it += gridDim.x) {
        const int slot = it >> 2, rt = it & 3;
        EpiCmp2P e{(u16*)(ws + WS_KCP), (u16*)(ws + WS_VCTP), slot};
        gemm_tile((const u16*)(ws + WS_A2P) + (long)slot * 1024 * 256, 256, (const u16*)(ws + WS_W2T) + (long)slot * 256 * 256, 256, 256, rt * 256, 0, e);
    }
}
DI void final_norm_rows(const Params& p, int r0, int r1, int parts) {
    const float* x2 = (const float*)(p.ws + (parts > 0 ? WS_X1 : WS_X2));
    const float* pp = (const float*)(p.ws + WS_PROJC);
    const int lane = threadIdx.x & 63, wid = threadIdx.x >> 6;
    for (int row = r0 + blockIdx.x * 8 + wid; row < r1; row += gridDim.x * 8) {
        const float4* x = reinterpret_cast<const float4*>(x2 + (long)row * DM);
        float4* y = reinterpret_cast<float4*>(row < NTP ? p.out + O_YP + (long)row * DM : p.out + O_YS + (long)(row - NTP) * DM);
        float4 v[8]; float ss = 0.f;
#pragma unroll
        for (int i = 0; i < 8; ++i) v[i] = x[lane + 64 * i];
        for (int q4 = 0; q4 < parts; ++q4) {
            const float4* xp = reinterpret_cast<const float4*>(pp + ((long)q4 * NTS + (row - NTP)) * DM);
#pragma unroll
            for (int i = 0; i < 8; ++i) { const float4 a = xp[lane + 64 * i]; v[i].x += a.x; v[i].y += a.y; v[i].z += a.z; v[i].w += a.w; }
        }
#pragma unroll
        for (int i = 0; i < 8; ++i) ss += v[i].x * v[i].x + v[i].y * v[i].y + v[i].z * v[i].z + v[i].w * v[i].w;
        ss = wave_sum(ss);
        const float inv = rsqrtf(ss * (1.f / DM) + 1e-6f);
#pragma unroll
        for (int i = 0; i < 8; ++i) {
            const float4 g = reinterpret_cast<const float4*>(p.final_norm)[lane + 64 * i];
            y[lane + 64 * i] = make_float4(v[i].x * inv * g.x, v[i].y * inv * g.y, v[i].z * inv * g.z, v[i].w * inv * g.w);
        }
    }
}
DI void win_copy_range(const Params& p, int i0, int i1) {
    const int n = 128 * 508 * 128;
    const f32x4* src = reinterpret_cast<const f32x4*>(p.cache_win);
    f32x4* dst = reinterpret_cast<f32x4*>(p.out + O_WINS);
    i1 = min(i1, n);
    for (int ib = i0 + (int)threadIdx.x; ib < i1; ib += 16 * 512) {
        f32x4 v[16];
#pragma unroll
        for (int u = 0; u < 16; ++u) { const int i = min(ib + u * 512, i1 - 1); const int b = i / (508 * 128), r = i - b * (508 * 128); v[u] = src[b * 512 * 128 + 4 * 128 + r]; }
#pragma unroll
        for (int u = 0; u < 16; ++u) { const int i = min(ib + u * 512, i1 - 1); const int b = i / (508 * 128), r = i - b * (508 * 128); dst[b * 512 * 128 + r] = v[u]; }
    }
}
DI int win_w(int x) { return x < 14 ? (int)((0x23345567788867ull >> (4 * x)) & 15) : 0; }
DI int win_wsum(int x) { int s = 0; for (int i = 0; i < x; ++i) s += win_w(i); return s; }
constexpr int WIN_U5 = 79, WIN_UT = 90;
DI void phase5(const Params& p) {
    char* ws = p.ws;
    for (int it = blockIdx.x; it < 256; it += gridDim.x) attn_prompt_item(p, it >> 6, (it >> 5) & 1, it & 31);
    for (int it = blockIdx.x; it < 256; it += gridDim.x) {
        const int x = it & 31;
        if (x >= 2) continue;
        const int j = (it >> 5) * 2 + x;
        EpiRes e{p.x_prompt, p.x_sample, (float*)(ws + WS_X1)};
        gemm_tile((const u16*)(ws + WS_OA), DM, (const u16*)(ws + WS_WOUTA), DM, DM, (32 + (j >> 3)) * 256, (j & 7) * 256, e);
    }
    if (gridDim.x == 256) {
        const int x = blockIdx.x & 31;
        if (x >= 2 && x < 16) gla_norm_gate(p, (blockIdx.x >> 5) * 14 + (x - 2), 112);
        if (win_w(x) > 0) {
            const long n = 128 * 508 * 128, units = 8 * WIN_UT;
            const long u0 = (blockIdx.x >> 5) * WIN_U5 + win_wsum(x), u1 = u0 + win_w(x);
            win_copy_range(p, (int)(n * u0 / units), (int)(n * u1 / units));
        }
    } else {
        gla_norm_gate(p, blockIdx.x, gridDim.x);
    }
}
DI void phase6(const Params& p) {
    char* ws = p.ws;
    for (int t = blockIdx.x; t < 32 * 8; t += gridDim.x) {
        EpiRes e{p.x_prompt, p.x_sample, (float*)(ws + WS_X1)};
        gemm_tile((const u16*)(ws + WS_OA), DM, (const u16*)(ws + WS_WOUTA), DM, DM, (t & 31) * 256, (t >> 5) * 256, e);
    }
    rmsnorm_rows_bf16((const float*)(ws + WS_X1) + (long)NTP * DM, (const float*)(ws + WS_X1) + (long)NTP * DM, NTS, NTS, p.c_norm, (u16*)(ws + WS_H) + (long)NTP * DM, blockIdx.x, gridDim.x);
}
DI EpiInC make_epi_c(const Params& p) {
    char* ws = p.ws;
    return EpiInC{(u16*)(ws + WS_HQT), (u16*)(ws + WS_HKA), (u16*)(ws + WS_HKST), (u16*)(ws + WS_HVT), (u16*)(ws + WS_ZB),
                  (u16*)(ws + WS_HDC), (float*)(ws + WS_PCS), p.c_lb_logits};
}
DI void phase7(const Params& p) {
    char* ws = p.ws;
    for (int t = blockIdx.x; t < 128; t += gridDim.x) {
        const int half = t >> 6, tile = t & 63;
        EpiInC e = make_epi_c(p);
        e.PCS += (long)half * NTS * NC;
        gemm_tile<EpiInC, true>((const u16*)(ws + WS_H) + half * 1024, DM, (const u16*)(ws + WS_WINC) + half * 1024, DM, 1024, (32 + (tile & 1)) * 256, (tile >> 1) * 256, e);
    }
    {
        const int nb = gridDim.x, first = nb > 128 ? 128 : 0, cnt = nb - first;
        if ((int)blockIdx.x >= first) {
            const int rank = blockIdx.x - first;
            rmsnorm_rows_bf16((const float*)(ws + WS_X1), (const float*)(ws + WS_X1), NTP, NTP, p.c_norm, (u16*)(ws + WS_H), rank, cnt);
            const long n = 128 * 508 * 128;
            const long c0 = nb == 256 ? n * (8 * WIN_U5) / (8 * WIN_UT) : 0;
            win_copy_range(p, (int)(c0 + (n - c0) * rank / cnt), (int)(c0 + (n - c0) * (rank + 1) / cnt));
        }
    }
}
DI void phase8(const Params& p) {
    char* ws = p.ws;
    for (int t = blockIdx.x; t < 32 * 32; t += gridDim.x) {
        const EpiInC e = make_epi_c(p);
        gemm_tile((const u16*)(ws + WS_H), DM, (const u16*)(ws + WS_WINC), DM, DM, (t & 31) * 256, (t >> 5) * 256, e);
    }
}
DI void phase9(const Params& p) {
    char* ws = p.ws;
    for (int it = first_item(0); it < 1024; it += gridDim.x) {
        const int bh = it >> 4, b = bh >> 4, h = bh & 15, chunk = (it & 15) * 8 + (threadIdx.x >> 6);
        rec_prep2<8>((const u16*)(ws + WS_HQT) + (long)bh * 262144, (const u16*)(ws + WS_HKA) + (long)bh * 262144,
                     (const u16*)(ws + WS_HVT) + (long)bh * 128 * 128 * 16, (float*)(ws + WS_HOI) + (long)bh * 128 * 8 * 256, chunk);
    }
    if (gridDim.x != 256) hgrn_sample_loop(p, first_item(1024) - 1024, 2048, gridDim.x);
}
DI void phase10(const Params&) {}
DI void phase11(const Params& p) {
    char* ws = p.ws;
    const int nb = gridDim.x, w = __builtin_amdgcn_readfirstlane((int)(threadIdx.x >> 6));
    if (nb == 256) {
        if (threadIdx.x < 4) reinterpret_cast<int*>(smem + RW_OFF + (threadIdx.x >> 1) * RW_PAIR_BYTES + RW_SLOTS * 4096)[threadIdx.x & 1] = 0;
        __syncthreads();
        if (w >= 6) {
            for (int n = 0; n < 4; ++n) hgrn_sample_wave(p, (int)blockIdx.x * 2 + (w - 6) + 512 * n, reinterpret_cast<float*>(smem + (w - 6) * 8192));
        } else if (w != 2 && w != 5) {
            const int ww = w >= 3 ? w - 3 : w;
            const int j = blockIdx.x & 7, local = ((int)blockIdx.x >> 3) + 32 * ww;
            const int t = (j * 8 + (local >> 3)) * 8 + (local & 7);
            const int bh = t >> 3, b = bh >> 4, h = bh & 15, vt = t & 7;
            if (w < 3)
                rec_state_wave<8>((const u16*)(ws + WS_HKST) + (long)bh * 128 * 2048, (const u16*)(ws + WS_HVT) + (long)bh * 128 * 128 * 16,
                                  (const u16*)(ws + WS_HDC) + (long)bh * 128 * 128, vt, p.out + O_HGP + (long)bh * 128 * 128, 128,
                                  RW_OFF + ww * RW_PAIR_BYTES);
            else
                rec_out_wave<8>((const u16*)(ws + WS_HQT) + (long)bh * 262144, (const u16*)(ws + WS_HKA) + (long)bh * 262144,
                                (const u16*)(ws + WS_HVT) + (long)bh * 128 * 128 * 16, vt,
                                (float*)(ws + WS_OC32) + (long)b * 2048 * DM + h * 128, DM, RW_OFF + ww * RW_PAIR_BYTES);
        }
    } else if (nb >= 64) {
        if ((int)blockIdx.x < 16) {
            for (int t = blockIdx.x; t < 16; t += 16) {
                EpiRes e{(const float*)(ws + WS_X1), (const float*)(ws + WS_X1) + (long)NTP * DM, (float*)(ws + WS_X2)};
                gemm_tile((const u16*)(ws + WS_OA), DM, (const u16*)(ws + WS_WOUTC), DM, DM, (32 + (t >> 3)) * 256, (t & 7) * 256, e);
            }
        } else {
            const int nw = nb - 16;
            {
                for (int t0 = (blockIdx.x - 16) + nw * w; t0 < 512; t0 += nw * 8) {
                    const int t = t0;
                    const int bh = t >> 3, b = bh >> 4, h = bh & 15, vt = t & 7;
                    rec_walker<8>((const u16*)(ws + WS_HQT) + (long)bh * 262144, (const u16*)(ws + WS_HKST) + (long)bh * 128 * 2048,
                                  (const u16*)(ws + WS_HVT) + (long)bh * 128 * 128 * 16, (const u16*)(ws + WS_HDC) + (long)bh * 128 * 128,
                                  (const float*)(ws + WS_HOI) + (long)bh * 128 * 8 * 256, vt,
                                  (float*)(ws + WS_OC32) + (long)b * 2048 * DM + h * 128, DM, p.out + O_HGP + (long)bh * 128 * 128, 128);
                }
            }
        }
    } else {
        for (int t = blockIdx.x; t < 16; t += nb) {
            EpiRes e{(const float*)(ws + WS_X1), (const float*)(ws + WS_X1) + (long)NTP * DM, (float*)(ws + WS_X2)};
            gemm_tile((const u16*)(ws + WS_OA), DM, (const u16*)(ws + WS_WOUTC), DM, DM, (32 + (t >> 3)) * 256, (t & 7) * 256, e);
        }
        for (int t = blockIdx.x + nb * w; t < 512; t += nb * 8) {
            const int bh = t >> 3, b = bh >> 4, h = bh & 15, vt = t & 7;
            rec_walker<8>((const u16*)(ws + WS_HQT) + (long)bh * 262144, (const u16*)(ws + WS_HKST) + (long)bh * 128 * 2048,
                          (const u16*)(ws + WS_HVT) + (long)bh * 128 * 128 * 16, (const u16*)(ws + WS_HDC) + (long)bh * 128 * 128,
                          (const float*)(ws + WS_HOI) + (long)bh * 128 * 8 * 256, vt,
                          (float*)(ws + WS_OC32) + (long)b * 2048 * DM + h * 128, DM, p.out + O_HGP + (long)bh * 128 * 128, 128);
        }
    }
}
DI void phase12(const Params& p) {
    char* ws = p.ws;
    if (gridDim.x == 256) {
        if (blockIdx.x < 64) {
            const int q4 = blockIdx.x >> 4, t = blockIdx.x & 15;
            EpiStore e{(float*)(ws + WS_PROJC) + ((long)q4 * NTS - NTP) * DM, DM};
            gemm_tile((const u16*)(ws + WS_OA) + q4 * 512, DM, (const u16*)(ws + WS_WOUTC) + q4 * 512, DM, 512, (32 + (t >> 3)) * 256, (t & 7) * 256, e);
        } else {
            hgrn_norm_gate(p, blockIdx.x - 64, 192);
        }
    } else {
        hgrn_norm_gate(p, blockIdx.x, gridDim.x);
    }
}
DI void phase13(const Params& p) {
    char* ws = p.ws;
    for (int t = blockIdx.x; t < 32 * 8; t += gridDim.x) {
        EpiRes e{(const float*)(ws + WS_X1), (const float*)(ws + WS_X1) + (long)NTP * DM, (float*)(ws + WS_X2)};
        gemm_tile((const u16*)(ws + WS_OA), DM, (const u16*)(ws + WS_WOUTC), DM, DM, (t & 31) * 256, (t >> 5) * 256, e);
    }
    final_norm_rows(p, NTP, NT, gridDim.x == 256 ? 4 : 0);
}
DI void phase14(const Params& p) { final_norm_rows(p, 0, NTP, 0); }

template <int PH> DI void run_phase(const Params& p) {
    if (PH == 0) phase0(p);
    if (PH == 1) phase1(p);
    if (PH == 2) phase2(p);
    if (PH == 3) phase3(p);
    if (PH == 4) phase4(p);
    if (PH == 5) phase5(p);
    if (PH == 6) phase6(p);
    if (PH == 7) phase7(p);
    if (PH == 8) phase8(p);
    if (PH == 9) phase9(p);
    if (PH == 10) phase10(p);
    if (PH == 11) phase11(p);
    if (PH == 12) phase12(p);
    if (PH == 13) phase13(p);
    if (PH == 14) phase14(p);
}

#ifndef MK_MULTI
#define MK_MULTI 0
#endif

#ifndef MK_DUMP_LO
#define MK_DUMP_LO 0
#define MK_DUMP_HI 4096
#endif
#if MK_MULTI
template <int PH> __global__ void __launch_bounds__(512, 2) k_phase(Params p) { run_phase<PH>(p); }
__global__ void k_dump(const float4* src, float4* dst, long n) {
    const u16* s = (const u16*)src; float* d = (float*)dst;
    for (long i = (long)blockIdx.x * blockDim.x + threadIdx.x; i < n; i += (long)gridDim.x * blockDim.x) { float v = bf2f(s[i]); const int col = (int)(i & 2047); if (col < MK_DUMP_LO || col >= MK_DUMP_HI) v = 0.f; d[i] = (fabsf(v) < 1e30f) ? v : 12345.f; } }
#else
__global__ void __launch_bounds__(512, 2) k_forward(Params p) {
    volatile LAS unsigned* xbw = (volatile LAS unsigned*)(smem + LDS_BYTES - 16);
    if (threadIdx.x == 0) { xbw[0] = 0u; xbw[1] = 0u; xbw[2] = 0u; xbw[3] = 0u; }
    __syncthreads();
    XcdBarrier bar = xcd_barrier_post(reinterpret_cast<unsigned*>(p.ws + WS_BAR), xbw);
#ifndef MK_DUP
#define MK_DUP -1
#endif
#define RUN_PH(PH) do { run_phase<PH>(p); if (MK_DUP == PH) { xcd_barrier(bar); run_phase<PH>(p); } } while (0)
    RUN_PH(0);  xcd_barrier(bar);
    RUN_PH(1);  xcd_barrier(bar);
    RUN_PH(2);  xcd_barrier(bar);
    RUN_PH(3);  xcd_barrier(bar);
    RUN_PH(4);  xcd_barrier(bar);
    RUN_PH(5);  xcd_barrier(bar);
    RUN_PH(6);  xcd_barrier(bar);
    RUN_PH(7);  xcd_barrier(bar);
    RUN_PH(8);  xcd_barrier(bar);
    if (gridDim.x != 256) { RUN_PH(9);  xcd_barrier(bar); }
#ifdef DBG_XBAR
    for (int i = 0; i < DBG_XBAR; ++i) xcd_barrier(bar);
#endif
    RUN_PH(11); xcd_barrier(bar);
    RUN_PH(12); xcd_barrier(bar);
    RUN_PH(13); xcd_barrier(bar);
    RUN_PH(14);
}
#endif

extern "C" void kernel_launch(void* const* d_in, const int* in_sizes, int n_in, void* d_out, int out_size, void* d_ws, size_t ws_size,
                              hipStream_t stream) {
    (void)in_sizes; (void)n_in; (void)out_size; (void)ws_size;
    Params p{};
    p.x_prompt = (const float*)d_in[0];  p.x_sample = (const float*)d_in[1];  p.cache_kv = (const float*)d_in[2];
    p.cache_win = (const float*)d_in[3]; p.state_gla = (const float*)d_in[4]; p.state_hgrn = (const float*)d_in[5];
    p.page_table = (const int*)d_in[6];
    p.a_norm = (const float*)d_in[7];    p.a_w_in = (const float*)d_in[8];    p.a_gla_w2 = (const float*)d_in[9];
    p.a_gla_b = (const float*)d_in[10];  p.a_gla_gn = (const float*)d_in[11]; p.a_cmp_pe = (const float*)d_in[12];
    p.a_cmp_w1 = (const float*)d_in[13]; p.a_cmp_b1 = (const float*)d_in[14]; p.a_cmp_w2 = (const float*)d_in[15];
    p.a_w_out = (const float*)d_in[16];  p.c_norm = (const float*)d_in[17];   p.c_w_in = (const float*)d_in[18];
    p.c_lb_logits = (const float*)d_in[19]; p.c_gn = (const float*)d_in[20];  p.c_w_out = (const float*)d_in[21];
    p.final_norm = (const float*)d_in[22];
    p.out = (float*)d_out; p.ws = (char*)d_ws;
    static int grid = 0;
#if MK_MULTI
    if (!grid) {
        int dev = 0, cus = 0; (void)hipGetDevice(&dev); (void)hipDeviceGetAttribute(&cus, hipDeviceAttributeMultiprocessorCount, dev);
        grid = cus > 0 ? cus : 256;
    }
#define LAUNCH_PH(PH) do { (void)hipFuncSetAttribute((const void*)k_phase<PH>, hipFuncAttributeMaxDynamicSharedMemorySize, LDS_BYTES); \
        hipLaunchKernelGGL(k_phase<PH>, dim3(grid), dim3(512), LDS_BYTES, stream, p); } while (0)
#ifndef MK_LAST
#define MK_LAST 14
#endif
#ifndef MK_SKIP
#define MK_SKIP 99
#endif
#define LAUNCH_IF(PH) do { if (PH <= MK_LAST && PH != MK_SKIP) LAUNCH_PH(PH); } while (0)
    LAUNCH_IF(0); LAUNCH_IF(1); LAUNCH_IF(2); LAUNCH_IF(3); LAUNCH_IF(4); LAUNCH_IF(5); LAUNCH_IF(6);
    LAUNCH_IF(7); LAUNCH_IF(8); LAUNCH_IF(9); LAUNCH_IF(10); LAUNCH_IF(11); LAUNCH_IF(12); LAUNCH_IF(13); LAUNCH_IF(14);
#ifdef MK_DUMP_OFF
    hipLaunchKernelGGL(k_dump, dim3(1024), dim3(256), 0, stream, (const float4*)(p.ws + MK_DUMP_OFF), (float4*)p.out, (long)MK_DUMP_N4);
#endif
#else
    if (!grid) {
        int dev = 0, cus = 0, per_cu = 0; (void)hipGetDevice(&dev); (void)hipDeviceGetAttribute(&cus, hipDeviceAttributeMultiprocessorCount, dev);
        (void)hipFuncSetAttribute((const void*)k_forward, hipFuncAttributeMaxDynamicSharedMemorySize, LDS_BYTES);
        (void)hipOccupancyMaxActiveBlocksPerMultiprocessor(&per_cu, (const void*)k_forward, 512, LDS_BYTES);
        if (cus <= 0) cus = 256;
        grid = cus * (per_cu < 1 ? 1 : 1);
    }
    (void)hipMemsetAsync(d_ws, 0, 65536, stream);
    hipLaunchKernelGGL(k_forward, dim3(grid), dim3(512), LDS_BYTES, stream, p);
#endif
}
```
